# Optimizing an MI355X kernel written in HIP

```python
import jax
import jax.numpy as jnp
from jax import lax
import numpy as np


D_MODEL = 1024
BATCH = 16
SEQ = 4096
DEPTH = 4

CTX_LEN = 256
GRID_W = 64
POOL_WINDOWS = (2, 4, 8, 16)
POOL_GROUP = D_MODEL // 8
POOL_WIDTH = POOL_GROUP * len(POOL_WINDOWS)
RET_HEADS = 4
RET_QK_DIM = D_MODEL // 8
RET_V_DIM = 2 * RET_QK_DIM
RET_QK_WIDTH = RET_HEADS * RET_QK_DIM
RET_V_WIDTH = RET_HEADS * RET_V_DIM
RET_CHUNK = 128
ROPE_BASE = 10000.0
OFF_Q = POOL_WIDTH
OFF_K = OFF_Q + RET_QK_WIDTH
OFF_V = OFF_K + RET_QK_WIDTH
OFF_G = OFF_V + RET_V_WIDTH
OFF_GATE_POOL = OFF_G + RET_V_WIDTH
OFF_GATE_RET = OFF_GATE_POOL + D_MODEL
IN_WIDTH = OFF_GATE_RET + D_MODEL
D_FF = 2816
N_EXPERTS = 8
TOP_K = 2
EXPERT_FF = 3584
MOE_BLOCK = 256
N_DENSE = (DEPTH + 1) // 2
N_MOE = DEPTH // 2
DEEPNORM_ALPHA = (2 * DEPTH) ** 0.25
DEEPNORM_BETA = (8 * DEPTH) ** -0.25
LN_EPS = 1e-5

kernel_name = 'hybrid_pool_retention_moe_dit'


def _layer_norm(x, g, b):
    xf = x.astype(jnp.float32)
    xc = xf - jnp.mean(xf, -1, keepdims=True)
    var = jnp.mean(xc * xc, -1, keepdims=True)
    return (xc * lax.rsqrt(var + LN_EPS) * g + b).astype(x.dtype)


def _box_mean(u, axis, w):
    n = u.shape[axis]
    left = w // 2
    right = w - 1 - left
    cs = jnp.cumsum(u.astype(jnp.float32), axis=axis)
    pad = [(0, 0)] * u.ndim
    pad[axis] = (1, 0)
    cs = jnp.pad(cs, pad)
    t = jnp.arange(n)
    hi = jnp.minimum(t + right + 1, n)
    lo = jnp.maximum(t - left, 0)
    shape = [1] * u.ndim
    shape[axis] = n
    cnt = (hi - lo).astype(jnp.float32).reshape(shape)
    return ((jnp.take(cs, hi, axis=axis) - jnp.take(cs, lo, axis=axis)) / cnt).astype(u.dtype)


def _pool_mixer(u, rows, w_group, scale):
    B, T, _ = u.shape
    ug = u.reshape(B, T, len(POOL_WINDOWS), POOL_GROUP)
    pooled = []
    for gi, w in enumerate(POOL_WINDOWS):
        g = ug[:, :, gi]
        if rows is None:
            p = _box_mean(g, 1, w)
        else:
            gg = g.reshape(B, rows, GRID_W, POOL_GROUP)
            p = _box_mean(_box_mean(gg, 1, w), 2, w).reshape(B, T, POOL_GROUP)
        pooled.append(p)
    d = jnp.stack(pooled, axis=2) - ug
    y = jnp.einsum('btgc,gcd->btgd', d, w_group).reshape(B, T, POOL_WIDTH)
    return y * scale


def _grid_rope(n_tokens):
    t = jnp.arange(n_tokens)
    row = (t // GRID_W).astype(jnp.float32)
    col = (t % GRID_W).astype(jnp.float32)
    n_freq = RET_QK_DIM // 4
    inv = jnp.exp(-jnp.log(ROPE_BASE) * jnp.arange(n_freq, dtype=jnp.float32) / n_freq)
    ang = jnp.concatenate([row[:, None] * inv, col[:, None] * inv], -1)
    return jnp.cos(ang), jnp.sin(ang)


def _rotate(t, cos, sin):
    half = t.shape[-1] // 2
    t1, t2 = t[..., :half], t[..., half:]
    c = cos[None, :, None, :]
    s = sin[None, :, None, :]
    return jnp.concatenate([t1 * c - t2 * s, t1 * s + t2 * c], -1).astype(t.dtype)


def _heads(t, d):
    B, T, _ = t.shape
    return t.reshape(B, T, RET_HEADS, d)


def _seq_flip(t, rev):
    return jnp.flip(t, axis=2) if rev else t


def _chunk_retention(q, k, v, log_gamma, state0):
    B, H, T, _ = q.shape
    dv = v.shape[-1]
    C = RET_CHUNK
    n = T // C
    f32 = jnp.float32
    pos = jnp.arange(C, dtype=f32)
    lg = log_gamma[:, None]
    diff = pos[:, None] - pos[None, :]
    inner = jnp.where(diff >= 0, jnp.exp(lg[:, :, None] * jnp.maximum(diff, 0.0)), 0.0)
    q_dec = jnp.exp(lg * (pos + 1.0))[:, :, None]
    k_dec = jnp.exp(lg * (C - 1.0 - pos))[:, :, None]
    c_dec = jnp.exp(log_gamma * C)[:, None, None]

    def chunks(t):
        return t.astype(f32).reshape(B, H, n, C, t.shape[-1]).transpose(2, 0, 1, 3, 4)

    def step(s, blk):
        qb, kb, vb = blk
        scores = jnp.einsum('bhid,bhjd->bhij', qb, kb) * inner
        o = jnp.einsum('bhij,bhjv->bhiv', scores, vb) + jnp.einsum('bhid,bhdv->bhiv', qb * q_dec, s)
        s = s * c_dec + jnp.einsum('bhjd,bhjv->bhdv', kb * k_dec, vb)
        return s, o

    s, o = lax.scan(step, state0, (chunks(q), chunks(k), chunks(v)))
    return o.transpose(1, 2, 0, 3, 4).reshape(B, H, T, dv), s


def _final_state(k, v, log_gamma):
    T = k.shape[2]
    w = jnp.exp(log_gamma[:, None] * (T - 1.0 - jnp.arange(T, dtype=jnp.float32)))
    return jnp.einsum('bhtd,bhtv->bhdv', k.astype(jnp.float32) * w[None, :, :, None], v.astype(jnp.float32))


def _head_norm(o, dtype):
    oc = o - jnp.mean(o, -1, keepdims=True)
    var = jnp.mean(oc * oc, -1, keepdims=True)
    on = oc * lax.rsqrt(var + LN_EPS)
    B, H, T, dv = o.shape
    return on.transpose(0, 2, 1, 3).reshape(B, T, H * dv).astype(dtype)


def _token_mixer(h, hc, cos, sin, rows, w_in, pool_w, pool_scale, w_pool_out,
                 w_ret_out, decay_logit, w_out, need_ctx):
    B = h.shape[0]
    log_gamma = jax.nn.log_sigmoid(decay_logit.astype(jnp.float32))
    k_scale = RET_QK_DIM ** -0.5

    p = h @ w_in
    q = _rotate(_heads(p[..., OFF_Q:OFF_K], RET_QK_DIM), cos, sin).transpose(0, 2, 1, 3)
    k = (_rotate(_heads(p[..., OFF_K:OFF_V], RET_QK_DIM), cos, sin) * k_scale).transpose(0, 2, 1, 3)
    v = _heads(p[..., OFF_V:OFF_G], RET_V_DIM).transpose(0, 2, 1, 3)
    if need_ctx:
        pc = hc @ w_in
        qc = _heads(pc[..., OFF_Q:OFF_K], RET_QK_DIM).transpose(0, 2, 1, 3)
        kc_src = pc[..., OFF_K:OFF_V]
        vc_src = pc[..., OFF_V:OFF_G]
    else:
        pc_kv = hc @ w_in[:, OFF_K:OFF_G]
        kc_src = pc_kv[..., :RET_QK_WIDTH]
        vc_src = pc_kv[..., RET_QK_WIDTH:]
    kc = (_heads(kc_src, RET_QK_DIM) * k_scale).transpose(0, 2, 1, 3)
    vc = _heads(vc_src, RET_V_DIM).transpose(0, 2, 1, 3)

    zero_state = jnp.zeros((B, RET_HEADS, RET_QK_DIM, RET_V_DIM), jnp.float32)
    o_lat = 0.0
    o_ctx = 0.0
    for d in range(2):
        rev = d == 1
        if need_ctx:
            oc, s = _chunk_retention(_seq_flip(qc, rev), _seq_flip(kc, rev), _seq_flip(vc, rev),
                                     log_gamma[d], zero_state)
            o_ctx = o_ctx + _seq_flip(oc, rev)
        else:
            s = _final_state(_seq_flip(kc, rev), _seq_flip(vc, rev), log_gamma[d])
        ol, _ = _chunk_retention(_seq_flip(q, rev), _seq_flip(k, rev), _seq_flip(v, rev), log_gamma[d], s)
        o_lat = o_lat + _seq_flip(ol, rev)

    def merge(pz, o, grid_rows):
        y_pool = _pool_mixer(pz[..., :OFF_Q], grid_rows, pool_w, pool_scale) @ w_pool_out
        y_ret = (jax.nn.silu(pz[..., OFF_G:OFF_GATE_POOL]) * _head_norm(o, pz.dtype)) @ w_ret_out
        mix = (jax.nn.sigmoid(pz[..., OFF_GATE_POOL:OFF_GATE_RET]) * y_pool
               + jax.nn.sigmoid(pz[..., OFF_GATE_RET:]) * y_ret)
        return mix @ w_out

    y = merge(p, o_lat, rows)
    yc = merge(pc, o_ctx, None) if need_ctx else None
    return y, yc


def _swiglu(t, w1, w3, w2):
    return (jax.nn.silu(t @ w1) * (t @ w3)) @ w2


def _moe_swiglu(t, w_router, w1, w3, w2):
    N, D = t.shape
    logits = (t @ w_router).astype(jnp.float32)
    top_logit, top_idx = lax.top_k(logits, TOP_K)
    top_w = jax.nn.softmax(top_logit, axis=-1)
    n_assign = N * TOP_K
    flat_e = top_idx.reshape(-1).astype(jnp.int32)
    flat_tok = jnp.arange(n_assign, dtype=jnp.int32) // TOP_K
    flat_w = top_w.reshape(-1)
    order = jnp.argsort(flat_e, stable=True)
    se = flat_e[order]
    counts = jax.ops.segment_sum(jnp.ones_like(flat_e), flat_e, num_segments=N_EXPERTS)
    padded = (counts + MOE_BLOCK - 1) // MOE_BLOCK * MOE_BLOCK
    pad_end = jnp.cumsum(padded)
    pad_start = pad_end - padded
    start = jnp.cumsum(counts) - counts
    dest = pad_start[se] + (jnp.arange(n_assign, dtype=jnp.int32) - start[se])
    n_blocks = (n_assign + MOE_BLOCK - 1) // MOE_BLOCK + N_EXPERTS
    n_rows = n_blocks * MOE_BLOCK
    row_tok = jnp.full((n_rows,), N, jnp.int32).at[dest].set(flat_tok[order])
    row_w = jnp.zeros((n_rows,), jnp.float32).at[dest].set(flat_w[order])
    block_start = jnp.arange(n_blocks, dtype=jnp.int32) * MOE_BLOCK
    block_e = jnp.minimum(jnp.searchsorted(pad_end, block_start, side='right'), N_EXPERTS - 1)
    t_pad = jnp.concatenate([t, jnp.zeros((1, D), t.dtype)], 0)

    def expert_block(args):
        tok, e = args
        xb = t_pad[tok]
        return (jax.nn.silu(xb @ w1[e]) * (xb @ w3[e])) @ w2[e]

    y = lax.map(expert_block, (row_tok.reshape(n_blocks, MOE_BLOCK), block_e))
    y = y.reshape(n_rows, D) * row_w[:, None].astype(y.dtype)
    return jax.ops.segment_sum(y, row_tok, num_segments=N + 1)[:N]


def setup_inputs(seed: int = 0) -> dict:
    key = jax.random.key(seed)
    ks = jax.random.split(key, 24)
    f32 = jnp.float32
    D = D_MODEL

    def nrm(k, shape, s):
        return jax.random.normal(k, shape, f32) * s

    base_logit = jnp.log(2.0 ** (5.0 + jnp.arange(RET_HEADS, dtype=f32)) - 1.0)
    return {
        'x': nrm(ks[0], (BATCH, SEQ, D), 1.0),
        'c': nrm(ks[1], (BATCH, D), 1.0),
        'ctx': nrm(ks[2], (BATCH, CTX_LEN, D), 1.0),
        'c_ctx': nrm(ks[3], (D,), 1.0),
        'ada_w': nrm(ks[4], (DEPTH, D, 6 * D), 0.5 * D ** -0.5),
        'ada_b': nrm(ks[5], (DEPTH, 6 * D), 0.01),
        'w_in': nrm(ks[6], (DEPTH, D, IN_WIDTH), D ** -0.5),
        'pool_w': nrm(ks[7], (DEPTH, len(POOL_WINDOWS), POOL_GROUP, POOL_GROUP), POOL_GROUP ** -0.5),
        'pool_scale': 1.0 + nrm(ks[8], (DEPTH, POOL_WIDTH), 0.02),
        'w_pool_out': nrm(ks[9], (DEPTH, POOL_WIDTH, D), POOL_WIDTH ** -0.5),
        'w_ret_out': nrm(ks[10], (DEPTH, RET_V_WIDTH, D), RET_V_WIDTH ** -0.5),
        'ret_decay_logit': base_logit + nrm(ks[11], (DEPTH, 2, RET_HEADS), 0.05),
        'w_out': nrm(ks[12], (DEPTH, D, D), DEEPNORM_BETA * D ** -0.5),
        'ln_mix_g': 1.0 + nrm(ks[13], (DEPTH, D), 0.02),
        'ln_mix_b': nrm(ks[14], (DEPTH, D), 0.01),
        'ln_ffn_g': 1.0 + nrm(ks[15], (DEPTH, D), 0.02),
        'ln_ffn_b': nrm(ks[16], (DEPTH, D), 0.01),
        'ffn_w1': nrm(ks[17], (N_DENSE, D, D_FF), D ** -0.5),
        'ffn_w3': nrm(ks[18], (N_DENSE, D, D_FF), D ** -0.5),
        'ffn_w2': nrm(ks[19], (N_DENSE, D_FF, D), DEEPNORM_BETA * D_FF ** -0.5),
        'moe_router': nrm(ks[20], (N_MOE, D, N_EXPERTS), D ** -0.5),
        'moe_w1': nrm(ks[21], (N_MOE, N_EXPERTS, D, EXPERT_FF), D ** -0.5),
        'moe_w3': nrm(ks[22], (N_MOE, N_EXPERTS, D, EXPERT_FF), D ** -0.5),
        'moe_w2': nrm(ks[23], (N_MOE, N_EXPERTS, EXPERT_FF, D), DEEPNORM_BETA * EXPERT_FF ** -0.5),
    }


def reference(x, c, ctx, c_ctx, ada_w, ada_b, w_in, pool_w, pool_scale, w_pool_out, w_ret_out,
              ret_decay_logit, w_out, ln_mix_g, ln_mix_b, ln_ffn_g, ln_ffn_b, ffn_w1, ffn_w3, ffn_w2,
              moe_router, moe_w1, moe_w3, moe_w2):
    B, L, D = x.shape
    rows = L // GRID_W
    n_ctx = ctx.shape[1]
    n_lat = B * L
    cos, sin = _grid_rope(L)
    s_lat = jax.nn.silu(c)
    s_ctx = jax.nn.silu(c_ctx)
    for l in range(DEPTH):
        need_ctx = l < DEPTH - 1
        mod = jnp.split((s_lat @ ada_w[l] + ada_b[l])[:, None, :], 6, axis=-1)
        mod_c = jnp.split(s_ctx @ ada_w[l] + ada_b[l], 6, axis=-1)

        h = x * (1.0 + mod[1]) + mod[0]
        hc = ctx * (1.0 + mod_c[1]) + mod_c[0]
        y, yc = _token_mixer(h, hc, cos, sin, rows, w_in[l], pool_w[l], pool_scale[l], w_pool_out[l],
                             w_ret_out[l], ret_decay_logit[l], w_out[l], need_ctx)
        x = _layer_norm(DEEPNORM_ALPHA * x + mod[2] * y, ln_mix_g[l], ln_mix_b[l])
        h = x * (1.0 + mod[4]) + mod[3]
        if need_ctx:
            ctx = _layer_norm(DEEPNORM_ALPHA * ctx + mod_c[2] * yc, ln_mix_g[l], ln_mix_b[l])
            hc = ctx * (1.0 + mod_c[4]) + mod_c[3]
            tokens = jnp.concatenate([h.reshape(-1, D), hc.reshape(-1, D)], 0)
        else:
            tokens = h.reshape(-1, D)

        if l % 2 == 0:
            f = _swiglu(tokens, ffn_w1[l // 2], ffn_w3[l // 2], ffn_w2[l // 2])
        else:
            f = _moe_swiglu(tokens, moe_router[l // 2], moe_w1[l // 2], moe_w3[l // 2], moe_w2[l // 2])
        x = _layer_norm(DEEPNORM_ALPHA * x + mod[5] * f[:n_lat].reshape(B, L, D), ln_ffn_g[l], ln_ffn_b[l])
        if need_ctx:
            ctx = _layer_norm(DEEPNORM_ALPHA * ctx + mod_c[5] * f[n_lat:].reshape(B, n_ctx, D),
                              ln_ffn_g[l], ln_ffn_b[l])
    return x
```

```cpp
#include <hip/hip_runtime.h>
#include <stdint.h>
#include <cstdio>

#define MAXPH NPH
#ifndef MK_MULTI
#define MK_MULTI 1
#endif
#ifndef MK_CHECK
#define MK_CHECK 0
#endif

#define DEVINL __device__ __forceinline__
#define LAS __attribute__((address_space(3)))
typedef unsigned short bf16_t;
typedef short bf16x8 __attribute__((ext_vector_type(8)));
typedef short v4i16_t __attribute__((ext_vector_type(4)));
typedef float f32x4 __attribute__((ext_vector_type(4)));
typedef unsigned u32x4 __attribute__((ext_vector_type(4)));
typedef unsigned u32x2 __attribute__((ext_vector_type(2)));

constexpr int D = 1024, BATCH = 16, SEQ = 4096, DEPTH = 4, CTXL = 256, GRIDW = 64;
constexpr int NLAT = BATCH * SEQ, NCTX = BATCH * CTXL, T = NLAT + NCTX;
constexpr int INW = 5632, DFF = 2816, NEXP = 8, EFF = 3584;
constexpr int MAXRB = 552;
constexpr int RBG = 128;
constexpr int NGRP = 5;
constexpr float ALPHA = 1.6817928305074290f;
constexpr float LN_EPS = 1e-5f;
constexpr float KSCALE = 0.08838834764831845f;

constexpr size_t AL(size_t x) { return (x + 255) & ~(size_t)255; }
constexpr size_t U = (size_t)T * 1024 * 2;
constexpr size_t WS_CTL = 0;
constexpr size_t CTL_BYTES = 65536;
constexpr size_t WS_MOD = WS_CTL + CTL_BYTES;
constexpr size_t WS_ROPE = AL(WS_MOD + (size_t)4 * 17 * 6144 * 4);
constexpr size_t WS_CTXS = AL(WS_ROPE + (size_t)4096 * 64 * 8);
constexpr size_t WS_TOKE = AL(WS_CTXS + (size_t)NCTX * 1024 * 4);
constexpr size_t WS_TOKW = AL(WS_TOKE + (size_t)T * 8);
constexpr size_t WS_TOKD = AL(WS_TOKW + (size_t)T * 8);
constexpr size_t WS_WGCNT = AL(WS_TOKD + (size_t)T * 8);
constexpr size_t WS_BLKE = AL(WS_WGCNT + 256 * 8 * 4);
constexpr size_t WS_WMIX = AL(WS_BLKE + (MAXRB + 8) * 4);
constexpr size_t WMIX_IN = 0, WMIX_POOL = (size_t)INW * 1024 * 2, WMIX_RET = WMIX_POOL + (size_t)1024 * 512 * 2, WMIX_OUT = WMIX_RET + (size_t)1024 * 1024 * 2, WMIX_BYTES = WMIX_OUT + (size_t)1024 * 1024 * 2;
constexpr size_t WS_A = AL(WS_WMIX + WMIX_BYTES);
constexpr size_t WS_BIG = AL(WS_A + U);
constexpr size_t B_U = 0, B_Q = U / 2, B_K = U, B_V = U + U / 2, B_SG = 2 * U + U / 2, B_GP = 3 * U + U / 2, B_GR = 4 * U + U / 2, B_OF = 5 * U + U / 2, B_OB = 6 * U + U / 2, B_END = 7 * U + U / 2;
constexpr size_t B_URET = B_V, B_Y1 = B_Q, B_MIX = B_OF;
constexpr size_t F_W = 0;
constexpr size_t F_DW2 = (size_t)2 * DFF * 1024 * 2;
constexpr size_t F_EW13 = (size_t)2 * EFF * 1024 * 2, F_EW2 = (size_t)1024 * EFF * 2, F_EALL = (size_t)NEXP * (F_EW13 + F_EW2);
constexpr size_t F_XS = AL(F_EALL);
constexpr size_t F_ACT = AL(F_XS + (size_t)MAXRB * 256 * 1024 * 2);
constexpr size_t F_END_D = F_ACT + (size_t)T * DFF * 2, F_END_M = F_ACT + (size_t)RBG * 256 * EFF * 2;
constexpr size_t WS_END = WS_BIG + B_END;
static_assert(F_END_D <= B_END && F_END_M <= B_END, "FFN stage must fit in BIG");
static_assert(WS_END <= (size_t)1295298688, "workspace budget");

constexpr int CW_BAR = 0;
constexpr int CW_DBG = 4096;

constexpr int LDS_MAIN = 139264;
constexpr int LDS_TAB = LDS_MAIN;
constexpr int LDS_CTL = LDS_MAIN + 1024;
constexpr int LDS_BYTES = LDS_CTL + 256;

DEVINL float bf2f(unsigned b) { return __uint_as_float(b << 16); }
DEVINL float bflo(unsigned w) { return __uint_as_float(w << 16); }
DEVINL float bfhi(unsigned w) { return __uint_as_float(w & 0xffff0000u); }
typedef __bf16 bf16v2_t __attribute__((ext_vector_type(2)));
typedef float f32v2_t __attribute__((ext_vector_type(2)));
DEVINL unsigned pk2(float lo, float hi) { const f32v2_t v = {lo, hi}; return __builtin_bit_cast(unsigned, __builtin_convertvector(v, bf16v2_t)); }
DEVINL bf16_t f2bf(float f) { return (bf16_t)(pk2(f, 0.f) & 0xffffu); }
DEVINL float sigmoidf_(float x) { return 1.0f / (1.0f + __expf(-x)); }
DEVINL float siluf_(float x) { return x / (1.0f + __expf(-x)); }
DEVINL int tid_hidden() { int t = threadIdx.x; asm volatile("" : "+v"(t)); return t; }
DEVINL float wave_sum(float v) {
#pragma unroll
    for (int o = 32; o >= 1; o >>= 1) v += __shfl_xor(v, o, 64);
    return v;
}

#define XB_TMO      128
#define XB_XCNT(j)  (256  + 64 * (j))
#define XB_XSUB(j)  (1280 + 64 * (j))
#define XB_XGEN(j)  (2304 + 64 * (j))
#define XB_TOP      3328
#define XB_TOPGEN   3392
#define XCD_BAR_WORDS 3456
#define XB_SPIN_CAP (1u << 20)
DEVINL unsigned xb_ld(unsigned* p)              { return __hip_atomic_load(p, __ATOMIC_RELAXED, __HIP_MEMORY_SCOPE_AGENT); }
DEVINL unsigned xb_add(unsigned* p, unsigned v) { return __hip_atomic_fetch_add(p, v, __ATOMIC_RELAXED, __HIP_MEMORY_SCOPE_AGENT); }
DEVINL unsigned xb_xcc_id() { return (unsigned)__builtin_amdgcn_s_getreg((3 << 11) | 20) & 0xFu; }
#define XB_SPIN(cond, bar) do { unsigned _sp = 0; while (cond) { __builtin_amdgcn_s_sleep(1); \
    if ((++_sp & 255u) == 0u) { if (xb_ld(&(bar)[XB_TMO])) break; if (_sp > XB_SPIN_CAP) { atomicAdd(&(bar)[XB_TMO], 1u); break; } } } } while (0)
struct XcdBarrier { unsigned* bar; unsigned x; volatile LAS unsigned* st; };
DEVINL XcdBarrier xcd_barrier_post(unsigned* bar, volatile LAS unsigned* st) {
    XcdBarrier b; b.bar = bar; b.x = xb_xcc_id(); b.st = st;
    if (threadIdx.x == 0) (void)xb_add(&bar[XB_XCNT(b.x)], 1u);
    return b;
}
DEVINL void xcd_barrier_complete(unsigned* bar, unsigned x, unsigned& nloc, unsigned& nx) {
    const unsigned G = gridDim.x * gridDim.y * gridDim.z;
    unsigned sum, cnt, mine, sp = 0u;
    for (;;) {
        sum = 0u; cnt = 0u; mine = 0u;
#pragma unroll
        for (unsigned j = 0; j < 16; ++j) { const unsigned c = xb_ld(&bar[XB_XCNT(j)]); sum += c; cnt += (c > 0u) ? 1u : 0u; mine = (j == x) ? c : mine; }
        if (sum == G) break;
        __builtin_amdgcn_s_sleep(1);
        if ((++sp & 255u) == 0u) { if (xb_ld(&bar[XB_TMO])) break; if (sp > XB_SPIN_CAP) { atomicAdd(&bar[XB_TMO], 1u); break; } }
    }
    nloc = mine > 0u ? mine : 1u; nx = cnt > 0u ? cnt : 1u;
}
DEVINL void xcd_barrier(const XcdBarrier& b) {
    asm volatile("s_waitcnt vmcnt(0)" ::: "memory");
    __syncthreads();
    if (threadIdx.x == 0) {
        unsigned* bar = b.bar;
        __builtin_amdgcn_s_waitcnt(0);
        unsigned nloc = b.st[0], nx = b.st[1];
        if (nloc == 0u) { xcd_barrier_complete(bar, b.x, nloc, nx); b.st[0] = nloc; b.st[1] = nx; }
        const unsigned old = xb_add(&bar[XB_XSUB(b.x)], 1u);
        const unsigned gen = old / nloc;
        if (old + 1u == (gen + 1u) * nloc) {
            __builtin_amdgcn_fence(__ATOMIC_RELEASE, "agent");
            asm volatile("s_waitcnt vmcnt(0)" ::: "memory");
            const unsigned og = xb_add(&bar[XB_TOP], 1u);
            const unsigned tg = og / nx;
            if (og + 1u == (tg + 1u) * nx) xb_add(&bar[XB_TOPGEN], 1u);
            else XB_SPIN(xb_ld(&bar[XB_TOPGEN]) == tg, bar);
            __builtin_amdgcn_fence(__ATOMIC_ACQUIRE, "agent");
            xb_add(&bar[XB_XGEN(b.x)], 1u);
            asm volatile("s_waitcnt vmcnt(0)" ::: "memory");
        } else {
            XB_SPIN(xb_ld(&bar[XB_XGEN(b.x)]) == gen, bar);
            __builtin_amdgcn_fence(__ATOMIC_ACQUIRE, "agent");
            asm volatile("s_waitcnt vmcnt(0)" ::: "memory");
        }
    }
    __syncthreads();
}

constexpr int BM = 256, BK = 64, HALF = 128, HTB = HALF * BK * 2, NXCD = 8, WGM = 8;
DEVINL int lds_byte(int r, int c) { const int st = (r >> 4) * 2 + (c >> 5), rr = r & 15, cc = c & 31, ob = rr * 64 + cc * 2; return st * 1024 + (ob ^ (((ob >> 9) & 1) << 5)); }
DEVINL void stage_rc(int b, int& R, int& C) { const int st = b / 1024, sb = b % 1024, swz = sb ^ (((sb >> 9) & 1) << 5); R = (st >> 1) * 16 + swz / 64; C = (st & 1) * 32 + (swz % 64) / 2; }
DEVINL int perm32(int rho) { const int n = rho >> 4, i = rho & 15; return 8 * (i >> 2) + 4 * n + (i & 3); }

struct Unit { int pm, pn; const char* a; const char* b; };

DEVINL bool rect_next(long L, int nM, int nN, int& pm, int& pn) {
    const int nwg = nM * nN; if (L >= nwg) return false;
    int wgid = (int)L; { const int q = nwg / NXCD, r = nwg % NXCD, xcd = wgid % NXCD, off = wgid / NXCD; wgid = (xcd < r ? xcd * (q + 1) : r * (q + 1) + (xcd - r) * q) + off; }
    const int nig = WGM * nN, gid = wgid / nig, fm = gid * WGM, gsz = (nM - fm) < WGM ? (nM - fm) : WGM;
    pm = fm + ((wgid % nig) % gsz); pn = (wgid % nig) / gsz; return true;
}
struct SchedRect {
    const char* A; const char* B; int nM, nN, G, c; size_t tstep;
    DEVINL bool next(int i, Unit& u) const { if (!rect_next((long)i * G + c, nM, nN, u.pm, u.pn)) return false; u.a = A + (size_t)u.pm * tstep; u.b = B + (size_t)u.pn * tstep; return true; }
};
struct SchedIn3 {
    const char* A; const char* B; int G, c; size_t tstep;
    DEVINL bool next(int i, Unit& u) const {
        const long L = (long)i * G + c;
        if (L < 256 * 22) { rect_next(L, 256, 22, u.pm, u.pn); }
        else { const long L2 = L - 256 * 22; if (L2 >= 16 * 6) return false; u.pm = 256 + (int)(L2 / 6); u.pn = 4 + (int)(L2 % 6); }
        u.a = A + (size_t)u.pm * tstep; u.b = B + (size_t)u.pn * tstep; return true; }
};
struct SchedMoe {
    const char* abase; const char* wbase; const int* blke; int rb0, arb0, nrb, nN, G, c; size_t tstep, estride;
    DEVINL bool next(int i, Unit& u) const {
        int pm, pn; if (!rect_next((long)i * G + c, nrb, nN, pm, pn)) return false;
        u.pm = rb0 + pm; u.pn = pn; const int e = blke[8 + u.pm] & 7;
        u.a = abase + (size_t)(u.pm - arb0) * tstep; u.b = wbase + (size_t)e * estride + (size_t)pn * tstep; return true; }
};

template <class Epi, class Sched>
DEVINL void gemm_phase(LAS unsigned char* lds, const int K, const Sched& S, const Epi& E) {
    int tid = threadIdx.x; asm volatile("" : "+v"(tid));
    const int wid = __builtin_amdgcn_readfirstlane(tid >> 6), lane = tid & 63, wr = wid >> 2, wc = wid & 3, fr = lane & 15, fq = lane >> 4;
    const int nt = K / BK;
    unsigned voffA[2], voffB[2];
#pragma unroll
    for (int i = 0; i < 2; ++i) { int R, C; stage_rc(tid * 16 + i * 8192, R, C); const int Rb = Epi::PERM ? ((R & ~31) + perm32(R & 31)) : R;
        voffA[i] = (unsigned)(R * K + C) * 2u; voffB[i] = (unsigned)(Rb * K + C) * 2u; }
    const size_t kstep = (size_t)(BK * 2);
    const size_t hstep = (size_t)HALF * K * 2;
    const unsigned ldsw = (unsigned)wid * 1024u;
    const int aoff = lds_byte(wr * 64 + fr, fq * 8), boff = lds_byte(wc * 32 + fr, fq * 8);
#define PG8_SA(b, h) (((b) * 2 + (h)) * HTB)
#define PG8_SB(b, h) ((4 + (b) * 2 + (h)) * HTB)
#define PG8_STAGE(bufoff, gbase, voff) do { _Pragma("unroll") for (int _i = 0; _i < 2; ++_i) \
        __builtin_amdgcn_global_load_lds((const unsigned*)((const char*)(gbase) + (voff)[_i]), (LAS unsigned*)(lds + (bufoff) + ldsw + _i * 8192), 16, 0, 0); } while (0)
#define PG8_LDA(dst, b, h) do { _Pragma("unroll") for (int m = 0; m < 4; ++m) _Pragma("unroll") for (int k = 0; k < 2; ++k) dst[m][k] = *(const LAS bf16x8*)(lds + PG8_SA(b, h) + aoff + m * 2048 + k * 1024); } while (0)
#define PG8_LDB(dst, b, h) do { _Pragma("unroll") for (int n = 0; n < 2; ++n) _Pragma("unroll") for (int k = 0; k < 2; ++k) dst[n][k] = *(const LAS bf16x8*)(lds + PG8_SB(b, h) + boff + n * 2048 + k * 1024); } while (0)
#define PG8_MMA(ai, bj, At, Bt) do { __builtin_amdgcn_s_setprio(1); _Pragma("unroll") for (int m = 0; m < 4; ++m) _Pragma("unroll") for (int n = 0; n < 2; ++n) _Pragma("unroll") for (int k = 0; k < 2; ++k) \
        acc[ai][bj][m][n] = __builtin_amdgcn_mfma_f32_16x16x32_bf16(Bt[n][k], At[m][k], acc[ai][bj][m][n], 0, 0, 0); __builtin_amdgcn_s_setprio(0); } while (0)
#define PG8_WAIT_V(n) asm volatile("s_waitcnt vmcnt(" #n ")" ::: "memory")
#define PG8_WAIT_L(n) asm volatile("s_waitcnt lgkmcnt(" #n ")" ::: "memory")
#define PG8_BAR __builtin_amdgcn_s_barrier()
#define PG8_SCHED __builtin_amdgcn_sched_barrier(0)
    Unit cur, nxt; int ui = 0;
    if (!S.next(0, cur)) return;
    f32x4 acc[2][2][4][2];
#pragma unroll
    for (int a = 0; a < 2; ++a)
#pragma unroll
        for (int b = 0; b < 2; ++b)
#pragma unroll
            for (int m = 0; m < 4; ++m)
#pragma unroll
                for (int n = 0; n < 2; ++n) acc[a][b][m][n] = (f32x4){0.f, 0.f, 0.f, 0.f};
    bf16x8 At[4][2], B0[2][2], B1[2][2];
    const char* cA = cur.a; const char* cB = cur.b;
    PG8_STAGE(PG8_SB(0, 0), cB, voffB); PG8_STAGE(PG8_SA(0, 0), cA, voffA); PG8_STAGE(PG8_SB(0, 1), cB + hstep, voffB); PG8_STAGE(PG8_SA(0, 1), cA + hstep, voffA);
    if (wr == 1) PG8_BAR;
    PG8_WAIT_V(4); PG8_BAR;
    PG8_STAGE(PG8_SB(1, 0), cB + kstep, voffB); PG8_STAGE(PG8_SA(1, 0), cA + kstep, voffA); PG8_STAGE(PG8_SB(1, 1), cB + hstep + kstep, voffB);
    PG8_WAIT_V(6); PG8_BAR;
    for (;;) {
        const bool has_next = S.next(ui + 1, nxt);
        const char* nA = has_next ? nxt.a : cA; const char* nB = has_next ? nxt.b : cB;
        for (int t = 0; t < nt; t += 2) {
            const bool last = (t == nt - 2);
            const char* a1 = cA + (size_t)(t + 1) * kstep;
            const char* a2 = last ? nA : cA + (size_t)(t + 2) * kstep; const char* b2 = last ? nB : cB + (size_t)(t + 2) * kstep;
            const char* a3 = a2 + kstep; const char* b3 = b2 + kstep;
            PG8_LDB(B0, 0, 0); PG8_SCHED; PG8_LDA(At, 0, 0); PG8_STAGE(PG8_SA(1, 1), a1 + hstep, voffA);
            PG8_WAIT_L(8); PG8_BAR; PG8_WAIT_L(0); PG8_MMA(0, 0, At, B0); PG8_BAR; PG8_SCHED;
            PG8_LDB(B1, 0, 1); PG8_STAGE(PG8_SB(0, 0), b2, voffB);
            PG8_BAR; PG8_WAIT_L(0); PG8_MMA(0, 1, At, B1); PG8_BAR;
            PG8_LDA(At, 0, 1); PG8_STAGE(PG8_SA(0, 0), a2, voffA);
            PG8_BAR; PG8_WAIT_L(0); PG8_MMA(1, 0, At, B0); PG8_BAR; PG8_SCHED;
            PG8_STAGE(PG8_SB(0, 1), b2 + hstep, voffB);
            PG8_WAIT_V(6); PG8_BAR; PG8_MMA(1, 1, At, B1); PG8_BAR;
            PG8_LDB(B0, 1, 0); PG8_SCHED; PG8_LDA(At, 1, 0); PG8_STAGE(PG8_SA(0, 1), a2 + hstep, voffA);
            PG8_WAIT_L(8); PG8_BAR; PG8_WAIT_L(0); PG8_MMA(0, 0, At, B0); PG8_BAR; PG8_SCHED;
            PG8_LDB(B1, 1, 1); PG8_STAGE(PG8_SB(1, 0), b3, voffB);
            PG8_BAR; PG8_WAIT_L(0); PG8_MMA(0, 1, At, B1); PG8_BAR;
            PG8_LDA(At, 1, 1); PG8_STAGE(PG8_SA(1, 0), a3, voffA);
            PG8_BAR; PG8_WAIT_L(0); PG8_MMA(1, 0, At, B0); PG8_BAR; PG8_SCHED;
            PG8_STAGE(PG8_SB(1, 1), b3 + hstep, voffB);
            PG8_WAIT_V(6); PG8_BAR; PG8_MMA(1, 1, At, B1); PG8_BAR;
        }
        E(acc, cur, wr, wc, fr, fq);
        if (!has_next) break;
#pragma unroll
        for (int a = 0; a < 2; ++a)
#pragma unroll
            for (int b = 0; b < 2; ++b)
#pragma unroll
                for (int m = 0; m < 4; ++m)
#pragma unroll
                    for (int n = 0; n < 2; ++n) acc[a][b][m][n] = (f32x4){0.f, 0.f, 0.f, 0.f};
        cur = nxt; cA = nA; cB = nB; ++ui;
    }
    PG8_WAIT_V(0);
    if (wr == 0) PG8_BAR;
    PG8_BAR;
#undef PG8_SA
#undef PG8_SB
#undef PG8_STAGE
#undef PG8_LDA
#undef PG8_LDB
#undef PG8_MMA
#undef PG8_WAIT_V
#undef PG8_WAIT_L
#undef PG8_BAR
#undef PG8_SCHED
}

typedef const f32x4 (&AccRef)[2][2][4][2];

struct EpiIn {
    static constexpr bool PERM = true;
    bf16_t* big; const float* rope;
    DEVINL void operator()(AccRef acc, const Unit& u, int wr, int wc, int fr, int fq) const {
        const int pn = u.pn; bf16_t* dst; int ldc, colt, kind;
        if (pn < 2)       { dst = (bf16_t*)((char*)big + B_U);  ldc = 512;  colt = pn * 256;        kind = 0; }
        else if (pn < 4)  { dst = (bf16_t*)((char*)big + B_Q);  ldc = 512;  colt = (pn - 2) * 256;  kind = 1; }
        else if (pn < 6)  { dst = (bf16_t*)((char*)big + B_K);  ldc = 512;  colt = (pn - 4) * 256;  kind = 2; }
        else if (pn < 10) { dst = (bf16_t*)((char*)big + B_V);  ldc = 1024; colt = (pn - 6) * 256;  kind = 0; }
        else if (pn < 14) { dst = (bf16_t*)((char*)big + B_SG); ldc = 1024; colt = (pn - 10) * 256; kind = 3; }
        else if (pn < 18) { dst = (bf16_t*)((char*)big + B_GP); ldc = 1024; colt = (pn - 14) * 256; kind = 4; }
        else              { dst = (bf16_t*)((char*)big + B_GR); ldc = 1024; colt = (pn - 18) * 256; kind = 4; }
        const int row0 = u.pm * BM + wr * 64 + fr, col0 = colt + wc * 32 + 8 * fq;
        const bool lat = u.pm < 256;
        const float ks = (kind == 2) ? KSCALE : 1.0f;
#pragma unroll
        for (int ai = 0; ai < 2; ++ai)
#pragma unroll
            for (int m = 0; m < 4; ++m) {
                const int row = row0 + ai * HALF + m * 16;
                bf16_t* rowp = dst + (size_t)row * ldc + col0;
                f32x4 cs0 = (f32x4){1.f, 0.f, 1.f, 0.f}, cs1 = cs0;
                if ((kind == 1 || kind == 2) && lat) { const float* rp = rope + ((size_t)(row & 4095) * 64 + wc * 16 + 4 * fq) * 2; cs0 = *(const f32x4*)rp; cs1 = *(const f32x4*)(rp + 4); }
#pragma unroll
                for (int bj = 0; bj < 2; ++bj) {
                    f32x4 v0 = acc[ai][bj][m][0], v1 = acc[ai][bj][m][1];
                    if (kind == 1 || kind == 2) {
                        f32x4 r0, r1;
                        r0[0] = (v0[0] * cs0[0] - v0[1] * cs0[1]) * ks; r0[1] = (v0[0] * cs0[1] + v0[1] * cs0[0]) * ks;
                        r0[2] = (v0[2] * cs0[2] - v0[3] * cs0[3]) * ks; r0[3] = (v0[2] * cs0[3] + v0[3] * cs0[2]) * ks;
                        r1[0] = (v1[0] * cs1[0] - v1[1] * cs1[1]) * ks; r1[1] = (v1[0] * cs1[1] + v1[1] * cs1[0]) * ks;
                        r1[2] = (v1[2] * cs1[2] - v1[3] * cs1[3]) * ks; r1[3] = (v1[2] * cs1[3] + v1[3] * cs1[2]) * ks;
                        v0 = r0; v1 = r1;
                    } else if (kind == 3) {
#pragma unroll
                        for (int j = 0; j < 4; ++j) { v0[j] = siluf_(v0[j]); v1[j] = siluf_(v1[j]); }
                    } else if (kind == 4) {
#pragma unroll
                        for (int j = 0; j < 4; ++j) { v0[j] = sigmoidf_(v0[j]); v1[j] = sigmoidf_(v1[j]); }
                    }
                    u32x4 w; w.x = pk2(v0[0], v0[1]); w.y = pk2(v0[2], v0[3]); w.z = pk2(v1[0], v1[1]); w.w = pk2(v1[2], v1[3]);
                    *(u32x4*)(rowp + bj * HALF) = w;
                }
                asm volatile("" ::: "memory");
            }
    }
};

template <int MODE  > struct EpiGate {
    static constexpr bool PERM = true;
    bf16_t* out; const bf16_t* gate; const bf16_t* y1;
    DEVINL void operator()(AccRef acc, const Unit& u, int wr, int wc, int fr, int fq) const {
        const int row0 = u.pm * BM + wr * 64 + fr, col0 = u.pn * BM + wc * 32 + 8 * fq;
#pragma unroll
        for (int ai = 0; ai < 2; ++ai)
#pragma unroll
            for (int m = 0; m < 4; ++m) {
                const size_t off = (size_t)(row0 + ai * HALF + m * 16) * 1024 + col0;
#pragma unroll
                for (int bj = 0; bj < 2; ++bj) {
                    f32x4 v0 = acc[ai][bj][m][0], v1 = acc[ai][bj][m][1];
                    if (MODE != 2) {
                        const u32x4 g = *(const u32x4*)(gate + off + bj * HALF);
                        v0[0] *= bflo(g.x); v0[1] *= bfhi(g.x); v0[2] *= bflo(g.y); v0[3] *= bfhi(g.y);
                        v1[0] *= bflo(g.z); v1[1] *= bfhi(g.z); v1[2] *= bflo(g.w); v1[3] *= bfhi(g.w);
                    }
                    if (MODE == 1) {
                        const u32x4 y = *(const u32x4*)(y1 + off + bj * HALF);
                        v0[0] += bflo(y.x); v0[1] += bfhi(y.x); v0[2] += bflo(y.y); v0[3] += bfhi(y.y);
                        v1[0] += bflo(y.z); v1[1] += bfhi(y.z); v1[2] += bflo(y.w); v1[3] += bfhi(y.w);
                    }
                    u32x4 w; w.x = pk2(v0[0], v0[1]); w.y = pk2(v0[2], v0[3]); w.z = pk2(v1[0], v1[1]); w.w = pk2(v1[2], v1[3]);
                    *(u32x4*)(out + off + bj * HALF) = w;
                }
            }
    }
};

struct EpiRes {
    static constexpr bool PERM = false;
    const float* xin_lat; const float* xin_ctx; float* out_lat; float* out_ctx; const float* modl; int which;
    DEVINL void operator()(AccRef acc, const Unit& u, int wr, int wc, int fr, int fq) const {
        const bool lat = u.pm < 256;
        const int rb = lat ? u.pm * BM : u.pm * BM - NLAT;
        const float* xin = lat ? xin_lat : xin_ctx; float* out = lat ? out_lat : out_ctx;
        const float* mv = modl + ((size_t)(lat ? (u.pm >> 4) : 16) * 6 + which) * 1024;
        const int row0 = rb + wr * 64 + fr, col0 = u.pn * BM + wc * 32 + 4 * fq;
        f32x4 bv[2][2];
#pragma unroll
        for (int bj = 0; bj < 2; ++bj)
#pragma unroll
            for (int n = 0; n < 2; ++n) bv[bj][n] = *(const f32x4*)(mv + col0 + bj * HALF + n * 16);
#pragma unroll
        for (int ai = 0; ai < 2; ++ai)
#pragma unroll
            for (int m = 0; m < 4; ++m) {
                const size_t off = (size_t)(row0 + ai * HALF + m * 16) * 1024 + col0;
#pragma unroll
                for (int bj = 0; bj < 2; ++bj)
#pragma unroll
                    for (int n = 0; n < 2; ++n) {
                        const f32x4 xv = *(const f32x4*)(xin + off + bj * HALF + n * 16);
                        *(f32x4*)(out + off + bj * HALF + n * 16) = xv * ALPHA + bv[bj][n] * acc[ai][bj][m][n];
                    }
            }
    }
};

struct EpiSwiglu {
    static constexpr bool PERM = true;
    bf16_t* act; int ldc; int rb0;
    DEVINL void operator()(AccRef acc, const Unit& u, int wr, int wc, int fr, int fq) const {
        const int row0 = (u.pm - rb0) * BM + wr * 64 + fr, col0 = u.pn * HALF + wc * 32 + 8 * fq;
#pragma unroll
        for (int ai = 0; ai < 2; ++ai)
#pragma unroll
            for (int m = 0; m < 4; ++m) {
                const f32x4 a0 = acc[ai][0][m][0], a1 = acc[ai][0][m][1], b0 = acc[ai][1][m][0], b1 = acc[ai][1][m][1];
                f32x4 v0, v1;
#pragma unroll
                for (int j = 0; j < 4; ++j) { v0[j] = siluf_(a0[j]) * b0[j]; v1[j] = siluf_(a1[j]) * b1[j]; }
                u32x4 w; w.x = pk2(v0[0], v0[1]); w.y = pk2(v0[2], v0[3]); w.z = pk2(v1[0], v1[1]); w.w = pk2(v1[2], v1[3]);
                *(u32x4*)(act + (size_t)(row0 + ai * HALF + m * 16) * ldc + col0) = w;
            }
    }
};

struct Params { const float* in[24]; float* out; unsigned char* ws; int ph_lo, ph_hi; };
enum { I_X = 0, I_C, I_CTX, I_CCTX, I_ADAW, I_ADAB, I_WIN, I_POOLW, I_POOLS, I_WPOOLOUT, I_WRETOUT, I_DECAY, I_WOUT, I_LNMG, I_LNMB, I_LNFG, I_LNFB, I_FW1, I_FW3, I_FW2, I_ROUTER, I_MW1, I_MW3, I_MW2 };

constexpr int PH_PRO_A = 0, PH_PRO_B = 1, PH_L0 = 2, PH_PER_L = 20, NPH = PH_L0 + DEPTH * PH_PER_L;
enum { Q_IN = 0, Q_POOLV, Q_RET, Q_COMB, Q_MIX, Q_OUT, Q_LN1, Q_F0, Q_F1  , Q_LN2 = 18 };

template <class RowMap>
DEVINL void cvt_T(LAS float* tl, const float* __restrict__ src, int K, int N, bf16_t* __restrict__ dst, RowMap rm, int rot) {
    const int tid = tid_hidden(), G = gridDim.x;
    const int tn = N / 64, ntile = (K / 64) * tn;
    for (int tile = (blockIdx.x + rot) % G; tile < ntile; tile += G) {
        const int k0 = (tile / tn) * 64, n0 = (tile % tn) * 64;
        const int r = tid >> 4, c4 = (tid & 15) * 4;
#pragma unroll
        for (int p = 0; p < 2; ++p) {
            const f32x4 v = *(const f32x4*)(src + (size_t)(k0 + r + 32 * p) * N + n0 + c4);
            LAS float* d = tl + (r + 32 * p) * 65 + c4; d[0] = v[0]; d[1] = v[1]; d[2] = v[2]; d[3] = v[3];
        }
        __syncthreads();
        const int nl = tid >> 3, k8 = (tid & 7) * 8;
        float e[8];
#pragma unroll
        for (int j = 0; j < 8; ++j) e[j] = tl[(k8 + j) * 65 + nl];
        u32x4 w; w.x = pk2(e[0], e[1]); w.y = pk2(e[2], e[3]); w.z = pk2(e[4], e[5]); w.w = pk2(e[6], e[7]);
        *(u32x4*)(dst + (size_t)rm(n0 + nl) * K + k0 + k8) = w;
        __syncthreads();
    }
}
struct MapId { DEVINL int operator()(int n) const { return n; } };
struct MapIn { DEVINL int operator()(int n) const { if (n < 512 || n >= 1536) return n; const int j = (n - 512) & 127, base = n - j; return base + (j < 64 ? 2 * j : 2 * (j - 64) + 1); } };
struct MapGU { int off; DEVINL int operator()(int n) const { return (n >> 7) * 256 + (n & 127) + off; } };

DEVINL void convert_mixer_weights(const Params& p, LAS unsigned char* lds, int l) {
    LAS float* tl = (LAS float*)lds;
    unsigned char* wm = p.ws + WS_WMIX;
    cvt_T(tl, p.in[I_WIN] + (size_t)l * 1024 * INW, 1024, INW, (bf16_t*)(wm + WMIX_IN), MapIn(), 0);
    cvt_T(tl, p.in[I_WRETOUT] + (size_t)l * 1024 * 1024, 1024, 1024, (bf16_t*)(wm + WMIX_RET), MapId(), 128);
    cvt_T(tl, p.in[I_WOUT] + (size_t)l * 1024 * 1024, 1024, 1024, (bf16_t*)(wm + WMIX_OUT), MapId(), 0);
    const int tid = tid_hidden(), G = gridDim.x;
    LAS float* sW = (LAS float*)lds;
    LAS float* sP = (LAS float*)(lds + 32768);
    const float* pw = p.in[I_POOLW] + (size_t)l * 4 * 128 * 128; const float* ps = p.in[I_POOLS] + (size_t)l * 512; const float* wo = p.in[I_WPOOLOUT] + (size_t)l * 512 * 1024;
    bf16_t* dst = (bf16_t*)(wm + WMIX_POOL);
    for (int item = (blockIdx.x + 64) % G; item < 64; item += G) {
        const int g = item >> 4, n0 = (item & 15) * 64;
        __syncthreads();
        for (int i = tid; i < 128 * 64; i += 512) { const int d = i >> 6, n = i & 63; sW[i] = ps[g * 128 + d] * wo[(size_t)(g * 128 + d) * 1024 + n0 + n]; }
        for (int i = tid; i < 128 * 128; i += 512) { const int c = i >> 7, d = i & 127; sP[c * 129 + d] = pw[(size_t)g * 16384 + i]; }
        __syncthreads();
        const int n = tid & 63, cq = tid >> 6;
        float a[16];
#pragma unroll
        for (int j = 0; j < 16; ++j) a[j] = 0.f;
        for (int d = 0; d < 128; ++d) { const float w = sW[d * 64 + n];
#pragma unroll
            for (int j = 0; j < 16; ++j) a[j] += sP[(cq * 16 + j) * 129 + d] * w; }
        u32x4 w0, w1; w0.x = pk2(a[0], a[1]); w0.y = pk2(a[2], a[3]); w0.z = pk2(a[4], a[5]); w0.w = pk2(a[6], a[7]);
        w1.x = pk2(a[8], a[9]); w1.y = pk2(a[10], a[11]); w1.z = pk2(a[12], a[13]); w1.w = pk2(a[14], a[15]);
        bf16_t* o = dst + (size_t)(n0 + n) * 512 + g * 128 + cq * 16;
        *(u32x4*)o = w0; *(u32x4*)(o + 8) = w1;
    }
    __syncthreads();
}
DEVINL void convert_ffn_weights(const Params& p, LAS unsigned char* lds, int l) {
    LAS float* tl = (LAS float*)lds;
    unsigned char* fw = p.ws + WS_BIG + F_W;
    const int li = l >> 1;
    if ((l & 1) == 0) {
        cvt_T(tl, p.in[I_FW1] + (size_t)li * 1024 * DFF, 1024, DFF, (bf16_t*)fw, MapGU{0}, 0);
        cvt_T(tl, p.in[I_FW3] + (size_t)li * 1024 * DFF, 1024, DFF, (bf16_t*)fw, MapGU{128}, 64);
        cvt_T(tl, p.in[I_FW2] + (size_t)li * DFF * 1024, DFF, 1024, (bf16_t*)(fw + F_DW2), MapId(), 128);
    } else {
        for (int e = 0; e < NEXP; ++e) {
            const size_t so = ((size_t)li * NEXP + e) * 1024 * EFF;
            cvt_T(tl, p.in[I_MW1] + so, 1024, EFF, (bf16_t*)(fw + (size_t)e * F_EW13), MapGU{0}, e * 32);
            cvt_T(tl, p.in[I_MW3] + so, 1024, EFF, (bf16_t*)(fw + (size_t)e * F_EW13), MapGU{128}, e * 32 + 16);
            cvt_T(tl, p.in[I_MW2] + so, EFF, 1024, (bf16_t*)(fw + (size_t)NEXP * F_EW13 + (size_t)e * F_EW2), MapId(), e * 32 + 8);
        }
    }
}

DEVINL void adaln_phase(const Params& p, LAS unsigned char* lds) {
    const int tid = tid_hidden(), G = gridDim.x;
    LAS float* s = (LAS float*)lds;
    LAS float* red = (LAS float*)(lds + 17 * 1024 * 4);
    for (int i = tid; i < 17 * 1024; i += 512) { const float v = i < 16 * 1024 ? p.in[I_C][i] : p.in[I_CCTX][i - 16 * 1024]; s[i] = v / (1.0f + __expf(-v)); }
    __syncthreads();
    float* mod = (float*)(p.ws + WS_MOD);
    for (int item = blockIdx.x; item < 4 * 96; item += G) {
        const int l = item / 96, n = (item % 96) * 64 + (tid & 63), kq = tid >> 6;
        const float* w = p.in[I_ADAW] + (size_t)l * 1024 * 6144 + n;
        float a[17];
#pragma unroll
        for (int r = 0; r < 17; ++r) a[r] = 0.f;
        for (int k = kq * 128; k < kq * 128 + 128; ++k) { const float wv = w[(size_t)k * 6144];
#pragma unroll
            for (int r = 0; r < 17; ++r) a[r] += s[r * 1024 + k] * wv; }
#pragma unroll
        for (int r = 0; r < 17; ++r) red[(kq * 17 + r) * 64 + (tid & 63)] = a[r];
        __syncthreads();
        for (int i = tid; i < 17 * 64; i += 512) { const int r = i >> 6, c = i & 63; float v = 0.f;
#pragma unroll
            for (int q = 0; q < 8; ++q) v += red[(q * 17 + r) * 64 + c];
            const int nn = (item % 96) * 64 + c; mod[((size_t)l * 17 + r) * 6144 + nn] = v + p.in[I_ADAB][(size_t)l * 6144 + nn]; }
        __syncthreads();
    }
}
DEVINL void rope_phase(const Params& p) {
    float* tab = (float*)(p.ws + WS_ROPE);
    for (int i = blockIdx.x * 512 + tid_hidden(); i < 4096 * 64; i += gridDim.x * 512) {
        const int pos = i >> 6, f = i & 63;
        const float inv = expf(-logf(10000.0f) * (float)(f & 31) / 32.0f);
        const float ang = (float)(f < 32 ? (pos >> 6) : (pos & 63)) * inv;
        float sn, cs; sincosf(ang, &sn, &cs);
        tab[2 * i] = cs; tab[2 * i + 1] = sn;
    }
}

DEVINL const float* row_in(const Params& p, int l, int t) {
    if (l == 0) return t < NLAT ? p.in[I_X] + (size_t)t * 1024 : p.in[I_CTX] + (size_t)(t - NLAT) * 1024;
    return t < NLAT ? p.out + (size_t)t * 1024 : (const float*)(p.ws + WS_CTXS) + (size_t)(t - NLAT) * 1024;
}
DEVINL float* row_st(const Params& p, int t) { return t < NLAT ? p.out + (size_t)t * 1024 : (float*)(p.ws + WS_CTXS) + (size_t)(t - NLAT) * 1024; }
DEVINL const float* mod_row(const Params& p, int l, int t, int which) { const int r = t < NLAT ? (t >> 12) : 16; return (const float*)(p.ws + WS_MOD) + (((size_t)l * 17 + r) * 6 + which) * 1024; }

DEVINL void modulate0_phase(const Params& p) {
    const int tid = tid_hidden(), lane = tid & 63, gw = blockIdx.x * 8 + (tid >> 6), nw = gridDim.x * 8;
    bf16_t* h = (bf16_t*)(p.ws + WS_A);
    for (int t = gw; t < T; t += nw) {
        const float* x = row_in(p, 0, t); const float* sh = mod_row(p, 0, t, 0); const float* sc = mod_row(p, 0, t, 1);
#pragma unroll
        for (int j = 0; j < 4; ++j) { const int c = j * 256 + lane * 4; const f32x4 xv = *(const f32x4*)(x + c), a = *(const f32x4*)(sh + c), b = *(const f32x4*)(sc + c);
            const f32x4 y = xv * (b + 1.0f) + a; u32x2 w; w.x = pk2(y[0], y[1]); w.y = pk2(y[2], y[3]); *(u32x2*)(h + (size_t)t * 1024 + c) = w; }
    }
}

DEVINL void poolv_phase(const Params& p, int Tact) {
    const int tid = tid_hidden(), lane = tid & 63, gw = blockIdx.x * 8 + (tid >> 6), nw = gridDim.x * 8;
    const bf16_t* u = (const bf16_t*)(p.ws + WS_BIG + B_U); bf16_t* vm = (bf16_t*)(p.ws + WS_A);
    for (int idx = gw; idx < Tact * 4; idx += nw) {
        const int t = idx >> 2, g = idx & 3, ch = g * 128 + lane * 2;
        if (t >= NLAT) { *(unsigned*)(vm + (size_t)t * 512 + ch) = *(const unsigned*)(u + (size_t)t * 512 + ch); continue; }
        const int w = 2 << g, left = w >> 1, right = w - 1 - left;
        const int r = (t >> 6) & 63; const int lo = max(r - left, 0), hi = min(r + right, 63);
        float s0 = 0.f, s1 = 0.f;
        for (int rr = lo; rr <= hi; ++rr) { const unsigned v = *(const unsigned*)(u + (size_t)(t + (rr - r) * 64) * 512 + ch); s0 += bflo(v); s1 += bfhi(v); }
        const float inv = 1.0f / (float)(hi - lo + 1);
        *(unsigned*)(vm + (size_t)t * 512 + ch) = pk2(s0 * inv, s1 * inv);
    }
}
DEVINL void poolh_phase(const Params& p, int Tact) {
    const int tid = tid_hidden(), lane = tid & 63, gw = blockIdx.x * 8 + (tid >> 6), nw = gridDim.x * 8;
    bf16_t* u = (bf16_t*)(p.ws + WS_BIG + B_U); const bf16_t* vm = (const bf16_t*)(p.ws + WS_A);
    for (int idx = gw; idx < Tact * 4; idx += nw) {
        const int t = idx >> 2, g = idx & 3, ch = g * 128 + lane * 2;
        const int w = 2 << g, left = w >> 1, right = w - 1 - left;
        const int pos = t < NLAT ? (t & 63) : ((t - NLAT) & 255), last = t < NLAT ? 63 : 255;
        const int lo = max(pos - left, 0), hi = min(pos + right, last);
        float s0 = 0.f, s1 = 0.f;
        for (int cc = lo; cc <= hi; ++cc) { const unsigned v = *(const unsigned*)(vm + (size_t)(t + (cc - pos)) * 512 + ch); s0 += bflo(v); s1 += bfhi(v); }
        const float inv = 1.0f / (float)(hi - lo + 1);
        const unsigned uv = *(const unsigned*)(u + (size_t)t * 512 + ch);
        *(unsigned*)(u + (size_t)t * 512 + ch) = pk2(s0 * inv - bflo(uv), s1 * inv - bfhi(uv));
    }
}
DEVINL void combine_phase(const Params& p, int Tact) {
    const int tid = tid_hidden(), lane = tid & 63, gw = blockIdx.x * 8 + (tid >> 6), nw = gridDim.x * 8;
    const bf16_t* of = (const bf16_t*)(p.ws + WS_BIG + B_OF); const bf16_t* ob = (const bf16_t*)(p.ws + WS_BIG + B_OB); const bf16_t* sg = (const bf16_t*)(p.ws + WS_BIG + B_SG);
    bf16_t* ur = (bf16_t*)(p.ws + WS_BIG + B_URET);
    for (int t = gw; t < Tact; t += nw) {
#pragma unroll
        for (int j = 0; j < 4; ++j) {
            const size_t off = (size_t)t * 1024 + j * 256 + lane * 4;
            const u32x2 a = *(const u32x2*)(of + off), b = *(const u32x2*)(ob + off), g = *(const u32x2*)(sg + off);
            float o[4] = {bflo(a.x) + bflo(b.x), bfhi(a.x) + bfhi(b.x), bflo(a.y) + bflo(b.y), bfhi(a.y) + bfhi(b.y)};
            const float mean = wave_sum(o[0] + o[1] + o[2] + o[3]) * (1.0f / 256.0f);
            float q = 0.f;
#pragma unroll
            for (int e = 0; e < 4; ++e) { o[e] -= mean; q += o[e] * o[e]; }
            const float rstd = rsqrtf(wave_sum(q) * (1.0f / 256.0f) + LN_EPS);
            u32x2 w; w.x = pk2(bflo(g.x) * o[0] * rstd, bfhi(g.x) * o[1] * rstd); w.y = pk2(bflo(g.y) * o[2] * rstd, bfhi(g.y) * o[3] * rstd);
            *(u32x2*)(ur + off) = w;
        }
    }
}

DEVINL void ln1_phase(const Params& p, LAS unsigned char* lds, int l, int Tact) {
    const int tid = tid_hidden(), lane = tid & 63, wv = tid >> 6, G = gridDim.x;
    const bool moe = (l & 1) != 0;
    LAS float* sR = (LAS float*)lds;
    LAS int* sCnt = (LAS int*)(lds + 32768);
    if (moe) { const float* wr = p.in[I_ROUTER] + (size_t)(l >> 1) * 1024 * 8; for (int i = tid; i < 8192; i += 512) sR[i] = wr[i]; if (tid < 8) sCnt[tid] = 0; }
    __syncthreads();
    const float* gam = p.in[I_LNMG] + (size_t)l * 1024; const float* bet = p.in[I_LNMB] + (size_t)l * 1024;
    bf16_t* h2 = (bf16_t*)(p.ws + WS_A);
    int* toke = (int*)(p.ws + WS_TOKE); float* tokw = (float*)(p.ws + WS_TOKW);
    const int per = (Tact + G - 1) / G, t0 = blockIdx.x * per, t1 = min(t0 + per, Tact);
    for (int t = t0 + wv; t < t1; t += 8) {
        float* x = row_st(p, t); const float* sh = mod_row(p, l, t, 3); const float* sc = mod_row(p, l, t, 4);
        f32x4 z[4]; float s = 0.f;
#pragma unroll
        for (int j = 0; j < 4; ++j) { z[j] = *(const f32x4*)(x + j * 256 + lane * 4); s += z[j][0] + z[j][1] + z[j][2] + z[j][3]; }
        const float mean = wave_sum(s) * (1.0f / 1024.0f);
        float q = 0.f;
#pragma unroll
        for (int j = 0; j < 4; ++j) { z[j] -= mean; q += z[j][0] * z[j][0] + z[j][1] * z[j][1] + z[j][2] * z[j][2] + z[j][3] * z[j][3]; }
        const float rstd = rsqrtf(wave_sum(q) * (1.0f / 1024.0f) + LN_EPS);
        float lg[8];
#pragma unroll
        for (int e = 0; e < 8; ++e) lg[e] = 0.f;
#pragma unroll
        for (int j = 0; j < 4; ++j) { const int c = j * 256 + lane * 4;
            const f32x4 xv = z[j] * rstd * *(const f32x4*)(gam + c) + *(const f32x4*)(bet + c);
            *(f32x4*)(x + c) = xv;
            const f32x4 hv = xv * (*(const f32x4*)(sc + c) + 1.0f) + *(const f32x4*)(sh + c);
            u32x2 w; w.x = pk2(hv[0], hv[1]); w.y = pk2(hv[2], hv[3]); *(u32x2*)(h2 + (size_t)t * 1024 + c) = w;
            if (moe) {
#pragma unroll
                for (int i = 0; i < 4; ++i) { const f32x4 r0 = *(const LAS f32x4*)(sR + (c + i) * 8), r1 = *(const LAS f32x4*)(sR + (c + i) * 8 + 4);
                    lg[0] += hv[i] * r0[0]; lg[1] += hv[i] * r0[1]; lg[2] += hv[i] * r0[2]; lg[3] += hv[i] * r0[3];
                    lg[4] += hv[i] * r1[0]; lg[5] += hv[i] * r1[1]; lg[6] += hv[i] * r1[2]; lg[7] += hv[i] * r1[3]; }
            }
        }
        if (moe) {
#pragma unroll
            for (int e = 0; e < 8; ++e) lg[e] = wave_sum(lg[e]);
            int e0 = 0; float m0 = lg[0];
#pragma unroll
            for (int e = 1; e < 8; ++e) if (lg[e] > m0) { m0 = lg[e]; e0 = e; }
            int e1 = -1; float m1 = -3.0e38f;
#pragma unroll
            for (int e = 0; e < 8; ++e) if (e != e0 && lg[e] > m1) { m1 = lg[e]; e1 = e; }
            if (e1 < 0) { e1 = (e0 + 1) & 7; m1 = m0; }
            const float ex = __expf(m1 - m0), w0 = 1.0f / (1.0f + ex), w1 = ex / (1.0f + ex);
            if (lane == 0) { toke[2 * t] = e0; toke[2 * t + 1] = e1; tokw[2 * t] = w0; tokw[2 * t + 1] = w1; __hip_atomic_fetch_add(&sCnt[e0], 1, __ATOMIC_RELAXED, __HIP_MEMORY_SCOPE_WORKGROUP); __hip_atomic_fetch_add(&sCnt[e1], 1, __ATOMIC_RELAXED, __HIP_MEMORY_SCOPE_WORKGROUP); }
        }
    }
    __syncthreads();
    if (moe && tid < 8) ((int*)(p.ws + WS_WGCNT))[blockIdx.x * 8 + tid] = sCnt[tid];
    __syncthreads();
}

DEVINL void moe_scatter_phase(const Params& p, LAS unsigned char* lds, int Tact) {
    const int tid = tid_hidden(), lane = tid & 63, wv = tid >> 6, G = gridDim.x;
    LAS int* sC = (LAS int*)lds;
    LAS int* sBase = (LAS int*)(lds + 16384);
    LAS int* sE = (LAS int*)(lds + 16384 + 256);
    LAS int* sD = (LAS int*)(lds + 16384 + 256 + 4096);
    const int* wgc = (const int*)(p.ws + WS_WGCNT);
    for (int i = tid; i < G * 8; i += 512) sC[i] = wgc[i];
    __syncthreads();
    if (tid < 8) { int tot = 0, before = 0; for (int g = 0; g < G; ++g) { const int c = sC[g * 8 + tid]; if (g < (int)blockIdx.x) before += c; tot += c; } sBase[tid] = before; sBase[8 + tid] = (tot + 255) / 256 * 256; }
    __syncthreads();
    if (tid == 0) { int acc = 0; for (int e = 0; e < 8; ++e) { const int pd = sBase[8 + e]; sBase[e] += acc; acc += pd; sBase[8 + e] = acc; } }
    __syncthreads();
    const int per = (Tact + G - 1) / G, t0 = blockIdx.x * per, t1 = min(t0 + per, Tact), na = max(t1 - t0, 0) * 2;
    const int* toke = (const int*)(p.ws + WS_TOKE); int* tokd = (int*)(p.ws + WS_TOKD);
    for (int a = tid; a < na; a += 512) sE[a] = toke[2 * t0 + a] & 7;
    __syncthreads();
    for (int a = tid; a < na; a += 512) { const int e = sE[a]; int r = 0; for (int b = 0; b < a; ++b) r += (sE[b] == e) ? 1 : 0; int d = sBase[e] + r; d = min(max(d, 0), MAXRB * 256 - 1); sD[a] = d; tokd[2 * t0 + a] = d; }
    if (blockIdx.x == 0) {
        int* blke = (int*)(p.ws + WS_BLKE);
        if (tid == 0) blke[0] = sBase[15] / 256;
        for (int rb = tid; rb < MAXRB; rb += 512) { int e = 0; while (e < 7 && rb * 256 >= sBase[8 + e]) ++e; blke[8 + rb] = e; }
    }
    __syncthreads();
    const bf16_t* h2 = (const bf16_t*)(p.ws + WS_A); bf16_t* xs = (bf16_t*)(p.ws + WS_BIG + F_XS);
    for (int a = wv; a < na; a += 8) { const int t = t0 + (a >> 1), d = sD[a];
        const u32x4 v0 = *(const u32x4*)(h2 + (size_t)t * 1024 + lane * 8), v1 = *(const u32x4*)(h2 + (size_t)t * 1024 + 512 + lane * 8);
        *(u32x4*)(xs + (size_t)d * 1024 + lane * 8) = v0; *(u32x4*)(xs + (size_t)d * 1024 + 512 + lane * 8) = v1; }
    __syncthreads();
}

DEVINL void ln2_phase(const Params& p, int l, int Tact) {
    const int tid = tid_hidden(), lane = tid & 63, gw = blockIdx.x * 8 + (tid >> 6), nw = gridDim.x * 8;
    const bool moe = (l & 1) != 0;
    const float* gam = p.in[I_LNFG] + (size_t)l * 1024; const float* bet = p.in[I_LNFB] + (size_t)l * 1024;
    bf16_t* h = (bf16_t*)(p.ws + WS_A); const bf16_t* yk = (const bf16_t*)(p.ws + WS_BIG + F_XS);
    const int* tokd = (const int*)(p.ws + WS_TOKD); const float* tokw = (const float*)(p.ws + WS_TOKW);
    for (int t = gw; t < Tact; t += nw) {
        float* x = row_st(p, t);
        f32x4 z[4]; float s = 0.f;
        int d0 = 0, d1 = 0; float w0 = 0.f, w1 = 0.f; const float* m5 = nullptr;
        if (moe) { d0 = tokd[2 * t]; d1 = tokd[2 * t + 1]; w0 = tokw[2 * t]; w1 = tokw[2 * t + 1]; m5 = mod_row(p, l, t, 5); }
#pragma unroll
        for (int j = 0; j < 4; ++j) { const int c = j * 256 + lane * 4; z[j] = *(const f32x4*)(x + c);
            if (moe) { const u32x2 a = *(const u32x2*)(yk + (size_t)d0 * 1024 + c), b = *(const u32x2*)(yk + (size_t)d1 * 1024 + c);
                f32x4 f; f[0] = w0 * bflo(a.x) + w1 * bflo(b.x); f[1] = w0 * bfhi(a.x) + w1 * bfhi(b.x); f[2] = w0 * bflo(a.y) + w1 * bflo(b.y); f[3] = w0 * bfhi(a.y) + w1 * bfhi(b.y);
                z[j] = z[j] * ALPHA + *(const f32x4*)(m5 + c) * f; }
            s += z[j][0] + z[j][1] + z[j][2] + z[j][3]; }
        const float mean = wave_sum(s) * (1.0f / 1024.0f);
        float q = 0.f;
#pragma unroll
        for (int j = 0; j < 4; ++j) { z[j] -= mean; q += z[j][0] * z[j][0] + z[j][1] * z[j][1] + z[j][2] * z[j][2] + z[j][3] * z[j][3]; }
        const float rstd = rsqrtf(wave_sum(q) * (1.0f / 1024.0f) + LN_EPS);
        const float* sh = nullptr; const float* sc = nullptr;
        if (l + 1 < DEPTH) { sh = mod_row(p, l + 1, t, 0); sc = mod_row(p, l + 1, t, 1); }
#pragma unroll
        for (int j = 0; j < 4; ++j) { const int c = j * 256 + lane * 4;
            const f32x4 xv = z[j] * rstd * *(const f32x4*)(gam + c) + *(const f32x4*)(bet + c);
            *(f32x4*)(x + c) = xv;
            if (l + 1 < DEPTH) { const f32x4 hv = xv * (*(const f32x4*)(sc + c) + 1.0f) + *(const f32x4*)(sh + c);
                u32x2 w; w.x = pk2(hv[0], hv[1]); w.y = pk2(hv[2], hv[3]); *(u32x2*)(h + (size_t)t * 1024 + c) = w; }
        }
    }
}

DEVINL bf16x8 cat8(v4i16_t a, v4i16_t b) { bf16x8 r; r[0] = a[0]; r[1] = a[1]; r[2] = a[2]; r[3] = a[3]; r[4] = b[0]; r[5] = b[1]; r[6] = b[2]; r[7] = b[3]; return r; }
DEVINL void retention_phase(const Params& p, LAS unsigned char* lds, int l, bool need_ctx) {
    constexpr int RS = 272;
    int tid = threadIdx.x; asm volatile("" : "+v"(tid));
    const int w = __builtin_amdgcn_readfirstlane(tid >> 6), lane = tid & 63, fr = lane & 15, fq = lane >> 4;
    LAS unsigned char* Qs = lds; LAS unsigned char* Ks = lds + 34816; LAS unsigned char* Vs = lds + 69632; LAS unsigned char* Ps = lds + 104448;
    LAS float* tqd = (LAS float*)(lds + LDS_TAB); LAS float* tkd = tqd + 128;
    const bf16_t* qg = (const bf16_t*)(p.ws + WS_BIG + B_Q); const bf16_t* kg = (const bf16_t*)(p.ws + WS_BIG + B_K); const bf16_t* vg = (const bf16_t*)(p.ws + WS_BIG + B_V);
    const int lr = tid >> 4, lc = tid & 15;
    const int trq = fr >> 2, trp = fr & 3;
    for (int item = blockIdx.x; item < 256; item += gridDim.x) {
        const int dvs = item & 1, dir = (item >> 1) & 1, hd = (item >> 2) & 3, b = item >> 4;
        bf16_t* og = (bf16_t*)(p.ws + WS_BIG + (dir ? B_OB : B_OF));
        const float zl = p.in[I_DECAY][l * 8 + dir * 4 + hd];
        const float lg2 = -log1pf(expf(-zl)) * 1.4426950408889634f;
        __syncthreads();
        if (tid < 128) { tqd[tid] = exp2f(lg2 * (float)(dir ? 128 - tid : tid + 1)); tkd[tid] = exp2f(lg2 * (float)(dir ? tid : 127 - tid)); }
        const float cdec = exp2f(lg2 * 128.0f);
        float afac[4];
#pragma unroll
        for (int jj = 0; jj < 4; ++jj) afac[jj] = exp2f(lg2 * (float)(dir ? (4 * fq + jj - fr) : (fr - 4 * fq - jj)));
        f32x4 S[8];
#pragma unroll
        for (int t = 0; t < 8; ++t) S[t] = (f32x4){0.f, 0.f, 0.f, 0.f};
        u32x4 rq[4], rk[4], rv[4];
#define RET_TOK0(c) ((c) < 2 ? NLAT + b * 256 + (dir ? 1 - (c) : (c)) * 128 : b * 4096 + (dir ? 33 - (c) : (c) - 2) * 128)
#define RET_LOAD(c) do { const int _t0 = RET_TOK0(c); _Pragma("unroll") for (int ps = 0; ps < 4; ++ps) { const size_t _t = (size_t)(_t0 + lr + 32 * ps); \
            rq[ps] = *(const u32x4*)(qg + _t * 512 + hd * 128 + lc * 8); rk[ps] = *(const u32x4*)(kg + _t * 512 + hd * 128 + lc * 8); rv[ps] = *(const u32x4*)(vg + _t * 1024 + hd * 256 + dvs * 128 + lc * 8); } } while (0)
        RET_LOAD(0);
        for (int c = 0; c < 34; ++c) {
            const int tok0 = RET_TOK0(c);
            __syncthreads();
#pragma unroll
            for (int ps = 0; ps < 4; ++ps) { const int o = (lr + 32 * ps) * RS + lc * 16; *(LAS u32x4*)(Qs + o) = rq[ps]; *(LAS u32x4*)(Ks + o) = rk[ps]; *(LAS u32x4*)(Vs + o) = rv[ps]; }
            __syncthreads();
            if (c + 1 < 34) RET_LOAD(c + 1);
            const bool do_out = (c >= 2) || need_ctx;
            if (do_out) {
                bf16x8 qf[4];
#pragma unroll
                for (int s = 0; s < 4; ++s) qf[s] = *(const LAS bf16x8*)(Qs + (16 * w + fr) * RS + (32 * s + 8 * fq) * 2);
                const int i = 16 * w + fr;
#pragma unroll
                for (int t = 0; t < 8; ++t) {
                    const bool live = dir ? (t >= w) : (t <= w);
                    f32x4 a = (f32x4){0.f, 0.f, 0.f, 0.f};
                    if (live) {
#pragma unroll
                        for (int s = 0; s < 4; ++s) { const bf16x8 kf = *(const LAS bf16x8*)(Ks + (16 * t + fr) * RS + (32 * s + 8 * fq) * 2); a = __builtin_amdgcn_mfma_f32_16x16x32_bf16(kf, qf[s], a, 0, 0, 0); }
                        const float bt = __builtin_amdgcn_exp2f(lg2 * 16.0f * (float)(dir ? t - w : w - t));
#pragma unroll
                        for (int jj = 0; jj < 4; ++jj) { const int dd = dir ? (4 * fq + jj - fr) : (fr - 4 * fq - jj); a[jj] = (t != w || dd >= 0) ? a[jj] * (afac[jj] * bt) : 0.f; }
                    }
                    u32x2 pw; pw.x = pk2(a[0], a[1]); pw.y = pk2(a[2], a[3]);
                    *(LAS u32x2*)(Ps + i * RS + (16 * t + 4 * fq) * 2) = pw;
                    if (t & 1) __builtin_amdgcn_sched_barrier(0);
                }
            }
            __syncthreads();
            bf16x8 vf[4];
#pragma unroll
            for (int s = 0; s < 4; ++s) { LAS unsigned char* a0 = Vs + (32 * s + 8 * fq + trq) * RS + (16 * w + 4 * trp) * 2;
                vf[s] = cat8(__builtin_amdgcn_ds_read_tr16_b64_v4i16((LAS v4i16_t*)a0), __builtin_amdgcn_ds_read_tr16_b64_v4i16((LAS v4i16_t*)(a0 + 4 * RS))); }
            if (do_out) {
                bf16x8 Sb[4];
#pragma unroll
                for (int s = 0; s < 4; ++s) { u32x4 t4; t4.x = pk2(S[2 * s][0], S[2 * s][1]); t4.y = pk2(S[2 * s][2], S[2 * s][3]); t4.z = pk2(S[2 * s + 1][0], S[2 * s + 1][1]); t4.w = pk2(S[2 * s + 1][2], S[2 * s + 1][3]); Sb[s] = __builtin_bit_cast(bf16x8, t4); }
#pragma unroll
                for (int it = 0; it < 8; ++it) {
                    const int i = 16 * it + fr;
                    f32x4 a = (f32x4){0.f, 0.f, 0.f, 0.f};
#pragma unroll
                    for (int s = 0; s < 4; ++s) { const u32x2 lo = *(const LAS u32x2*)(Qs + i * RS + (32 * s + 4 * fq) * 2), hi = *(const LAS u32x2*)(Qs + i * RS + (32 * s + 16 + 4 * fq) * 2);
                        u32x4 t4; t4.x = lo.x; t4.y = lo.y; t4.z = hi.x; t4.w = hi.y; a = __builtin_amdgcn_mfma_f32_16x16x32_bf16(Sb[s], __builtin_bit_cast(bf16x8, t4), a, 0, 0, 0); }
                    a *= tqd[i];
#pragma unroll
                    for (int s = 0; s < 4; ++s) if (dir ? (2 * s + 1 >= it) : (2 * s <= it)) { const bf16x8 pb = *(const LAS bf16x8*)(Ps + i * RS + (32 * s + 8 * fq) * 2); a = __builtin_amdgcn_mfma_f32_16x16x32_bf16(vf[s], pb, a, 0, 0, 0); }
                    u32x2 ow; ow.x = pk2(a[0], a[1]); ow.y = pk2(a[2], a[3]);
                    *(u32x2*)(og + (size_t)(tok0 + i) * 1024 + hd * 256 + dvs * 128 + 16 * w + 4 * fq) = ow;
                    if (it & 1) __builtin_amdgcn_sched_barrier(0);
                }
            }
#pragma unroll
            for (int t = 0; t < 8; ++t) S[t] *= cdec;
#pragma unroll
            for (int s = 0; s < 4; ++s) {
                const f32x4 k0 = *(const LAS f32x4*)(tkd + 32 * s + 8 * fq), k1 = *(const LAS f32x4*)(tkd + 32 * s + 8 * fq + 4);
                const u32x4 vv = __builtin_bit_cast(u32x4, vf[s]); u32x4 t4;
                t4.x = pk2(bflo(vv.x) * k0[0], bfhi(vv.x) * k0[1]); t4.y = pk2(bflo(vv.y) * k0[2], bfhi(vv.y) * k0[3]);
                t4.z = pk2(bflo(vv.z) * k1[0], bfhi(vv.z) * k1[1]); t4.w = pk2(bflo(vv.w) * k1[2], bfhi(vv.w) * k1[3]);
                const bf16x8 vsc = __builtin_bit_cast(bf16x8, t4);
#pragma unroll
                for (int t = 0; t < 8; ++t) {
                    LAS unsigned char* a0 = Ks + (32 * s + 8 * fq + trq) * RS + (16 * t + 4 * trp) * 2;
                    const bf16x8 kt = cat8(__builtin_amdgcn_ds_read_tr16_b64_v4i16((LAS v4i16_t*)a0), __builtin_amdgcn_ds_read_tr16_b64_v4i16((LAS v4i16_t*)(a0 + 4 * RS)));
                    S[t] = __builtin_amdgcn_mfma_f32_16x16x32_bf16(kt, vsc, S[t], 0, 0, 0);
                }
                __builtin_amdgcn_sched_barrier(0);
            }
        }
#undef RET_TOK0
#undef RET_LOAD
    }
    __syncthreads();
}

__global__ void __launch_bounds__(512, 2) fwd_kernel(Params p) {
    extern __shared__ __attribute__((aligned(16))) unsigned char lds_raw[];
    LAS unsigned char* lds = (LAS unsigned char*)lds_raw;
    const int tid = threadIdx.x, G = gridDim.x, lo = p.ph_lo, hi = p.ph_hi;
    volatile LAS unsigned* xst = (volatile LAS unsigned*)(lds + LDS_CTL);
    if (tid < 4) xst[tid] = 0u;
    __syncthreads();
    XcdBarrier bar; bar.bar = (unsigned*)(p.ws + WS_CTL) + CW_BAR; bar.x = 0; bar.st = xst;
    const bool multi = (hi - lo) > 1;
    if (multi) bar = xcd_barrier_post((unsigned*)(p.ws + WS_CTL) + CW_BAR, xst);
#ifndef PHM
#define PHM 0xFFFFFFFFu
#endif
#define PM(q) ((PHM >> (q)) & 1u)
#define IN(k) (lo <= (k) && (k) < hi)
#define SEAM(k) do { if ((k) + 1 < hi) xcd_barrier(bar); } while (0)
    unsigned char* big = p.ws + WS_BIG;
    const char* wmix = (const char*)(p.ws + WS_WMIX);

    if (PM(13) && IN(PH_PRO_A)) { adaln_phase(p, lds); rope_phase(p); __syncthreads(); convert_mixer_weights(p, lds, 0); SEAM(PH_PRO_A); }
    if (PM(14) && IN(PH_PRO_B)) { modulate0_phase(p); SEAM(PH_PRO_B); }

    for (int l = 0; l < DEPTH; ++l) {
        const int pb = PH_L0 + l * PH_PER_L;
        if (hi <= pb || lo >= pb + PH_PER_L) continue;
        const bool need_ctx = l < DEPTH - 1;
        const int Tact = need_ctx ? T : NLAT, nMact = Tact / 256;
        const float* modl = (const float*)(p.ws + WS_MOD) + (size_t)l * 17 * 6144;

        if (PM(0) && IN(pb + Q_IN)) {
            EpiIn E{(bf16_t*)big, (const float*)(p.ws + WS_ROPE)};
            if (need_ctx) { SchedRect S{(const char*)(p.ws + WS_A), wmix + WMIX_IN, T / 256, INW / 256, G, (int)blockIdx.x, (size_t)256 * 1024 * 2}; gemm_phase(lds, 1024, S, E); }
            else { SchedIn3 S{(const char*)(p.ws + WS_A), wmix + WMIX_IN, G, (int)blockIdx.x, (size_t)256 * 1024 * 2}; gemm_phase(lds, 1024, S, E); }
            SEAM(pb + Q_IN);
        }
        if (PM(1) && IN(pb + Q_POOLV)) { poolv_phase(p, Tact); SEAM(pb + Q_POOLV); }
        if (PM(2) && IN(pb + Q_RET)) { retention_phase(p, lds, l, need_ctx); SEAM(pb + Q_RET); }
        if (PM(3) && IN(pb + Q_COMB)) { combine_phase(p, Tact); poolh_phase(p, Tact); SEAM(pb + Q_COMB); }
        if (PM(4) && IN(pb + Q_MIX)) {
            { SchedRect S{(const char*)(big + B_U), wmix + WMIX_POOL, nMact, 4, G, (int)blockIdx.x, (size_t)256 * 512 * 2};
              EpiGate<0> E{(bf16_t*)(big + B_Y1), (const bf16_t*)(big + B_GP), nullptr}; gemm_phase(lds, 512, S, E); }
            __syncthreads();
            { SchedRect S{(const char*)(big + B_URET), wmix + WMIX_RET, nMact, 4, G, (int)blockIdx.x, (size_t)256 * 1024 * 2};
              EpiGate<1> E{(bf16_t*)(big + B_MIX), (const bf16_t*)(big + B_GR), (const bf16_t*)(big + B_Y1)}; gemm_phase(lds, 1024, S, E); }
            SEAM(pb + Q_MIX);
        }
        if (PM(5) && IN(pb + Q_OUT)) {
            SchedRect S{(const char*)(big + B_MIX), wmix + WMIX_OUT, nMact, 4, G, (int)blockIdx.x, (size_t)256 * 1024 * 2};
            EpiRes E{l == 0 ? p.in[I_X] : p.out, l == 0 ? p.in[I_CTX] : (const float*)(p.ws + WS_CTXS), p.out, (float*)(p.ws + WS_CTXS), modl, 2};
            gemm_phase(lds, 1024, S, E);
            SEAM(pb + Q_OUT);
        }
        if (PM(6) && IN(pb + Q_LN1)) {
            ln1_phase(p, lds, l, Tact);
            convert_ffn_weights(p, lds, l);
            if (l + 1 < DEPTH) convert_mixer_weights(p, lds, l + 1);
            SEAM(pb + Q_LN1);
        }
        if ((l & 1) == 0) {
            if (PM(7) && IN(pb + Q_F0)) {
                SchedRect S{(const char*)(p.ws + WS_A), (const char*)(big + F_W), nMact, 2 * DFF / 256, G, (int)blockIdx.x, (size_t)256 * 1024 * 2};
                EpiSwiglu E{(bf16_t*)(big + F_ACT), DFF, 0}; gemm_phase(lds, 1024, S, E);
                SEAM(pb + Q_F0);
            }
            if (PM(8) && IN(pb + Q_F1)) {
                SchedRect S{(const char*)(big + F_ACT), (const char*)(big + F_DW2), nMact, 4, G, (int)blockIdx.x, (size_t)256 * DFF * 2};
                EpiRes E{p.out, (const float*)(p.ws + WS_CTXS), p.out, (float*)(p.ws + WS_CTXS), modl, 5};
                gemm_phase(lds, DFF, S, E);
                SEAM(pb + Q_F1);
            }
        } else {
            if (PM(9) && IN(pb + Q_F0)) { moe_scatter_phase(p, lds, Tact); SEAM(pb + Q_F0); }
            const int* blke = (const int*)(p.ws + WS_BLKE);
            for (int g = 0; g < NGRP; ++g) {
                if (PM(10) && IN(pb + Q_F1 + 2 * g)) {
                    const int nb = min(blke[0], MAXRB), rb0 = g * RBG, nrb = min(RBG, nb - rb0);
                    if (nrb > 0) {
                        SchedMoe S{(const char*)(big + F_XS), (const char*)(big + F_W), blke, rb0, 0, nrb, 2 * EFF / 256, G, (int)blockIdx.x, (size_t)256 * 1024 * 2, F_EW13};
                        EpiSwiglu E{(bf16_t*)(big + F_ACT), EFF, rb0}; gemm_phase(lds, 1024, S, E);
                    }
                    SEAM(pb + Q_F1 + 2 * g);
                }
                if (PM(11) && IN(pb + Q_F1 + 2 * g + 1)) {
                    const int nb = min(blke[0], MAXRB), rb0 = g * RBG, nrb = min(RBG, nb - rb0);
                    if (nrb > 0) {
                        SchedMoe S{(const char*)(big + F_ACT), (const char*)(big + F_W + (size_t)NEXP * F_EW13), blke, rb0, rb0, nrb, 4, G, (int)blockIdx.x, (size_t)256 * EFF * 2, F_EW2};
                        EpiGate<2> E{(bf16_t*)(big + F_XS), nullptr, nullptr}; gemm_phase(lds, EFF, S, E);
                    }
                    SEAM(pb + Q_F1 + 2 * g + 1);
                }
            }
        }
        if (PM(12) && IN(pb + Q_LN2)) { ln2_phase(p, l, Tact); SEAM(pb + Q_LN2); }
    }
#undef IN
#undef SEAM
}

#if MK_CHECK
constexpr size_t WS_DBGF = AL(WS_END);
DEVINL unsigned hsh(unsigned x) { x ^= x >> 16; x *= 0x7feb352du; x ^= x >> 15; x *= 0x846ca68bu; x ^= x >> 16; return x; }
DEVINL void chk_rep(const Params& p, int id, float got, float ex, float tol) {
    float e = fabsf(got - ex) / tol; if (!(e == e) || e > 1e30f) e = 1e30f;
    atomicMax((unsigned*)(p.ws + WS_CTL) + CW_DBG + id, __float_as_uint(e));
}
DEVINL float in_stream(const Params& p, int l, int t, int c) { return row_in(p, l, t)[c]; }
DEVINL float modv(const Params& p, int l, int t, int which, int c) { return mod_row(p, l, t, which)[c]; }
DEVINL float bfr(float x) { return bf2f(f2bf(x)); }

enum { C_MOD = 0, C_ROPE, C_WCVT, C_H, C_IN, C_VM, C_RET, C_URET, C_DPOOL, C_MIX, C_OUT, C_LN1X, C_LN1H, C_ROUTE, C_UP, C_DOWN, C_LN2X, C_LN2H, C_SCAT, C_MUP, C_MDOWN, C_FWCVT };

__global__ void chk_pro(Params p) {
    const int s = blockIdx.x * blockDim.x + threadIdx.x; if (s >= 256) return;
    { const unsigned h = hsh(s * 3 + 1); const int l = h & 3, r = (h >> 2) % 17, n = (h >> 8) % 6144;
      float a = 0.f; for (int k = 0; k < 1024; ++k) { const float c = r < 16 ? p.in[I_C][r * 1024 + k] : p.in[I_CCTX][k]; a += c / (1.f + expf(-c)) * p.in[I_ADAW][((size_t)l * 1024 + k) * 6144 + n]; }
      a += p.in[I_ADAB][l * 6144 + n];
      chk_rep(p, C_MOD, ((const float*)(p.ws + WS_MOD))[((size_t)l * 17 + r) * 6144 + n], a, 2e-3f); }
    { const unsigned h = hsh(s * 3 + 2); const int pos = h & 4095, f = (h >> 12) & 63;
      const float inv = expf(-logf(10000.0f) * (float)(f & 31) / 32.0f), ang = (float)(f < 32 ? (pos >> 6) : (pos & 63)) * inv;
      const float* tb = (const float*)(p.ws + WS_ROPE) + ((size_t)pos * 64 + f) * 2;
      chk_rep(p, C_ROPE, tb[0], cosf(ang), 1e-4f); chk_rep(p, C_ROPE, tb[1], sinf(ang), 1e-4f); }
}
__global__ void chk_wmix(Params p, int l) {
    const int s = blockIdx.x * blockDim.x + threadIdx.x; if (s >= 512) return;
    const unsigned h = hsh(s * 5 + 7 + l); const int k = h & 1023, n = (h >> 10) % INW;
    const unsigned char* wm = p.ws + WS_WMIX;
    { const int np = MapIn()(n); const float ex = p.in[I_WIN][((size_t)l * 1024 + k) * INW + n]; chk_rep(p, l * 22 + C_WCVT, bf2f(((const bf16_t*)(wm + WMIX_IN))[(size_t)np * 1024 + k]), ex, 0.01f * fabsf(ex) + 1e-5f); }
    { const int n2 = n & 1023; const float ex = p.in[I_WRETOUT][((size_t)l * 1024 + k) * 1024 + n2]; chk_rep(p, l * 22 + C_WCVT, bf2f(((const bf16_t*)(wm + WMIX_RET))[(size_t)n2 * 1024 + k]), ex, 0.01f * fabsf(ex) + 1e-5f); }
    { const int n2 = n & 1023; const float ex = p.in[I_WOUT][((size_t)l * 1024 + k) * 1024 + n2]; chk_rep(p, l * 22 + C_WCVT, bf2f(((const bf16_t*)(wm + WMIX_OUT))[(size_t)n2 * 1024 + k]), ex, 0.01f * fabsf(ex) + 1e-5f); }
    { const int n2 = n & 1023, kc = k & 511, g = kc >> 7, c = kc & 127; float a = 0.f;
      for (int d = 0; d < 128; ++d) a += p.in[I_POOLW][(((size_t)l * 4 + g) * 128 + c) * 128 + d] * p.in[I_POOLS][l * 512 + g * 128 + d] * p.in[I_WPOOLOUT][((size_t)l * 512 + g * 128 + d) * 1024 + n2];
      chk_rep(p, l * 22 + C_WCVT, bf2f(((const bf16_t*)(wm + WMIX_POOL))[(size_t)n2 * 512 + kc]), a, 0.01f * fabsf(a) + 2e-5f); }
}
__global__ void chk_h(Params p, int l) {
    const int s = blockIdx.x * blockDim.x + threadIdx.x; if (s >= 512) return;
    const unsigned h = hsh(s * 7 + 3 + l); const int t = h % T, c = (h >> 17) & 1023;
    const float ex = in_stream(p, l, t, c) * (1.f + modv(p, l, t, 1, c)) + modv(p, l, t, 0, c);
    chk_rep(p, l * 22 + C_H, bf2f(((const bf16_t*)(p.ws + WS_A))[(size_t)t * 1024 + c]), ex, 0.02f + 0.01f * fabsf(ex));
}
DEVINL float dot_h_win(const Params& p, int l, int t, int n) { const bf16_t* h = (const bf16_t*)(p.ws + WS_A) + (size_t)t * 1024; const float* w = p.in[I_WIN] + (size_t)l * 1024 * INW + n; float a = 0.f; for (int k = 0; k < 1024; ++k) a += bf2f(h[k]) * w[(size_t)k * INW]; return a; }
__global__ void chk_in(Params p, int l) {
    const int s = blockIdx.x * blockDim.x + threadIdx.x; if (s >= 768) return;
    const unsigned h = hsh(s * 11 + 5 + l); int t = h % T; if ((s & 7) == 7) t = NLAT + (h % NCTX);
    int n = (h >> 9) % INW; if ((s & 3) == 1) n = 512 + (h >> 9) % 1024;
    const bool lat = t < NLAT;
    if (l == DEPTH - 1 && !lat && (n < 1024 || n >= 2560)) return;
    const unsigned char* big = p.ws + WS_BIG; const float tol = 0.04f;
    float ex, got;
    if (n < 512) { ex = dot_h_win(p, l, t, n); got = bf2f(((const bf16_t*)(big + B_U))[(size_t)t * 512 + n]); }
    else if (n < 1536) {
        const bool isk = n >= 1024; const int nb = isk ? 1024 : 512, hd = (n - nb) >> 7, j = (n - nb) & 127, i = j & 63;
        const float t1 = dot_h_win(p, l, t, nb + hd * 128 + i), t2 = dot_h_win(p, l, t, nb + hd * 128 + i + 64);
        float cs = 1.f, sn = 0.f;
        if (lat) { const int pos = t & 4095; const float inv = expf(-logf(10000.0f) * (float)(i & 31) / 32.0f), ang = (float)(i < 32 ? (pos >> 6) : (pos & 63)) * inv; cs = cosf(ang); sn = sinf(ang); }
        ex = (j < 64) ? (t1 * cs - t2 * sn) : (t1 * sn + t2 * cs); if (isk) ex *= KSCALE;
        got = bf2f(((const bf16_t*)(big + (isk ? B_K : B_Q)))[(size_t)t * 512 + hd * 128 + 2 * i + (j >= 64 ? 1 : 0)]);
    }
    else if (n < 2560) { ex = dot_h_win(p, l, t, n); got = bf2f(((const bf16_t*)(big + B_V))[(size_t)t * 1024 + n - 1536]); }
    else if (n < 3584) { const float a = dot_h_win(p, l, t, n); ex = a / (1.f + expf(-a)); got = bf2f(((const bf16_t*)(big + B_SG))[(size_t)t * 1024 + n - 2560]); }
    else if (n < 4608) { const float a = dot_h_win(p, l, t, n); ex = 1.f / (1.f + expf(-a)); got = bf2f(((const bf16_t*)(big + B_GP))[(size_t)t * 1024 + n - 3584]); }
    else { const float a = dot_h_win(p, l, t, n); ex = 1.f / (1.f + expf(-a)); got = bf2f(((const bf16_t*)(big + B_GR))[(size_t)t * 1024 + n - 4608]); }
    chk_rep(p, l * 22 + C_IN, got, ex, tol + 0.01f * fabsf(ex));
}
DEVINL float box1(const bf16_t* u, int t, int ch, int stride, int pos, int last, int w) {
    const int left = w >> 1, right = w - 1 - left, lo = max(pos - left, 0), hi = min(pos + right, last); float a = 0.f;
    for (int q = lo; q <= hi; ++q) a += bf2f(u[(size_t)(t + (q - pos) * stride) * 512 + ch]);
    return a / (float)(hi - lo + 1);
}
__global__ void chk_poolv(Params p, int l, int Tact) {
    const int s = blockIdx.x * blockDim.x + threadIdx.x; if (s >= 512) return;
    const unsigned h = hsh(s * 13 + 1 + l); int t = h % NLAT; if ((s & 7) == 7 && Tact > NLAT) t = NLAT + (h % NCTX);
    const int ch = (h >> 7) & 511, w = 2 << (ch >> 7);
    const bf16_t* u = (const bf16_t*)(p.ws + WS_BIG + B_U); const bf16_t* vm = (const bf16_t*)(p.ws + WS_A);
    float* dex = (float*)(p.ws + WS_DBGF);
    if (t < NLAT) {
        const float ex = box1(u, t, ch, 64, (t >> 6) & 63, 63, w);
        chk_rep(p, l * 22 + C_VM, bf2f(vm[(size_t)t * 512 + ch]), ex, 0.02f + 0.01f * fabsf(ex));
        const int left = w >> 1, right = w - 1 - left, c = t & 63, lo = max(c - left, 0), hi = min(c + right, 63); float a = 0.f;
        for (int cc = lo; cc <= hi; ++cc) a += box1(u, t + (cc - c), ch, 64, (t >> 6) & 63, 63, w);
        dex[s] = a / (float)(hi - lo + 1) - bf2f(u[(size_t)t * 512 + ch]);
    } else {
        chk_rep(p, l * 22 + C_VM, bf2f(vm[(size_t)t * 512 + ch]), bf2f(u[(size_t)t * 512 + ch]), 1e-6f);
        dex[s] = box1(u, t, ch, 1, (t - NLAT) & 255, 255, w) - bf2f(u[(size_t)t * 512 + ch]);
    }
}
__global__ void chk_ret(Params p, int l, int need_ctx) {
    __shared__ float red[256];
    const int s = blockIdx.x; const unsigned h = hsh(s * 17 + 9 + l);
    const int dir = s & 1; int t = h % NLAT; int typ = 2;
    if ((s & 7) >= 4 && need_ctx) { typ = ((s & 7) >= 6) ? 1 : 0; const int firstchunk = dir ? 1 : 0; const int ch = typ == 0 ? firstchunk : 1 - firstchunk; t = NLAT + ((h >> 3) % BATCH) * 256 + ch * 128 + (h % 128); }
    const int hd = (h >> 20) & 3, dv = (h >> 22) & 255;
    const unsigned char* big = p.ws + WS_BIG;
    const bf16_t* qg = (const bf16_t*)(big + B_Q); const bf16_t* kg = (const bf16_t*)(big + B_K); const bf16_t* vg = (const bf16_t*)(big + B_V);
    const float zl = p.in[I_DECAY][l * 8 + dir * 4 + hd]; const float lg = -log1pf(expf(-zl));
    const bool lat = t < NLAT; const int b = lat ? t >> 12 : (t - NLAT) >> 8;
    const int tpos = lat ? 256 + (dir ? 4095 - (t & 4095) : (t & 4095)) : (dir ? 255 - ((t - NLAT) & 255) : ((t - NLAT) & 255));
    float acc = 0.f;
    for (int j = threadIdx.x; j < 4352; j += 256) {
        const bool jl = j >= 256; const int tok = jl ? b * 4096 + (dir ? 4095 - (j - 256) : (j - 256)) : NLAT + b * 256 + (dir ? 255 - j : j);
        if (j > tpos) continue;
        if (!lat && jl) continue;
        float d = 0.f; for (int c = 0; c < 128; ++c) d += bf2f(qg[(size_t)t * 512 + hd * 128 + c]) * bf2f(kg[(size_t)tok * 512 + hd * 128 + c]);
        acc += d * expf(lg * (float)(tpos - j)) * bf2f(vg[(size_t)tok * 1024 + hd * 256 + dv]);
    }
    red[threadIdx.x] = acc; __syncthreads();
    for (int o = 128; o > 0; o >>= 1) { if ((int)threadIdx.x < o) red[threadIdx.x] += red[threadIdx.x + o]; __syncthreads(); }
    if (threadIdx.x == 0) { const float ex = red[0]; const float got = bf2f(((const bf16_t*)(big + (dir ? B_OB : B_OF)))[(size_t)t * 1024 + hd * 256 + dv]); if (!(fabsf(got) < 1e30f)) chk_rep(p, 5, 1e6f, 0.f, 1.f); if (!(fabsf(ex) < 1e30f)) chk_rep(p, 4, 1e6f, 0.f, 1.f);
        chk_rep(p, l * 22 + C_RET + typ * 2 + dir, got, ex, 0.1f + 0.03f * fabsf(ex)); }
}
__global__ void chk_comb(Params p, int l, int Tact) {
    const int s = blockIdx.x * blockDim.x + threadIdx.x; if (s >= 512) return;
    const unsigned char* big = p.ws + WS_BIG;
    { const unsigned h = hsh(s * 19 + 4 + l); const int t = h % Tact, col = (h >> 17) & 1023, hb = col & ~255;
      const bf16_t* of = (const bf16_t*)(big + B_OF) + (size_t)t * 1024; const bf16_t* ob = (const bf16_t*)(big + B_OB) + (size_t)t * 1024;
      float m = 0.f; for (int c = 0; c < 256; ++c) m += bf2f(of[hb + c]) + bf2f(ob[hb + c]); m /= 256.f;
      float v = 0.f; for (int c = 0; c < 256; ++c) { const float d = bf2f(of[hb + c]) + bf2f(ob[hb + c]) - m; v += d * d; } v /= 256.f;
      const float ex = bf2f(((const bf16_t*)(big + B_SG))[(size_t)t * 1024 + col]) * (bf2f(of[col]) + bf2f(ob[col]) - m) * rsqrtf(v + LN_EPS);
      chk_rep(p, l * 22 + C_URET, bf2f(((const bf16_t*)(big + B_URET))[(size_t)t * 1024 + col]), ex, 0.02f + 0.01f * fabsf(ex)); }
    { const unsigned h = hsh(s * 13 + 1 + l); int t = h % NLAT; if ((s & 7) == 7 && Tact > NLAT) t = NLAT + (h % NCTX); const int ch = (h >> 7) & 511;
      const float ex = ((const float*)(p.ws + WS_DBGF))[s];
      chk_rep(p, l * 22 + C_DPOOL, bf2f(((const bf16_t*)(big + B_U))[(size_t)t * 512 + ch]), ex, 0.03f + 0.01f * fabsf(ex)); }
}
__global__ void chk_mix(Params p, int l, int Tact) {
    const int s = blockIdx.x * blockDim.x + threadIdx.x; if (s >= 256) return;
    const unsigned char* big = p.ws + WS_BIG; const unsigned h = hsh(s * 23 + 2 + l); const int t = h % Tact, n = (h >> 17) & 1023;
    const bf16_t* d = (const bf16_t*)(big + B_U) + (size_t)t * 512; float yp = 0.f;
    for (int g = 0; g < 4; ++g) for (int dd = 0; dd < 128; ++dd) { float a = 0.f; for (int c = 0; c < 128; ++c) a += bf2f(d[g * 128 + c]) * p.in[I_POOLW][(((size_t)l * 4 + g) * 128 + c) * 128 + dd];
        yp += a * p.in[I_POOLS][l * 512 + g * 128 + dd] * p.in[I_WPOOLOUT][((size_t)l * 512 + g * 128 + dd) * 1024 + n]; }
    float yr = 0.f; const bf16_t* ur = (const bf16_t*)(big + B_URET) + (size_t)t * 1024;
    for (int k = 0; k < 1024; ++k) yr += bf2f(ur[k]) * p.in[I_WRETOUT][((size_t)l * 1024 + k) * 1024 + n];
    const float ex = bf2f(((const bf16_t*)(big + B_GP))[(size_t)t * 1024 + n]) * yp + bf2f(((const bf16_t*)(big + B_GR))[(size_t)t * 1024 + n]) * yr;
    chk_rep(p, l * 22 + C_MIX, bf2f(((const bf16_t*)(big + B_MIX))[(size_t)t * 1024 + n]), ex, 0.03f + 0.02f * fabsf(ex));
}
__global__ void chk_out(Params p, int l, int Tact, int post) {
    const int s = blockIdx.x * blockDim.x + threadIdx.x; if (s >= 256) return;
    const unsigned char* big = p.ws + WS_BIG; const unsigned h = hsh(s * 29 + 6 + l); const int t = h % Tact, n = (h >> 17) & 1023;
    float* st = (float*)(p.ws + WS_DBGF) + 1024;
    if (!post) { float y = 0.f; const bf16_t* mx = (const bf16_t*)(big + B_MIX) + (size_t)t * 1024; for (int k = 0; k < 1024; ++k) y += bf2f(mx[k]) * p.in[I_WOUT][((size_t)l * 1024 + k) * 1024 + n];
        st[s] = ALPHA * in_stream(p, l, t, n) + modv(p, l, t, 2, n) * y; }
    else chk_rep(p, l * 22 + C_OUT, row_st(p, t)[n], st[s], 0.01f + 0.003f * fabsf(st[s]));
}
__global__ void chk_ln(Params p, int l, int Tact, int which  , int post) {
    __shared__ float red[256]; __shared__ float stat[2];
    const int s = blockIdx.x; const unsigned h = hsh(s * 31 + 8 + l + which * 77); const int t = h % Tact; const bool moe = (l & 1) != 0;
    float* st = (float*)(p.ws + WS_DBGF) + 2048 + (size_t)(which - 1) * 8 * 2048 + (size_t)s * 2048;
    const float* gam = p.in[which == 1 ? I_LNMG : I_LNFG] + l * 1024; const float* bet = p.in[which == 1 ? I_LNMB : I_LNFB] + l * 1024;
    if (!post) {
        float z[4]; float a = 0.f;
        for (int q = 0; q < 4; ++q) { const int c = threadIdx.x + 256 * q; float zz = row_st(p, t)[c];
            if (which == 2 && moe) { const int d0 = ((const int*)(p.ws + WS_TOKD))[2 * t], d1 = ((const int*)(p.ws + WS_TOKD))[2 * t + 1]; const float w0 = ((const float*)(p.ws + WS_TOKW))[2 * t], w1 = ((const float*)(p.ws + WS_TOKW))[2 * t + 1];
                const bf16_t* yk = (const bf16_t*)(p.ws + WS_BIG + F_XS); zz = ALPHA * zz + modv(p, l, t, 5, c) * (w0 * bf2f(yk[(size_t)d0 * 1024 + c]) + w1 * bf2f(yk[(size_t)d1 * 1024 + c])); }
            z[q] = zz; a += zz; }
        red[threadIdx.x] = a; __syncthreads(); for (int o = 128; o > 0; o >>= 1) { if ((int)threadIdx.x < o) red[threadIdx.x] += red[threadIdx.x + o]; __syncthreads(); }
        if (threadIdx.x == 0) stat[0] = red[0] / 1024.f; __syncthreads(); const float m = stat[0]; a = 0.f;
        for (int q = 0; q < 4; ++q) a += (z[q] - m) * (z[q] - m);
        __syncthreads(); red[threadIdx.x] = a; __syncthreads(); for (int o = 128; o > 0; o >>= 1) { if ((int)threadIdx.x < o) red[threadIdx.x] += red[threadIdx.x + o]; __syncthreads(); }
        const float rstd = rsqrtf(red[0] / 1024.f + LN_EPS);
        for (int q = 0; q < 4; ++q) { const int c = threadIdx.x + 256 * q; const float x = (z[q] - m) * rstd * gam[c] + bet[c]; st[c] = x;
            float hv = 0.f; if (which == 1) hv = x * (1.f + modv(p, l, t, 4, c)) + modv(p, l, t, 3, c); else if (l + 1 < DEPTH) hv = x * (1.f + modv(p, l + 1, t, 1, c)) + modv(p, l + 1, t, 0, c);
            st[1024 + c] = hv; }
    } else {
        for (int q = 0; q < 4; ++q) { const int c = threadIdx.x + 256 * q;
            chk_rep(p, l * 22 + (which == 1 ? C_LN1X : C_LN2X), row_st(p, t)[c], st[c], 2e-3f + 1e-3f * fabsf(st[c]));
            if (which == 1 || l + 1 < DEPTH) chk_rep(p, l * 22 + (which == 1 ? C_LN1H : C_LN2H), bf2f(((const bf16_t*)(p.ws + WS_A))[(size_t)t * 1024 + c]), st[1024 + c], 0.02f + 0.01f * fabsf(st[1024 + c])); }
        if (which == 1 && moe && threadIdx.x == 0) {
            float lgv[8]; for (int e = 0; e < 8; ++e) { float a = 0.f; for (int c = 0; c < 1024; ++c) a += st[1024 + c] * p.in[I_ROUTER][((size_t)(l >> 1) * 1024 + c) * 8 + e]; lgv[e] = a; }
            int e0 = 0; for (int e = 1; e < 8; ++e) if (lgv[e] > lgv[e0]) e0 = e; int e1 = -1; for (int e = 0; e < 8; ++e) if (e != e0 && (e1 < 0 || lgv[e] > lgv[e1])) e1 = e;
            const float ex = expf(lgv[e1] - lgv[e0]);
            const int* te = (const int*)(p.ws + WS_TOKE); const float* tw = (const float*)(p.ws + WS_TOKW);
            chk_rep(p, l * 22 + C_ROUTE, (float)te[2 * t], (float)e0, 0.5f); chk_rep(p, l * 22 + C_ROUTE, (float)te[2 * t + 1], (float)e1, 0.5f);
            chk_rep(p, l * 22 + C_ROUTE, tw[2 * t], 1.f / (1.f + ex), 2e-3f); chk_rep(p, l * 22 + C_ROUTE, tw[2 * t + 1], ex / (1.f + ex), 2e-3f);
        }
    }
}
__global__ void chk_fw(Params p, int l) {
    const int s = blockIdx.x * blockDim.x + threadIdx.x; if (s >= 512) return;
    const unsigned h = hsh(s * 37 + 11 + l); const unsigned char* fw = p.ws + WS_BIG + F_W; const int li = l >> 1, k = h & 1023;
    if ((l & 1) == 0) { const int n = (h >> 10) % DFF;
        float ex = p.in[I_FW1][((size_t)li * 1024 + k) * DFF + n]; chk_rep(p, l * 22 + C_FWCVT, bf2f(((const bf16_t*)fw)[(size_t)((n >> 7) * 256 + (n & 127)) * 1024 + k]), ex, 0.01f * fabsf(ex) + 1e-5f);
        ex = p.in[I_FW3][((size_t)li * 1024 + k) * DFF + n]; chk_rep(p, l * 22 + C_FWCVT, bf2f(((const bf16_t*)fw)[(size_t)((n >> 7) * 256 + 128 + (n & 127)) * 1024 + k]), ex, 0.01f * fabsf(ex) + 1e-5f);
        ex = p.in[I_FW2][((size_t)li * DFF + n) * 1024 + k]; chk_rep(p, l * 22 + C_FWCVT, bf2f(((const bf16_t*)(fw + F_DW2))[(size_t)k * DFF + n]), ex, 0.01f * fabsf(ex) + 1e-5f);
    } else { const int n = (h >> 10) % EFF, e = (h >> 24) & 7; const size_t so = ((size_t)li * NEXP + e) * 1024 * EFF;
        float ex = p.in[I_MW1][so + (size_t)k * EFF + n]; chk_rep(p, l * 22 + C_FWCVT, bf2f(((const bf16_t*)(fw + (size_t)e * F_EW13))[(size_t)((n >> 7) * 256 + (n & 127)) * 1024 + k]), ex, 0.01f * fabsf(ex) + 1e-5f);
        ex = p.in[I_MW3][so + (size_t)k * EFF + n]; chk_rep(p, l * 22 + C_FWCVT, bf2f(((const bf16_t*)(fw + (size_t)e * F_EW13))[(size_t)((n >> 7) * 256 + 128 + (n & 127)) * 1024 + k]), ex, 0.01f * fabsf(ex) + 1e-5f);
        ex = p.in[I_MW2][so + (size_t)n * 1024 + k]; chk_rep(p, l * 22 + C_FWCVT, bf2f(((const bf16_t*)(fw + (size_t)NEXP * F_EW13 + (size_t)e * F_EW2))[(size_t)k * EFF + n]), ex, 0.01f * fabsf(ex) + 1e-5f);
    }
}
__global__ void chk_up(Params p, int l, int Tact) {
    const int s = blockIdx.x * blockDim.x + threadIdx.x; if (s >= 256) return;
    const unsigned h = hsh(s * 41 + 12 + l); const int t = h % Tact, n = (h >> 17) % DFF, li = l >> 1;
    const bf16_t* h2 = (const bf16_t*)(p.ws + WS_A) + (size_t)t * 1024; float a = 0.f, b = 0.f;
    for (int k = 0; k < 1024; ++k) { const float x = bf2f(h2[k]); a += x * p.in[I_FW1][((size_t)li * 1024 + k) * DFF + n]; b += x * p.in[I_FW3][((size_t)li * 1024 + k) * DFF + n]; }
    const float ex = a / (1.f + expf(-a)) * b;
    chk_rep(p, l * 22 + C_UP, bf2f(((const bf16_t*)(p.ws + WS_BIG + F_ACT))[(size_t)t * DFF + n]), ex, 0.04f + 0.02f * fabsf(ex));
}
__global__ void chk_down(Params p, int l, int Tact, int post) {
    const int s = blockIdx.x * blockDim.x + threadIdx.x; if (s >= 256) return;
    const unsigned h = hsh(s * 43 + 13 + l); const int t = h % Tact, n = (h >> 17) & 1023, li = l >> 1;
    float* st = (float*)(p.ws + WS_DBGF) + 1280;
    if (!post) { const bf16_t* ac = (const bf16_t*)(p.ws + WS_BIG + F_ACT) + (size_t)t * DFF; float y = 0.f; for (int k = 0; k < DFF; ++k) y += bf2f(ac[k]) * p.in[I_FW2][((size_t)li * DFF + k) * 1024 + n];
        st[s] = ALPHA * row_st(p, t)[n] + modv(p, l, t, 5, n) * y; }
    else chk_rep(p, l * 22 + C_DOWN, row_st(p, t)[n], st[s], 0.01f + 0.003f * fabsf(st[s]));
}
__global__ void chk_scat(Params p, int l, int Tact) {
    const int s = blockIdx.x * blockDim.x + threadIdx.x; if (s >= 512) return;
    const unsigned h = hsh(s * 47 + 14 + l); const int t = h % Tact, k = (h >> 20) & 1, c = (h >> 21) & 1023;
    const int d = ((const int*)(p.ws + WS_TOKD))[2 * t + k], e = ((const int*)(p.ws + WS_TOKE))[2 * t + k]; const int* blke = (const int*)(p.ws + WS_BLKE);
    const bool ok = d >= 0 && d < MAXRB * 256 && d < blke[0] * 256;
    chk_rep(p, l * 22 + C_SCAT, ok ? 0.f : 1e6f, 0.f, 1.f);
    if (ok) { chk_rep(p, l * 22 + C_SCAT, (float)blke[8 + (d >> 8)], (float)e, 0.5f);
        chk_rep(p, l * 22 + C_SCAT, bf2f(((const bf16_t*)(p.ws + WS_BIG + F_XS))[(size_t)d * 1024 + c]), bf2f(((const bf16_t*)(p.ws + WS_A))[(size_t)t * 1024 + c]), 1e-6f); }
    if (s == 0) { int tot = 0; for (int i = 0; i < 256 * 8; ++i) tot += ((const int*)(p.ws + WS_WGCNT))[i]; chk_rep(p, l * 22 + C_SCAT, (float)tot, (float)(2 * Tact), 0.5f); chk_rep(p, l * 22 + C_SCAT, (float)(blke[0] >= 2 * Tact / 256 && blke[0] <= MAXRB), 1.f, 0.5f); }
}
__global__ void chk_mup(Params p, int l, int g) {
    const int s = blockIdx.x * blockDim.x + threadIdx.x; if (s >= 256) return;
    const int* blke = (const int*)(p.ws + WS_BLKE); const int nb = blke[0], rb0 = g * RBG, nrb = min(RBG, nb - rb0); if (nrb <= 0) return;
    const unsigned h = hsh(s * 53 + 15 + l + g * 5); const int r = rb0 * 256 + h % (nrb * 256), n = (h >> 17) % EFF, e = blke[8 + (r >> 8)], li = l >> 1;
    const size_t so = ((size_t)li * NEXP + e) * 1024 * EFF; const bf16_t* x = (const bf16_t*)(p.ws + WS_BIG + F_XS) + (size_t)r * 1024; float a = 0.f, b = 0.f;
    for (int k = 0; k < 1024; ++k) { const float xv = bf2f(x[k]); a += xv * p.in[I_MW1][so + (size_t)k * EFF + n]; b += xv * p.in[I_MW3][so + (size_t)k * EFF + n]; }
    const float ex = a / (1.f + expf(-a)) * b;
    if (ex == ex && fabsf(ex) < 1e20f) chk_rep(p, l * 22 + C_MUP, bf2f(((const bf16_t*)(p.ws + WS_BIG + F_ACT))[(size_t)(r - rb0 * 256) * EFF + n]), ex, 0.04f + 0.02f * fabsf(ex));
}
__global__ void chk_mdown(Params p, int l, int g) {
    const int s = blockIdx.x * blockDim.x + threadIdx.x; if (s >= 256) return;
    const int* blke = (const int*)(p.ws + WS_BLKE); const int nb = blke[0], rb0 = g * RBG, nrb = min(RBG, nb - rb0); if (nrb <= 0) return;
    const unsigned h = hsh(s * 59 + 16 + l + g * 5); const int r = rb0 * 256 + h % (nrb * 256), n = (h >> 17) & 1023, e = blke[8 + (r >> 8)], li = l >> 1;
    const size_t so = ((size_t)li * NEXP + e) * 1024 * EFF; const bf16_t* ac = (const bf16_t*)(p.ws + WS_BIG + F_ACT) + (size_t)(r - rb0 * 256) * EFF; float y = 0.f;
    for (int k = 0; k < EFF; ++k) y += bf2f(ac[k]) * p.in[I_MW2][so + (size_t)k * 1024 + n];
    if (y == y && fabsf(y) < 1e20f) chk_rep(p, l * 22 + C_MDOWN, bf2f(((const bf16_t*)(p.ws + WS_BIG + F_XS))[(size_t)r * 1024 + n]), y, 0.02f + 0.02f * fabsf(y));
}
__global__ void chk_encode(Params p, int nslots) {
    const unsigned* dbg = (const unsigned*)(p.ws + WS_CTL) + CW_DBG;
    int first = -1; float e = 0.f;
    for (int i = 0; i < nslots; ++i) { const float v = __uint_as_float(dbg[i]); if (v > 1.0f) { first = i; e = v; break; } }
    if (first < 0) return;
    const size_t n = (size_t)NLAT * 1024;
    for (size_t i = (size_t)blockIdx.x * blockDim.x + threadIdx.x; i < n; i += (size_t)gridDim.x * blockDim.x) p.out[i] = 0.f;
    if (blockIdx.x == 0 && threadIdx.x == 0) {
        int ex = 1 + (int)(4.f * log10f(e)); if (ex > 31) ex = 31; if (ex < 1) ex = 1;
        const double rv = (double)(10 + first) * pow(10.0, (double)ex);
        p.out[0] = (float)sqrt(rv * (double)n);
    }
}
#endif

static bool phase_active(int ph) {
    if (ph < PH_L0) return true;
    const int l = (ph - PH_L0) / PH_PER_L, q = (ph - PH_L0) % PH_PER_L;
    if (q <= Q_F0 || q == Q_LN2) return true;
    if (q >= Q_F1 && q < Q_LN2) { if ((l & 1) == 0) return q == Q_F1; return q < Q_F1 + 2 * NGRP; }
    return false;
}

extern "C" void kernel_launch(void* const* d_in, const int* in_sizes, int n_in, void* d_out, int out_size, void* d_ws, size_t ws_size, hipStream_t stream) {
    static int grid = 0;
    if (grid == 0) {
        if (n_in != 24 || out_size != NLAT * 1024 || ws_size < WS_END) { fprintf(stderr, "kernel_launch: unexpected shapes (n_in %d out %d ws %zu need %zu)\n", n_in, out_size, ws_size, (size_t)WS_END); grid = -1; return; }
        int dev = 0, cus = 0, per_cu = 0;
        if (hipGetDevice(&dev) != hipSuccess || hipDeviceGetAttribute(&cus, hipDeviceAttributeMultiprocessorCount, dev) != hipSuccess) { grid = -1; return; }
        if (hipFuncSetAttribute((const void*)fwd_kernel, hipFuncAttributeMaxDynamicSharedMemorySize, LDS_BYTES) != hipSuccess) { fprintf(stderr, "kernel_launch: hipFuncSetAttribute failed\n"); grid = -1; return; }
        if (hipOccupancyMaxActiveBlocksPerMultiprocessor(&per_cu, (const void*)fwd_kernel, 512, LDS_BYTES) != hipSuccess || per_cu < 1) { fprintf(stderr, "kernel_launch: occupancy query says %d\n", per_cu); (void)hipGetLastError(); per_cu = 1; }
        grid = cus;
    }
    if (grid < 0) return;
    (void)hipMemsetAsync((char*)d_ws + WS_CTL, 0, CTL_BYTES, stream);
    Params p{};
    for (int i = 0; i < 24; ++i) p.in[i] = (const float*)d_in[i];
    p.out = (float*)d_out; p.ws = (unsigned char*)d_ws;
#if MK_MULTI
#ifndef MAXPH
#define MAXPH NPH
#endif
    for (int ph = 0; ph < MAXPH; ++ph) {
        if (!phase_active(ph)) continue;
        p.ph_lo = ph; p.ph_hi = ph + 1;
#if MK_CHECK
        const int cl = ph < PH_L0 ? 0 : (ph - PH_L0) / PH_PER_L, cq = ph < PH_L0 ? -1 : (ph - PH_L0) % PH_PER_L; const bool cmoe = (cl & 1) != 0; const int cT = cl < DEPTH - 1 ? T : NLAT;
        if (cq == Q_OUT) chk_out<<<1, 256, 0, stream>>>(p, cl, cT, 0);
        if (cq == Q_LN1) chk_ln<<<8, 256, 0, stream>>>(p, cl, cT, 1, 0);
        if (cq == Q_F1 && !cmoe) chk_down<<<1, 256, 0, stream>>>(p, cl, cT, 0);
        if (cq == Q_LN2) chk_ln<<<8, 256, 0, stream>>>(p, cl, cT, 2, 0);
#endif
        hipLaunchKernelGGL(fwd_kernel, dim3(grid), dim3(512), LDS_BYTES, stream, p);
#if MK_CHECK
        if (ph == PH_PRO_A) { chk_pro<<<1, 256, 0, stream>>>(p); chk_wmix<<<2, 256, 0, stream>>>(p, 0); }
        if (ph == PH_PRO_B) chk_h<<<2, 256, 0, stream>>>(p, 0);
        if (cq == Q_IN) chk_in<<<3, 256, 0, stream>>>(p, cl);
        if (cq == Q_POOLV) chk_poolv<<<2, 256, 0, stream>>>(p, cl, cT);
        if (cq == Q_RET) chk_ret<<<128, 256, 0, stream>>>(p, cl, cl < DEPTH - 1 ? 1 : 0);
        if (cq == Q_COMB) chk_comb<<<2, 256, 0, stream>>>(p, cl, cT);
        if (cq == Q_MIX) chk_mix<<<1, 256, 0, stream>>>(p, cl, cT);
        if (cq == Q_OUT) chk_out<<<1, 256, 0, stream>>>(p, cl, cT, 1);
        if (cq == Q_LN1) { chk_ln<<<8, 256, 0, stream>>>(p, cl, cT, 1, 1); chk_fw<<<2, 256, 0, stream>>>(p, cl); if (cl + 1 < DEPTH) chk_wmix<<<2, 256, 0, stream>>>(p, cl + 1); }
        if (cq == Q_F0 && !cmoe) chk_up<<<1, 256, 0, stream>>>(p, cl, cT);
        if (cq == Q_F1 && !cmoe) chk_down<<<1, 256, 0, stream>>>(p, cl, cT, 1);
        if (cq == Q_F0 && cmoe) chk_scat<<<2, 256, 0, stream>>>(p, cl, cT);
        if (cmoe && cq >= Q_F1 && cq < Q_F1 + 2 * NGRP) { const int g = (cq - Q_F1) >> 1; if (((cq - Q_F1) & 1) == 0) chk_mup<<<1, 256, 0, stream>>>(p, cl, g); else chk_mdown<<<1, 256, 0, stream>>>(p, cl, g); }
        if (cq == Q_LN2) { chk_ln<<<8, 256, 0, stream>>>(p, cl, cT, 2, 1); if (cl + 1 < DEPTH) chk_h<<<2, 256, 0, stream>>>(p, cl + 1); }
#endif
    }
#if MK_CHECK
    chk_encode<<<1024, 256, 0, stream>>>(p, 88);
#endif
#else
    p.ph_lo = 0; p.ph_hi = NPH;
    hipLaunchKernelGGL(fwd_kernel, dim3(grid), dim3(512), LDS_BYTES, stream, p);
#endif
}
```

```cpp
#include <hip/hip_runtime.h>
#include <stdint.h>
#include <cstdio>

#define MAXPH NPH
#ifndef MK_MULTI
#define MK_MULTI 0
#endif
#ifndef MK_CHECK
#define MK_CHECK 0
#endif

#define DEVINL __device__ __forceinline__
#define LAS __attribute__((address_space(3)))
typedef unsigned short bf16_t;
typedef short bf16x8 __attribute__((ext_vector_type(8)));
typedef short v4i16_t __attribute__((ext_vector_type(4)));
typedef float f32x4 __attribute__((ext_vector_type(4)));
typedef unsigned u32x4 __attribute__((ext_vector_type(4)));
typedef unsigned u32x2 __attribute__((ext_vector_type(2)));

constexpr int D = 1024, BATCH = 16, SEQ = 4096, DEPTH = 4, CTXL = 256, GRIDW = 64;
constexpr int NLAT = BATCH * SEQ, NCTX = BATCH * CTXL, T = NLAT + NCTX;
constexpr int INW = 5632, DFF = 2816, NEXP = 8, EFF = 3584;
constexpr int MAXRB = 552;
constexpr int RBG = 128;
constexpr int NGRP = 5;
constexpr float ALPHA = 1.6817928305074290f;
constexpr float LN_EPS = 1e-5f;
constexpr float KSCALE = 0.08838834764831845f;

constexpr size_t AL(size_t x) { return (x + 255) & ~(size_t)255; }
constexpr size_t U = (size_t)T * 1024 * 2;
constexpr size_t WS_CTL = 0;
constexpr size_t CTL_BYTES = 65536;
constexpr size_t WS_MOD = WS_CTL + CTL_BYTES;
constexpr size_t WS_ROPE = AL(WS_MOD + (size_t)4 * 17 * 6144 * 4);
constexpr size_t WS_CTXS = AL(WS_ROPE + (size_t)4096 * 64 * 8);
constexpr size_t WS_TOKE = AL(WS_CTXS + (size_t)NCTX * 1024 * 4);
constexpr size_t WS_TOKW = AL(WS_TOKE + (size_t)T * 8);
constexpr size_t WS_TOKD = AL(WS_TOKW + (size_t)T * 8);
constexpr size_t WS_WGCNT = AL(WS_TOKD + (size_t)T * 8);
constexpr size_t WS_BLKE = AL(WS_WGCNT + 256 * 8 * 4);
constexpr size_t WS_WMIX = AL(WS_BLKE + (MAXRB + 8) * 4);
constexpr size_t WMIX_IN = 0, WMIX_POOL = (size_t)INW * 1024 * 2, WMIX_RET = WMIX_POOL + (size_t)1024 * 512 * 2, WMIX_OUT = WMIX_RET + (size_t)1024 * 1024 * 2, WMIX_BYTES = WMIX_OUT + (size_t)1024 * 1024 * 2;
constexpr size_t WS_A = AL(WS_WMIX + WMIX_BYTES);
constexpr size_t WS_BIG = AL(WS_A + U);
constexpr size_t B_U = 0, B_Q = U / 2, B_K = U, B_V = U + U / 2, B_SG = 2 * U + U / 2, B_GP = 3 * U + U / 2, B_GR = 4 * U + U / 2, B_OF = 5 * U + U / 2, B_OB = 6 * U + U / 2, B_END = 7 * U + U / 2;
constexpr size_t B_URET = B_V, B_Y1 = B_Q, B_MIX = B_OF;
constexpr size_t F_W = 0;
constexpr size_t F_DW2 = (size_t)2 * DFF * 1024 * 2;
constexpr size_t F_EW13 = (size_t)2 * EFF * 1024 * 2, F_EW2 = (size_t)1024 * EFF * 2, F_EALL = (size_t)NEXP * (F_EW13 + F_EW2);
constexpr size_t F_XS = AL(F_EALL);
constexpr size_t F_ACT = AL(F_XS + (size_t)MAXRB * 256 * 1024 * 2);
constexpr size_t F_END_D = F_ACT + (size_t)T * DFF * 2, F_END_M = F_ACT + (size_t)RBG * 256 * EFF * 2;
constexpr size_t WS_END = WS_BIG + B_END;
static_assert(F_END_D <= B_END && F_END_M <= B_END, "FFN stage must fit in BIG");
static_assert(WS_END <= (size_t)1295298688, "workspace budget");

constexpr int CW_BAR = 0;
constexpr int CW_DBG = 4096;

constexpr int LDS_MAIN = 139264;
constexpr int LDS_TAB = LDS_MAIN;
constexpr int LDS_CTL = LDS_MAIN + 1024;
constexpr int LDS_BYTES = LDS_CTL + 256;

DEVINL float bf2f(unsigned b) { return __uint_as_float(b << 16); }
DEVINL float bflo(unsigned w) { return __uint_as_float(w << 16); }
DEVINL float bfhi(unsigned w) { return __uint_as_float(w & 0xffff0000u); }
typedef __bf16 bf16v2_t __attribute__((ext_vector_type(2)));
typedef float f32v2_t __attribute__((ext_vector_type(2)));
DEVINL unsigned pk2(float lo, float hi) { const f32v2_t v = {lo, hi}; return __builtin_bit_cast(unsigned, __builtin_convertvector(v, bf16v2_t)); }
DEVINL bf16_t f2bf(float f) { return (bf16_t)(pk2(f, 0.f) & 0xffffu); }
DEVINL float sigmoidf_(float x) { return 1.0f / (1.0f + __expf(-x)); }
DEVINL float siluf_(float x) { return x / (1.0f + __expf(-x)); }
DEVINL int tid_hidden() { int t = threadIdx.x; asm volatile("" : "+v"(t)); return t; }
DEVINL float wave_sum(float v) {
#pragma unroll
    for (int o = 32; o >= 1; o >>= 1) v += __shfl_xor(v, o, 64);
    return v;
}

#define XB_TMO      128
#define XB_XCNT(j)  (256  + 64 * (j))
#define XB_XSUB(j)  (1280 + 64 * (j))
#define XB_XGEN(j)  (2304 + 64 * (j))
#define XB_TOP      3328
#define XB_TOPGEN   3392
#define XCD_BAR_WORDS 3456
#define XB_SPIN_CAP (1u << 20)
DEVINL unsigned xb_ld(unsigned* p)              { return __hip_atomic_load(p, __ATOMIC_RELAXED, __HIP_MEMORY_SCOPE_AGENT); }
DEVINL unsigned xb_add(unsigned* p, unsigned v) { return __hip_atomic_fetch_add(p, v, __ATOMIC_RELAXED, __HIP_MEMORY_SCOPE_AGENT); }
DEVINL unsigned xb_xcc_id() { return (unsigned)__builtin_amdgcn_s_getreg((3 << 11) | 20) & 0xFu; }
#define XB_SPIN(cond, bar) do { unsigned _sp = 0; while (cond) { __builtin_amdgcn_s_sleep(1); \
    if ((++_sp & 255u) == 0u) { if (xb_ld(&(bar)[XB_TMO])) break; if (_sp > XB_SPIN_CAP) { atomicAdd(&(bar)[XB_TMO], 1u); break; } } } } while (0)
struct XcdBarrier { unsigned* bar; unsigned x; volatile LAS unsigned* st; };
DEVINL XcdBarrier xcd_barrier_post(unsigned* bar, volatile LAS unsigned* st) {
    XcdBarrier b; b.bar = bar; b.x = xb_xcc_id(); b.st = st;
    if (threadIdx.x == 0) (void)xb_add(&bar[XB_XCNT(b.x)], 1u);
    return b;
}
DEVINL void xcd_barrier_complete(unsigned* bar, unsigned x, unsigned& nloc, unsigned& nx) {
    const unsigned G = gridDim.x * gridDim.y * gridDim.z;
    unsigned sum, cnt, mine, sp = 0u;
    for (;;) {
        sum = 0u; cnt = 0u; mine = 0u;
#pragma unroll
        for (unsigned j = 0; j < 16; ++j) { const unsigned c = xb_ld(&bar[XB_XCNT(j)]); sum += c; cnt += (c > 0u) ? 1u : 0u; mine = (j == x) ? c : mine; }
        if (sum == G) break;
        __builtin_amdgcn_s_sleep(1);
        if ((++sp & 255u) == 0u) { if (xb_ld(&bar[XB_TMO])) break; if (sp > XB_SPIN_CAP) { atomicAdd(&bar[XB_TMO], 1u); break; } }
    }
    nloc = mine > 0u ? mine : 1u; nx = cnt > 0u ? cnt : 1u;
}
DEVINL void xcd_barrier(const XcdBarrier& b) {
    asm volatile("s_waitcnt vmcnt(0)" ::: "memory");
    __syncthreads();
    if (threadIdx.x == 0) {
        unsigned* bar = b.bar;
        __builtin_amdgcn_s_waitcnt(0);
        unsigned nloc = b.st[0], nx = b.st[1];
        if (nloc == 0u) { xcd_barrier_complete(bar, b.x, nloc, nx); b.st[0] = nloc; b.st[1] = nx; }
        const unsigned old = xb_add(&bar[XB_XSUB(b.x)], 1u);
        const unsigned gen = old / nloc;
        if (old + 1u == (gen + 1u) * nloc) {
            __builtin_amdgcn_fence(__ATOMIC_RELEASE, "agent");
            asm volatile("s_waitcnt vmcnt(0)" ::: "memory");
            const unsigned og = xb_add(&bar[XB_TOP], 1u);
            const unsigned tg = og / nx;
            if (og + 1u == (tg + 1u) * nx) xb_add(&bar[XB_TOPGEN], 1u);
            else XB_SPIN(xb_ld(&bar[XB_TOPGEN]) == tg, bar);
            __builtin_amdgcn_fence(__ATOMIC_ACQUIRE, "agent");
            xb_add(&bar[XB_XGEN(b.x)], 1u);
            asm volatile("s_waitcnt vmcnt(0)" ::: "memory");
        } else {
            XB_SPIN(xb_ld(&bar[XB_XGEN(b.x)]) == gen, bar);
            __builtin_amdgcn_fence(__ATOMIC_ACQUIRE, "agent");
            asm volatile("s_waitcnt vmcnt(0)" ::: "memory");
        }
    }
    __syncthreads();
}

constexpr int BM = 256, BK = 64, HALF = 128, HTB = HALF * BK * 2, NXCD = 8, WGM = 8;
DEVINL int lds_byte(int r, int c) { const int st = (r >> 4) * 2 + (c >> 5), rr = r & 15, cc = c & 31, ob = rr * 64 + cc * 2; return st * 1024 + (ob ^ (((ob >> 9) & 1) << 5)); }
DEVINL void stage_rc(int b, int& R, int& C) { const int st = b / 1024, sb = b % 1024, swz = sb ^ (((sb >> 9) & 1) << 5); R = (st >> 1) * 16 + swz / 64; C = (st & 1) * 32 + (swz % 64) / 2; }
DEVINL int perm32(int rho) { const int n = rho >> 4, i = rho & 15; return 8 * (i >> 2) + 4 * n + (i & 3); }

struct Unit { int pm, pn; const char* a; const char* b; };

DEVINL bool rect_next(long L, int nM, int nN, int& pm, int& pn) {
    const int nwg = nM * nN; if (L >= nwg) return false;
    int wgid = (int)L; { const int q = nwg / NXCD, r = nwg % NXCD, xcd = wgid % NXCD, off = wgid / NXCD; wgid = (xcd < r ? xcd * (q + 1) : r * (q + 1) + (xcd - r) * q) + off; }
    const int nig = WGM * nN, gid = wgid / nig, fm = gid * WGM, gsz = (nM - fm) < WGM ? (nM - fm) : WGM;
    pm = fm + ((wgid % nig) % gsz); pn = (wgid % nig) / gsz; return true;
}
struct SchedRect {
    const char* A; const char* B; int nM, nN, G, c; size_t tstep;
    DEVINL bool next(int i, Unit& u) const { if (!rect_next((long)i * G + c, nM, nN, u.pm, u.pn)) return false; u.a = A + (size_t)u.pm * tstep; u.b = B + (size_t)u.pn * tstep; return true; }
};
struct SchedIn3 {
    const char* A; const char* B; int G, c; size_t tstep;
    DEVINL bool next(int i, Unit& u) const {
        const long L = (long)i * G + c;
        if (L < 256 * 22) { rect_next(L, 256, 22, u.pm, u.pn); }
        else { const long L2 = L - 256 * 22; if (L2 >= 16 * 6) return false; u.pm = 256 + (int)(L2 / 6); u.pn = 4 + (int)(L2 % 6); }
        u.a = A + (size_t)u.pm * tstep; u.b = B + (size_t)u.pn * tstep; return true; }
};
struct SchedMoe {
    const char* abase; const char* wbase; const int* blke; int rb0, arb0, nrb, nN, G, c; size_t tstep, estride;
    DEVINL bool next(int i, Unit& u) const {
        int pm, pn; if (!rect_next((long)i * G + c, nrb, nN, pm, pn)) return false;
        u.pm = rb0 + pm; u.pn = pn; const int e = blke[8 + u.pm] & 7;
        u.a = abase + (size_t)(u.pm - arb0) * tstep; u.b = wbase + (size_t)e * estride + (size_t)pn * tstep; return true; }
};

template <class Epi, class Sched>
DEVINL void gemm_phase(LAS unsigned char* lds, const int K, const Sched& S, const Epi& E) {
    int tid = threadIdx.x; asm volatile("" : "+v"(tid));
    const int wid = __builtin_amdgcn_readfirstlane(tid >> 6), lane = tid & 63, wr = wid >> 2, wc = wid & 3, fr = lane & 15, fq = lane >> 4;
    const int nt = K / BK;
    unsigned voffA[2], voffB[2];
#pragma unroll
    for (int i = 0; i < 2; ++i) { int R, C; stage_rc(tid * 16 + i * 8192, R, C); const int Rb = Epi::PERM ? ((R & ~31) + perm32(R & 31)) : R;
        voffA[i] = (unsigned)(R * K + C) * 2u; voffB[i] = (unsigned)(Rb * K + C) * 2u; }
    const size_t kstep = (size_t)(BK * 2);
    const size_t hstep = (size_t)HALF * K * 2;
    const unsigned ldsw = (unsigned)wid * 1024u;
    const int aoff = lds_byte(wr * 64 + fr, fq * 8), boff = lds_byte(wc * 32 + fr, fq * 8);
#define PG8_SA(b, h) (((b) * 2 + (h)) * HTB)
#define PG8_SB(b, h) ((4 + (b) * 2 + (h)) * HTB)
#define PG8_STAGE(bufoff, gbase, voff) do { _Pragma("unroll") for (int _i = 0; _i < 2; ++_i) \
        __builtin_amdgcn_global_load_lds((const unsigned*)((const char*)(gbase) + (voff)[_i]), (LAS unsigned*)(lds + (bufoff) + ldsw + _i * 8192), 16, 0, 0); } while (0)
#define PG8_LDA(dst, b, h) do { _Pragma("unroll") for (int m = 0; m < 4; ++m) _Pragma("unroll") for (int k = 0; k < 2; ++k) dst[m][k] = *(const LAS bf16x8*)(lds + PG8_SA(b, h) + aoff + m * 2048 + k * 1024); } while (0)
#define PG8_LDB(dst, b, h) do { _Pragma("unroll") for (int n = 0; n < 2; ++n) _Pragma("unroll") for (int k = 0; k < 2; ++k) dst[n][k] = *(const LAS bf16x8*)(lds + PG8_SB(b, h) + boff + n * 2048 + k * 1024); } while (0)
#define PG8_MMA(ai, bj, At, Bt) do { __builtin_amdgcn_s_setprio(1); _Pragma("unroll") for (int m = 0; m < 4; ++m) _Pragma("unroll") for (int n = 0; n < 2; ++n) _Pragma("unroll") for (int k = 0; k < 2; ++k) \
        acc[ai][bj][m][n] = __builtin_amdgcn_mfma_f32_16x16x32_bf16(Bt[n][k], At[m][k], acc[ai][bj][m][n], 0, 0, 0); __builtin_amdgcn_s_setprio(0); } while (0)
#define PG8_WAIT_V(n) asm volatile("s_waitcnt vmcnt(" #n ")" ::: "memory")
#define PG8_WAIT_L(n) asm volatile("s_waitcnt lgkmcnt(" #n ")" ::: "memory")
#define PG8_BAR __builtin_amdgcn_s_barrier()
#define PG8_SCHED __builtin_amdgcn_sched_barrier(0)
    Unit cur, nxt; int ui = 0;
    if (!S.next(0, cur)) return;
    f32x4 acc[2][2][4][2];
#pragma unroll
    for (int a = 0; a < 2; ++a)
#pragma unroll
        for (int b = 0; b < 2; ++b)
#pragma unroll
            for (int m = 0; m < 4; ++m)
#pragma unroll
                for (int n = 0; n < 2; ++n) acc[a][b][m][n] = (f32x4){0.f, 0.f, 0.f, 0.f};
    bf16x8 At[4][2], B0[2][2], B1[2][2];
    const char* cA = cur.a; const char* cB = cur.b;
    PG8_STAGE(PG8_SB(0, 0), cB, voffB); PG8_STAGE(PG8_SA(0, 0), cA, voffA); PG8_STAGE(PG8_SB(0, 1), cB + hstep, voffB); PG8_STAGE(PG8_SA(0, 1), cA + hstep, voffA);
    if (wr == 1) PG8_BAR;
    PG8_WAIT_V(4); PG8_BAR;
    PG8_STAGE(PG8_SB(1, 0), cB + kstep, voffB); PG8_STAGE(PG8_SA(1, 0), cA + kstep, voffA); PG8_STAGE(PG8_SB(1, 1), cB + hstep + kstep, voffB);
    PG8_WAIT_V(6); PG8_BAR;
    for (;;) {
        const bool has_next = S.next(ui + 1, nxt);
        const char* nA = has_next ? nxt.a : cA; const char* nB = has_next ? nxt.b : cB;
        for (int t = 0; t < nt; t += 2) {
            const bool last = (t == nt - 2);
            const char* a1 = cA + (size_t)(t + 1) * kstep;
            const char* a2 = last ? nA : cA + (size_t)(t + 2) * kstep; const char* b2 = last ? nB : cB + (size_t)(t + 2) * kstep;
            const char* a3 = a2 + kstep; const char* b3 = b2 + kstep;
            PG8_LDB(B0, 0, 0); PG8_SCHED; PG8_LDA(At, 0, 0); PG8_STAGE(PG8_SA(1, 1), a1 + hstep, voffA);
            PG8_WAIT_L(8); PG8_BAR; PG8_WAIT_L(0); PG8_MMA(0, 0, At, B0); PG8_BAR; PG8_SCHED;
            PG8_LDB(B1, 0, 1); PG8_STAGE(PG8_SB(0, 0), b2, voffB);
            PG8_BAR; PG8_WAIT_L(0); PG8_MMA(0, 1, At, B1); PG8_BAR;
            PG8_LDA(At, 0, 1); PG8_STAGE(PG8_SA(0, 0), a2, voffA);
            PG8_BAR; PG8_WAIT_L(0); PG8_MMA(1, 0, At, B0); PG8_BAR; PG8_SCHED;
            PG8_STAGE(PG8_SB(0, 1), b2 + hstep, voffB);
            PG8_WAIT_V(6); PG8_BAR; PG8_MMA(1, 1, At, B1); PG8_BAR;
            PG8_LDB(B0, 1, 0); PG8_SCHED; PG8_LDA(At, 1, 0); PG8_STAGE(PG8_SA(0, 1), a2 + hstep, voffA);
            PG8_WAIT_L(8); PG8_BAR; PG8_WAIT_L(0); PG8_MMA(0, 0, At, B0); PG8_BAR; PG8_SCHED;
            PG8_LDB(B1, 1, 1); PG8_STAGE(PG8_SB(1, 0), b3, voffB);
            PG8_BAR; PG8_WAIT_L(0); PG8_MMA(0, 1, At, B1); PG8_BAR;
            PG8_LDA(At, 1, 1); PG8_STAGE(PG8_SA(1, 0), a3, voffA);
            PG8_BAR; PG8_WAIT_L(0); PG8_MMA(1, 0, At, B0); PG8_BAR; PG8_SCHED;
            PG8_STAGE(PG8_SB(1, 1), b3 + hstep, voffB);
            PG8_WAIT_V(6); PG8_BAR; PG8_MMA(1, 1, At, B1); PG8_BAR;
        }
        E(acc, cur, wr, wc, fr, fq);
        if (!has_next) break;
#pragma unroll
        for (int a = 0; a < 2; ++a)
#pragma unroll
            for (int b = 0; b < 2; ++b)
#pragma unroll
                for (int m = 0; m < 4; ++m)
#pragma unroll
                    for (int n = 0; n < 2; ++n) acc[a][b][m][n] = (f32x4){0.f, 0.f, 0.f, 0.f};
        cur = nxt; cA = nA; cB = nB; ++ui;
    }
    PG8_WAIT_V(0);
    if (wr == 0) PG8_BAR;
    PG8_BAR;
#undef PG8_SA
#undef PG8_SB
#undef PG8_STAGE
#undef PG8_LDA
#undef PG8_LDB
#undef PG8_MMA
#undef PG8_WAIT_V
#undef PG8_WAIT_L
#undef PG8_BAR
#undef PG8_SCHED
}

typedef const f32x4 (&AccRef)[2][2][4][2];

struct EpiIn {
    static constexpr bool PERM = true;
    bf16_t* big; const float* rope;
    DEVINL void operator()(AccRef acc, const Unit& u, int wr, int wc, int fr, int fq) const {
        const int pn = u.pn; bf16_t* dst; int ldc, colt, kind;
        if (pn < 2)       { dst = (bf16_t*)((char*)big + B_U);  ldc = 512;  colt = pn * 256;        kind = 0; }
        else if (pn < 4)  { dst = (bf16_t*)((char*)big + B_Q);  ldc = 512;  colt = (pn - 2) * 256;  kind = 1; }
        else if (pn < 6)  { dst = (bf16_t*)((char*)big + B_K);  ldc = 512;  colt = (pn - 4) * 256;  kind = 2; }
        else if (pn < 10) { dst = (bf16_t*)((char*)big + B_V);  ldc = 1024; colt = (pn - 6) * 256;  kind = 0; }
        else if (pn < 14) { dst = (bf16_t*)((char*)big + B_SG); ldc = 1024; colt = (pn - 10) * 256; kind = 3; }
        else if (pn < 18) { dst = (bf16_t*)((char*)big + B_GP); ldc = 1024; colt = (pn - 14) * 256; kind = 4; }
        else              { dst = (bf16_t*)((char*)big + B_GR); ldc = 1024; colt = (pn - 18) * 256; kind = 4; }
        const int row0 = u.pm * BM + wr * 64 + fr, col0 = colt + wc * 32 + 8 * fq;
        const bool lat = u.pm < 256;
        const float ks = (kind == 2) ? KSCALE : 1.0f;
#pragma unroll
        for (int ai = 0; ai < 2; ++ai)
#pragma unroll
            for (int m = 0; m < 4; ++m) {
                const int row = row0 + ai * HALF + m * 16;
                bf16_t* rowp = dst + (size_t)row * ldc + col0;
                f32x4 cs0 = (f32x4){1.f, 0.f, 1.f, 0.f}, cs1 = cs0;
                if ((kind == 1 || kind == 2) && lat) { const float* rp = rope + ((size_t)(row & 4095) * 64 + wc * 16 + 4 * fq) * 2; cs0 = *(const f32x4*)rp; cs1 = *(const f32x4*)(rp + 4); }
#pragma unroll
                for (int bj = 0; bj < 2; ++bj) {
                    f32x4 v0 = acc[ai][bj][m][0], v1 = acc[ai][bj][m][1];
                    if (kind == 1 || kind == 2) {
                        f32x4 r0, r1;
                        r0[0] = (v0[0] * cs0[0] - v0[1] * cs0[1]) * ks; r0[1] = (v0[0] * cs0[1] + v0[1] * cs0[0]) * ks;
                        r0[2] = (v0[2] * cs0[2] - v0[3] * cs0[3]) * ks; r0[3] = (v0[2] * cs0[3] + v0[3] * cs0[2]) * ks;
                        r1[0] = (v1[0] * cs1[0] - v1[1] * cs1[1]) * ks; r1[1] = (v1[0] * cs1[1] + v1[1] * cs1[0]) * ks;
                        r1[2] = (v1[2] * cs1[2] - v1[3] * cs1[3]) * ks; r1[3] = (v1[2] * cs1[3] + v1[3] * cs1[2]) * ks;
                        v0 = r0; v1 = r1;
                    } else if (kind == 3) {
#pragma unroll
                        for (int j = 0; j < 4; ++j) { v0[j] = siluf_(v0[j]); v1[j] = siluf_(v1[j]); }
                    } else if (kind == 4) {
#pragma unroll
                        for (int j = 0; j < 4; ++j) { v0[j] = sigmoidf_(v0[j]); v1[j] = sigmoidf_(v1[j]); }
                    }
                    u32x4 w; w.x = pk2(v0[0], v0[1]); w.y = pk2(v0[2], v0[3]); w.z = pk2(v1[0], v1[1]); w.w = pk2(v1[2], v1[3]);
                    *(u32x4*)(rowp + bj * HALF) = w;
                }
                asm volatile("" ::: "memory");
            }
    }
};

template <int MODE  > struct EpiGate {
    static constexpr bool PERM = true;
    bf16_t* out; const bf16_t* gate; const bf16_t* y1;
    DEVINL void operator()(AccRef acc, const Unit& u, int wr, int wc, int fr, int fq) const {
        const int row0 = u.pm * BM + wr * 64 + fr, col0 = u.pn * BM + wc * 32 + 8 * fq;
#pragma unroll
        for (int ai = 0; ai < 2; ++ai)
#pragma unroll
            for (int m = 0; m < 4; ++m) {
                const size_t off = (size_t)(row0 + ai * HALF + m * 16) * 1024 + col0;
#pragma unroll
                for (int bj = 0; bj < 2; ++bj) {
                    f32x4 v0 = acc[ai][bj][m][0], v1 = acc[ai][bj][m][1];
                    if (MODE != 2) {
                        const u32x4 g = *(const u32x4*)(gate + off + bj * HALF);
                        v0[0] *= bflo(g.x); v0[1] *= bfhi(g.x); v0[2] *= bflo(g.y); v0[3] *= bfhi(g.y);
                        v1[0] *= bflo(g.z); v1[1] *= bfhi(g.z); v1[2] *= bflo(g.w); v1[3] *= bfhi(g.w);
                    }
                    if (MODE == 1) {
                        const u32x4 y = *(const u32x4*)(y1 + off + bj * HALF);
                        v0[0] += bflo(y.x); v0[1] += bfhi(y.x); v0[2] += bflo(y.y); v0[3] += bfhi(y.y);
                        v1[0] += bflo(y.z); v1[1] += bfhi(y.z); v1[2] += bflo(y.w); v1[3] += bfhi(y.w);
                    }
                    u32x4 w; w.x = pk2(v0[0], v0[1]); w.y = pk2(v0[2], v0[3]); w.z = pk2(v1[0], v1[1]); w.w = pk2(v1[2], v1[3]);
                    *(u32x4*)(out + off + bj * HALF) = w;
                }
            }
    }
};

struct EpiRes {
    static constexpr bool PERM = false;
    const float* xin_lat; const float* xin_ctx; float* out_lat; float* out_ctx; const float* modl; int which;
    DEVINL void operator()(AccRef acc, const Unit& u, int wr, int wc, int fr, int fq) const {
        const bool lat = u.pm < 256;
        const int rb = lat ? u.pm * BM : u.pm * BM - NLAT;
        const float* xin = lat ? xin_lat : xin_ctx; float* out = lat ? out_lat : out_ctx;
        const float* mv = modl + ((size_t)(lat ? (u.pm >> 4) : 16) * 6 + which) * 1024;
        const int row0 = rb + wr * 64 + fr, col0 = u.pn * BM + wc * 32 + 4 * fq;
        f32x4 bv[2][2];
#pragma unroll
        for (int bj = 0; bj < 2; ++bj)
#pragma unroll
            for (int n = 0; n < 2; ++n) bv[bj][n] = *(const f32x4*)(mv + col0 + bj * HALF + n * 16);
#pragma unroll
        for (int ai = 0; ai < 2; ++ai)
#pragma unroll
            for (int m = 0; m < 4; ++m) {
                const size_t off = (size_t)(row0 + ai * HALF + m * 16) * 1024 + col0;
#pragma unroll
                for (int bj = 0; bj < 2; ++bj)
#pragma unroll
                    for (int n = 0; n < 2; ++n) {
                        const f32x4 xv = *(const f32x4*)(xin + off + bj * HALF + n * 16);
                        *(f32x4*)(out + off + bj * HALF + n * 16) = xv * ALPHA + bv[bj][n] * acc[ai][bj][m][n];
                    }
            }
    }
};

struct EpiSwiglu {
    static constexpr bool PERM = true;
    bf16_t* act; int ldc; int rb0;
    DEVINL void operator()(AccRef acc, const Unit& u, int wr, int wc, int fr, int fq) const {
        const int row0 = (u.pm - rb0) * BM + wr * 64 + fr, col0 = u.pn * HALF + wc * 32 + 8 * fq;
#pragma unroll
        for (int ai = 0; ai < 2; ++ai)
#pragma unroll
            for (int m = 0; m < 4; ++m) {
                const f32x4 a0 = acc[ai][0][m][0], a1 = acc[ai][0][m][1], b0 = acc[ai][1][m][0], b1 = acc[ai][1][m][1];
                f32x4 v0, v1;
#pragma unroll
                for (int j = 0; j < 4; ++j) { v0[j] = siluf_(a0[j]) * b0[j]; v1[j] = siluf_(a1[j]) * b1[j]; }
                u32x4 w; w.x = pk2(v0[0], v0[1]); w.y = pk2(v0[2], v0[3]); w.z = pk2(v1[0], v1[1]); w.w = pk2(v1[2], v1[3]);
                *(u32x4*)(act + (size_t)(row0 + ai * HALF + m * 16) * ldc + col0) = w;
            }
    }
};

struct Params { const float* in[24]; float* out; unsigned char* ws; int ph_lo, ph_hi; };
enum { I_X = 0, I_C, I_CTX, I_CCTX, I_ADAW, I_ADAB, I_WIN, I_POOLW, I_POOLS, I_WPOOLOUT, I_WRETOUT, I_DECAY, I_WOUT, I_LNMG, I_LNMB, I_LNFG, I_LNFB, I_FW1, I_FW3, I_FW2, I_ROUTER, I_MW1, I_MW3, I_MW2 };

constexpr int PH_PRO_A = 0, PH_PRO_B = 1, PH_L0 = 2, PH_PER_L = 20, NPH = PH_L0 + DEPTH * PH_PER_L;
enum { Q_IN = 0, Q_POOLV, Q_RET, Q_COMB, Q_MIX, Q_OUT, Q_LN1, Q_F0, Q_F1  , Q_LN2 = 18 };

template <class RowMap>
DEVINL void cvt_T(LAS float* tl, const float* __restrict__ src, int K, int N, bf16_t* __restrict__ dst, RowMap rm, int rot) {
    const int tid = tid_hidden(), G = gridDim.x;
    const int tn = N / 64, ntile = (K / 64) * tn;
    for (int tile = (blockIdx.x + rot) % G; tile < ntile; tile += G) {
        const int k0 = (tile / tn) * 64, n0 = (tile % tn) * 64;
        const int r = tid >> 4, c4 = (tid & 15) * 4;
#pragma unroll
        for (int p = 0; p < 2; ++p) {
            const f32x4 v = *(const f32x4*)(src + (size_t)(k0 + r + 32 * p) * N + n0 + c4);
            LAS float* d = tl + (r + 32 * p) * 65 + c4; d[0] = v[0]; d[1] = v[1]; d[2] = v[2]; d[3] = v[3];
        }
        __syncthreads();
        const int nl = tid >> 3, k8 = (tid & 7) * 8;
        float e[8];
#pragma unroll
        for (int j = 0; j < 8; ++j) e[j] = tl[(k8 + j) * 65 + nl];
        u32x4 w; w.x = pk2(e[0], e[1]); w.y = pk2(e[2], e[3]); w.z = pk2(e[4], e[5]); w.w = pk2(e[6], e[7]);
        *(u32x4*)(dst + (size_t)rm(n0 + nl) * K + k0 + k8) = w;
        __syncthreads();
    }
}
struct MapId { DEVINL int operator()(int n) const { return n; } };
struct MapIn { DEVINL int operator()(int n) const { if (n < 512 || n >= 1536) return n; const int j = (n - 512) & 127, base = n - j; return base + (j < 64 ? 2 * j : 2 * (j - 64) + 1); } };
struct MapGU { int off; DEVINL int operator()(int n) const { return (n >> 7) * 256 + (n & 127) + off; } };

DEVINL void convert_mixer_weights(const Params& p, LAS unsigned char* lds, int l) {
    LAS float* tl = (LAS float*)lds;
    unsigned char* wm = p.ws + WS_WMIX;
    cvt_T(tl, p.in[I_WIN] + (size_t)l * 1024 * INW, 1024, INW, (bf16_t*)(wm + WMIX_IN), MapIn(), 0);
    cvt_T(tl, p.in[I_WRETOUT] + (size_t)l * 1024 * 1024, 1024, 1024, (bf16_t*)(wm + WMIX_RET), MapId(), 128);
    cvt_T(tl, p.in[I_WOUT] + (size_t)l * 1024 * 1024, 1024, 1024, (bf16_t*)(wm + WMIX_OUT), MapId(), 0);
    const int tid = tid_hidden(), G = gridDim.x;
    LAS float* sW = (LAS float*)lds;
    LAS float* sP = (LAS float*)(lds + 32768);
    const float* pw = p.in[I_POOLW] + (size_t)l * 4 * 128 * 128; const float* ps = p.in[I_POOLS] + (size_t)l * 512; const float* wo = p.in[I_WPOOLOUT] + (size_t)l * 512 * 1024;
    bf16_t* dst = (bf16_t*)(wm + WMIX_POOL);
    for (int item = (blockIdx.x + 64) % G; item < 64; item += G) {
        const int g = item >> 4, n0 = (item & 15) * 64;
        __syncthreads();
        for (int i = tid; i < 128 * 64; i += 512) { const int d = i >> 6, n = i & 63; sW[i] = ps[g * 128 + d] * wo[(size_t)(g * 128 + d) * 1024 + n0 + n]; }
        for (int i = tid; i < 128 * 128; i += 512) { const int c = i >> 7, d = i & 127; sP[c * 129 + d] = pw[(size_t)g * 16384 + i]; }
        __syncthreads();
        const int n = tid & 63, cq = tid >> 6;
        float a[16];
#pragma unroll
        for (int j = 0; j < 16; ++j) a[j] = 0.f;
        for (int d = 0; d < 128; ++d) { const float w = sW[d * 64 + n];
#pragma unroll
            for (int j = 0; j < 16; ++j) a[j] += sP[(cq * 16 + j) * 129 + d] * w; }
        u32x4 w0, w1; w0.x = pk2(a[0], a[1]); w0.y = pk2(a[2], a[3]); w0.z = pk2(a[4], a[5]); w0.w = pk2(a[6], a[7]);
        w1.x = pk2(a[8], a[9]); w1.y = pk2(a[10], a[11]); w1.z = pk2(a[12], a[13]); w1.w = pk2(a[14], a[15]);
        bf16_t* o = dst + (size_t)(n0 + n) * 512 + g * 128 + cq * 16;
        *(u32x4*)o = w0; *(u32x4*)(o + 8) = w1;
    }
    __syncthreads();
}
DEVINL void convert_ffn_weights(const Params& p, LAS unsigned char* lds, int l) {
    LAS float* tl = (LAS float*)lds;
    unsigned char* fw = p.ws + WS_BIG + F_W;
    const int li = l >> 1;
    if ((l & 1) == 0) {
        cvt_T(tl, p.in[I_FW1] + (size_t)li * 1024 * DFF, 1024, DFF, (bf16_t*)fw, MapGU{0}, 0);
        cvt_T(tl, p.in[I_FW3] + (size_t)li * 1024 * DFF, 1024, DFF, (bf16_t*)fw, MapGU{128}, 64);
        cvt_T(tl, p.in[I_FW2] + (size_t)li * DFF * 1024, DFF, 1024, (bf16_t*)(fw + F_DW2), MapId(), 128);
    } else {
        for (int e = 0; e < NEXP; ++e) {
            const size_t so = ((size_t)li * NEXP + e) * 1024 * EFF;
            cvt_T(tl, p.in[I_MW1] + so, 1024, EFF, (bf16_t*)(fw + (size_t)e * F_EW13), MapGU{0}, e * 32);
            cvt_T(tl, p.in[I_MW3] + so, 1024, EFF, (bf16_t*)(fw + (size_t)e * F_EW13), MapGU{128}, e * 32 + 16);
            cvt_T(tl, p.in[I_MW2] + so, EFF, 1024, (bf16_t*)(fw + (size_t)NEXP * F_EW13 + (size_t)e * F_EW2), MapId(), e * 32 + 8);
        }
    }
}

DEVINL void adaln_phase(const Params& p, LAS unsigned char* lds) {
    const int tid = tid_hidden(), G = gridDim.x;
    LAS float* s = (LAS float*)lds;
    LAS float* red = (LAS float*)(lds + 17 * 1024 * 4);
    for (int i = tid; i < 17 * 1024; i += 512) { const float v = i < 16 * 1024 ? p.in[I_C][i] : p.in[I_CCTX][i - 16 * 1024]; s[i] = v / (1.0f + __expf(-v)); }
    __syncthreads();
    float* mod = (float*)(p.ws + WS_MOD);
    for (int item = blockIdx.x; item < 4 * 96; item += G) {
        const int l = item / 96, n = (item % 96) * 64 + (tid & 63), kq = tid >> 6;
        const float* w = p.in[I_ADAW] + (size_t)l * 1024 * 6144 + n;
        float a[17];
#pragma unroll
        for (int r = 0; r < 17; ++r) a[r] = 0.f;
        for (int k = kq * 128; k < kq * 128 + 128; ++k) { const float wv = w[(size_t)k * 6144];
#pragma unroll
            for (int r = 0; r < 17; ++r) a[r] += s[r * 1024 + k] * wv; }
#pragma unroll
        for (int r = 0; r < 17; ++r) red[(kq * 17 + r) * 64 + (tid & 63)] = a[r];
        __syncthreads();
        for (int i = tid; i < 17 * 64; i += 512) { const int r = i >> 6, c = i & 63; float v = 0.f;
#pragma unroll
            for (int q = 0; q < 8; ++q) v += red[(q * 17 + r) * 64 + c];
            const int nn = (item % 96) * 64 + c; mod[((size_t)l * 17 + r) * 6144 + nn] = v + p.in[I_ADAB][(size_t)l * 6144 + nn]; }
        __syncthreads();
    }
}
DEVINL void rope_phase(const Params& p) {
    float* tab = (float*)(p.ws + WS_ROPE);
    for (int i = blockIdx.x * 512 + tid_hidden(); i < 4096 * 64; i += gridDim.x * 512) {
        const int pos = i >> 6, f = i & 63;
        const float inv = expf(-logf(10000.0f) * (float)(f & 31) / 32.0f);
        const float ang = (float)(f < 32 ? (pos >> 6) : (pos & 63)) * inv;
        float sn, cs; sincosf(ang, &sn, &cs);
        tab[2 * i] = cs; tab[2 * i + 1] = sn;
    }
}

DEVINL const float* row_in(const Params& p, int l, int t) {
    if (l == 0) return t < NLAT ? p.in[I_X] + (size_t)t * 1024 : p.in[I_CTX] + (size_t)(t - NLAT) * 1024;
    return t < NLAT ? p.out + (size_t)t * 1024 : (const float*)(p.ws + WS_CTXS) + (size_t)(t - NLAT) * 1024;
}
DEVINL float* row_st(const Params& p, int t) { return t < NLAT ? p.out + (size_t)t * 1024 : (float*)(p.ws + WS_CTXS) + (size_t)(t - NLAT) * 1024; }
DEVINL const float* mod_row(const Params& p, int l, int t, int which) { const int r = t < NLAT ? (t >> 12) : 16; return (const float*)(p.ws + WS_MOD) + (((size_t)l * 17 + r) * 6 + which) * 1024; }

DEVINL void modulate0_phase(const Params& p) {
    const int tid = tid_hidden(), lane = tid & 63, gw = blockIdx.x * 8 + (tid >> 6), nw = gridDim.x * 8;
    bf16_t* h = (bf16_t*)(p.ws + WS_A);
    for (int t = gw; t < T; t += nw) {
        const float* x = row_in(p, 0, t); const float* sh = mod_row(p, 0, t, 0); const float* sc = mod_row(p, 0, t, 1);
#pragma unroll
        for (int j = 0; j < 4; ++j) { const int c = j * 256 + lane * 4; const f32x4 xv = *(const f32x4*)(x + c), a = *(const f32x4*)(sh + c), b = *(const f32x4*)(sc + c);
            const f32x4 y = xv * (b + 1.0f) + a; u32x2 w; w.x = pk2(y[0], y[1]); w.y = pk2(y[2], y[3]); *(u32x2*)(h + (size_t)t * 1024 + c) = w; }
    }
}

DEVINL void poolv_phase(const Params& p, int Tact) {
    const int tid = tid_hidden(), lane = tid & 63, gw = blockIdx.x * 8 + (tid >> 6), nw = gridDim.x * 8;
    const bf16_t* u = (const bf16_t*)(p.ws + WS_BIG + B_U); bf16_t* vm = (bf16_t*)(p.ws + WS_A);
    for (int idx = gw; idx < Tact * 4; idx += nw) {
        const int t = idx >> 2, g = idx & 3, ch = g * 128 + lane * 2;
        if (t >= NLAT) { *(unsigned*)(vm + (size_t)t * 512 + ch) = *(const unsigned*)(u + (size_t)t * 512 + ch); continue; }
        const int w = 2 << g, left = w >> 1, right = w - 1 - left;
        const int r = (t >> 6) & 63; const int lo = max(r - left, 0), hi = min(r + right, 63);
        float s0 = 0.f, s1 = 0.f;
        for (int rr = lo; rr <= hi; ++rr) { const unsigned v = *(const unsigned*)(u + (size_t)(t + (rr - r) * 64) * 512 + ch); s0 += bflo(v); s1 += bfhi(v); }
        const float inv = 1.0f / (float)(hi - lo + 1);
        *(unsigned*)(vm + (size_t)t * 512 + ch) = pk2(s0 * inv, s1 * inv);
    }
}
DEVINL void poolh_phase(const Params& p, int Tact) {
    const int tid = tid_hidden(), lane = tid & 63, gw = blockIdx.x * 8 + (tid >> 6), nw = gridDim.x * 8;
    bf16_t* u = (bf16_t*)(p.ws + WS_BIG + B_U); const bf16_t* vm = (const bf16_t*)(p.ws + WS_A);
    for (int idx = gw; idx < Tact * 4; idx += nw) {
        const int t = idx >> 2, g = idx & 3, ch = g * 128 + lane * 2;
        const int w = 2 << g, left = w >> 1, right = w - 1 - left;
        const int pos = t < NLAT ? (t & 63) : ((t - NLAT) & 255), last = t < NLAT ? 63 : 255;
        const int lo = max(pos - left, 0), hi = min(pos + right, last);
        float s0 = 0.f, s1 = 0.f;
        for (int cc = lo; cc <= hi; ++cc) { const unsigned v = *(const unsigned*)(vm + (size_t)(t + (cc - pos)) * 512 + ch); s0 += bflo(v); s1 += bfhi(v); }
        const float inv = 1.0f / (float)(hi - lo + 1);
        const unsigned uv = *(const unsigned*)(u + (size_t)t * 512 + ch);
        *(unsigned*)(u + (size_t)t * 512 + ch) = pk2(s0 * inv - bflo(uv), s1 * inv - bfhi(uv));
    }
}
DEVINL void combine_phase(const Params& p, int Tact) {
    const int tid = tid_hidden(), lane = tid & 63, gw = blockIdx.x * 8 + (tid >> 6), nw = gridDim.x * 8;
    const bf16_t* of = (const bf16_t*)(p.ws + WS_BIG + B_OF); const bf16_t* ob = (const bf16_t*)(p.ws + WS_BIG + B_OB); const bf16_t* sg = (const bf16_t*)(p.ws + WS_BIG + B_SG);
    bf16_t* ur = (bf16_t*)(p.ws + WS_BIG + B_URET);
    for (int t = gw; t < Tact; t += nw) {
#pragma unroll
        for (int j = 0; j < 4; ++j) {
            const size_t off = (size_t)t * 1024 + j * 256 + lane * 4;
            const u32x2 a = *(const u32x2*)(of + off), b = *(const u32x2*)(ob + off), g = *(const u32x2*)(sg + off);
            float o[4] = {bflo(a.x) + bflo(b.x), bfhi(a.x) + bfhi(b.x), bflo(a.y) + bflo(b.y), bfhi(a.y) + bfhi(b.y)};
            const float mean = wave_sum(o[0] + o[1] + o[2] + o[3]) * (1.0f / 256.0f);
            float q = 0.f;
#pragma unroll
            for (int e = 0; e < 4; ++e) { o[e] -= mean; q += o[e] * o[e]; }
            const float rstd = rsqrtf(wave_sum(q) * (1.0f / 256.0f) + LN_EPS);
            u32x2 w; w.x = pk2(bflo(g.x) * o[0] * rstd, bfhi(g.x) * o[1] * rstd); w.y = pk2(bflo(g.y) * o[2] * rstd, bfhi(g.y) * o[3] * rstd);
            *(u32x2*)(ur + off) = w;
        }
    }
}

DEVINL void ln1_phase(const Params& p, LAS unsigned char* lds, int l, int Tact) {
    const int tid = tid_hidden(), lane = tid & 63, wv = tid >> 6, G = gridDim.x;
    const bool moe = (l & 1) != 0;
    LAS float* sR = (LAS float*)lds;
    LAS int* sCnt = (LAS int*)(lds + 32768);
    if (moe) { const float* wr = p.in[I_ROUTER] + (size_t)(l >> 1) * 1024 * 8; for (int i = tid; i < 8192; i += 512) sR[i] = wr[i]; if (tid < 8) sCnt[tid] = 0; }
    __syncthreads();
    const float* gam = p.in[I_LNMG] + (size_t)l * 1024; const float* bet = p.in[I_LNMB] + (size_t)l * 1024;
    bf16_t* h2 = (bf16_t*)(p.ws + WS_A);
    int* toke = (int*)(p.ws + WS_TOKE); float* tokw = (float*)(p.ws + WS_TOKW);
    const int per = (Tact + G - 1) / G, t0 = blockIdx.x * per, t1 = min(t0 + per, Tact);
    for (int t = t0 + wv; t < t1; t += 8) {
        float* x = row_st(p, t); const float* sh = mod_row(p, l, t, 3); const float* sc = mod_row(p, l, t, 4);
        f32x4 z[4]; float s = 0.f;
#pragma unroll
        for (int j = 0; j < 4; ++j) { z[j] = *(const f32x4*)(x + j * 256 + lane * 4); s += z[j][0] + z[j][1] + z[j][2] + z[j][3]; }
        const float mean = wave_sum(s) * (1.0f / 1024.0f);
        float q = 0.f;
#pragma unroll
        for (int j = 0; j < 4; ++j) { z[j] -= mean; q += z[j][0] * z[j][0] + z[j][1] * z[j][1] + z[j][2] * z[j][2] + z[j][3] * z[j][3]; }
        const float rstd = rsqrtf(wave_sum(q) * (1.0f / 1024.0f) + LN_EPS);
        float lg[8];
#pragma unroll
        for (int e = 0; e < 8; ++e) lg[e] = 0.f;
#pragma unroll
        for (int j = 0; j < 4; ++j) { const int c = j * 256 + lane * 4;
            const f32x4 xv = z[j] * rstd * *(const f32x4*)(gam + c) + *(const f32x4*)(bet + c);
            *(f32x4*)(x + c) = xv;
            const f32x4 hv = xv * (*(const f32x4*)(sc + c) + 1.0f) + *(const f32x4*)(sh + c);
            u32x2 w; w.x = pk2(hv[0], hv[1]); w.y = pk2(hv[2], hv[3]); *(u32x2*)(h2 + (size_t)t * 1024 + c) = w;
            if (moe) {
#pragma unroll
                for (int i = 0; i < 4; ++i) { const f32x4 r0 = *(const LAS f32x4*)(sR + (c + i) * 8), r1 = *(const LAS f32x4*)(sR + (c + i) * 8 + 4);
                    lg[0] += hv[i] * r0[0]; lg[1] += hv[i] * r0[1]; lg[2] += hv[i] * r0[2]; lg[3] += hv[i] * r0[3];
                    lg[4] += hv[i] * r1[0]; lg[5] += hv[i] * r1[1]; lg[6] += hv[i] * r1[2]; lg[7] += hv[i] * r1[3]; }
            }
        }
        if (moe) {
#pragma unroll
            for (int e = 0; e < 8; ++e) lg[e] = wave_sum(lg[e]);
            int e0 = 0; float m0 = lg[0];
#pragma unroll
            for (int e = 1; e < 8; ++e) if (lg[e] > m0) { m0 = lg[e]; e0 = e; }
            int e1 = -1; float m1 = -3.0e38f;
#pragma unroll
            for (int e = 0; e < 8; ++e) if (e != e0 && lg[e] > m1) { m1 = lg[e]; e1 = e; }
            if (e1 < 0) { e1 = (e0 + 1) & 7; m1 = m0; }
            const float ex = __expf(m1 - m0), w0 = 1.0f / (1.0f + ex), w1 = ex / (1.0f + ex);
            if (lane == 0) { toke[2 * t] = e0; toke[2 * t + 1] = e1; tokw[2 * t] = w0; tokw[2 * t + 1] = w1; __hip_atomic_fetch_add(&sCnt[e0], 1, __ATOMIC_RELAXED, __HIP_MEMORY_SCOPE_WORKGROUP); __hip_atomic_fetch_add(&sCnt[e1], 1, __ATOMIC_RELAXED, __HIP_MEMORY_SCOPE_WORKGROUP); }
        }
    }
    __syncthreads();
    if (moe && tid < 8) ((int*)(p.ws + WS_WGCNT))[blockIdx.x * 8 + tid] = sCnt[tid];
    __syncthreads();
}

DEVINL void moe_scatter_phase(const Params& p, LAS unsigned char* lds, int Tact) {
    const int tid = tid_hidden(), lane = tid & 63, wv = tid >> 6, G = gridDim.x;
    LAS int* sC = (LAS int*)lds;
    LAS int* sBase = (LAS int*)(lds + 16384);
    LAS int* sE = (LAS int*)(lds + 16384 + 256);
    LAS int* sD = (LAS int*)(lds + 16384 + 256 + 4096);
    const int* wgc = (const int*)(p.ws + WS_WGCNT);
    for (int i = tid; i < G * 8; i += 512) sC[i] = wgc[i];
    __syncthreads();
    if (tid < 8) { int tot = 0, before = 0; for (int g = 0; g < G; ++g) { const int c = sC[g * 8 + tid]; if (g < (int)blockIdx.x) before += c; tot += c; } sBase[tid] = before; sBase[8 + tid] = (tot + 255) / 256 * 256; }
    __syncthreads();
    if (tid == 0) { int acc = 0; for (int e = 0; e < 8; ++e) { const int pd = sBase[8 + e]; sBase[e] += acc; acc += pd; sBase[8 + e] = acc; } }
    __syncthreads();
    const int per = (Tact + G - 1) / G, t0 = blockIdx.x * per, t1 = min(t0 + per, Tact), na = max(t1 - t0, 0) * 2;
    const int* toke = (const int*)(p.ws + WS_TOKE); int* tokd = (int*)(p.ws + WS_TOKD);
    for (int a = tid; a < na; a += 512) sE[a] = toke[2 * t0 + a] & 7;
    __syncthreads();
    for (int a = tid; a < na; a += 512) { const int e = sE[a]; int r = 0; for (int b = 0; b < a; ++b) r += (sE[b] == e) ? 1 : 0; int d = sBase[e] + r; d = min(max(d, 0), MAXRB * 256 - 1); sD[a] = d; tokd[2 * t0 + a] = d; }
    if (blockIdx.x == 0) {
        int* blke = (int*)(p.ws + WS_BLKE);
        if (tid == 0) blke[0] = sBase[15] / 256;
        for (int rb = tid; rb < MAXRB; rb += 512) { int e = 0; while (e < 7 && rb * 256 >= sBase[8 + e]) ++e; blke[8 + rb] = e; }
    }
    __syncthreads();
    const bf16_t* h2 = (const bf16_t*)(p.ws + WS_A); bf16_t* xs = (bf16_t*)(p.ws + WS_BIG + F_XS);
    for (int a = wv; a < na; a += 8) { const int t = t0 + (a >> 1), d = sD[a];
        const u32x4 v0 = *(const u32x4*)(h2 + (size_t)t * 1024 + lane * 8), v1 = *(const u32x4*)(h2 + (size_t)t * 1024 + 512 + lane * 8);
        *(u32x4*)(xs + (size_t)d * 1024 + lane * 8) = v0; *(u32x4*)(xs + (size_t)d * 1024 + 512 + lane * 8) = v1; }
    __syncthreads();
}

DEVINL void ln2_phase(const Params& p, int l, int Tact) {
    const int tid = tid_hidden(), lane = tid & 63, gw = blockIdx.x * 8 + (tid >> 6), nw = gridDim.x * 8;
    const bool moe = (l & 1) != 0;
    const float* gam = p.in[I_LNFG] + (size_t)l * 1024; const float* bet = p.in[I_LNFB] + (size_t)l * 1024;
    bf16_t* h = (bf16_t*)(p.ws + WS_A); const bf16_t* yk = (const bf16_t*)(p.ws + WS_BIG + F_XS);
    const int* tokd = (const int*)(p.ws + WS_TOKD); const float* tokw = (const float*)(p.ws + WS_TOKW);
    for (int t = gw; t < Tact; t += nw) {
        float* x = row_st(p, t);
        f32x4 z[4]; float s = 0.f;
        int d0 = 0, d1 = 0; float w0 = 0.f, w1 = 0.f; const float* m5 = nullptr;
        if (moe) { d0 = tokd[2 * t]; d1 = tokd[2 * t + 1]; w0 = tokw[2 * t]; w1 = tokw[2 * t + 1]; m5 = mod_row(p, l, t, 5); }
#pragma unroll
        for (int j = 0; j < 4; ++j) { const int c = j * 256 + lane * 4; z[j] = *(const f32x4*)(x + c);
            if (moe) { const u32x2 a = *(const u32x2*)(yk + (size_t)d0 * 1024 + c), b = *(const u32x2*)(yk + (size_t)d1 * 1024 + c);
                f32x4 f; f[0] = w0 * bflo(a.x) + w1 * bflo(b.x); f[1] = w0 * bfhi(a.x) + w1 * bfhi(b.x); f[2] = w0 * bflo(a.y) + w1 * bflo(b.y); f[3] = w0 * bfhi(a.y) + w1 * bfhi(b.y);
                z[j] = z[j] * ALPHA + *(const f32x4*)(m5 + c) * f; }
            s += z[j][0] + z[j][1] + z[j][2] + z[j][3]; }
        const float mean = wave_sum(s) * (1.0f / 1024.0f);
        float q = 0.f;
#pragma unroll
        for (int j = 0; j < 4; ++j) { z[j] -= mean; q += z[j][0] * z[j][0] + z[j][1] * z[j][1] + z[j][2] * z[j][2] + z[j][3] * z[j][3]; }
        const float rstd = rsqrtf(wave_sum(q) * (1.0f / 1024.0f) + LN_EPS);
        const float* sh = nullptr; const float* sc = nullptr;
        if (l + 1 < DEPTH) { sh = mod_row(p, l + 1, t, 0); sc = mod_row(p, l + 1, t, 1); }
#pragma unroll
        for (int j = 0; j < 4; ++j) { const int c = j * 256 + lane * 4;
            const f32x4 xv = z[j] * rstd * *(const f32x4*)(gam + c) + *(const f32x4*)(bet + c);
            *(f32x4*)(x + c) = xv;
            if (l + 1 < DEPTH) { const f32x4 hv = xv * (*(const f32x4*)(sc + c) + 1.0f) + *(const f32x4*)(sh + c);
                u32x2 w; w.x = pk2(hv[0], hv[1]); w.y = pk2(hv[2], hv[3]); *(u32x2*)(h + (size_t)t * 1024 + c) = w; }
        }
    }
}

DEVINL bf16x8 cat8(v4i16_t a, v4i16_t b) { bf16x8 r; r[0] = a[0]; r[1] = a[1]; r[2] = a[2]; r[3] = a[3]; r[4] = b[0]; r[5] = b[1]; r[6] = b[2]; r[7] = b[3]; return r; }
DEVINL void retention_phase(const Params& p, LAS unsigned char* lds, int l, bool need_ctx) {
    constexpr int RS = 272;
    int tid = threadIdx.x; asm volatile("" : "+v"(tid));
    const int w = __builtin_amdgcn_readfirstlane(tid >> 6), lane = tid & 63, fr = lane & 15, fq = lane >> 4;
    LAS unsigned char* Qs = lds; LAS unsigned char* Ks = lds + 34816; LAS unsigned char* Vs = lds + 69632; LAS unsigned char* Ps = lds + 104448;
    LAS float* tqd = (LAS float*)(lds + LDS_TAB); LAS float* tkd = tqd + 128;
    const bf16_t* qg = (const bf16_t*)(p.ws + WS_BIG + B_Q); const bf16_t* kg = (const bf16_t*)(p.ws + WS_BIG + B_K); const bf16_t* vg = (const bf16_t*)(p.ws + WS_BIG + B_V);
    const int lr = tid >> 4, lc = tid & 15;
    const int trq = fr >> 2, trp = fr & 3;
    for (int item = blockIdx.x; item < 256; item += gridDim.x) {
        const int dvs = item & 1, dir = (item >> 1) & 1, hd = (item >> 2) & 3, b = item >> 4;
        bf16_t* og = (bf16_t*)(p.ws + WS_BIG + (dir ? B_OB : B_OF));
        const float zl = p.in[I_DECAY][l * 8 + dir * 4 + hd];
        const float lg2 = -log1pf(expf(-zl)) * 1.4426950408889634f;
        __syncthreads();
        if (tid < 128) { tqd[tid] = exp2f(lg2 * (float)(dir ? 128 - tid : tid + 1)); tkd[tid] = exp2f(lg2 * (float)(dir ? tid : 127 - tid)); }
        const float cdec = exp2f(lg2 * 128.0f);
        float afac[4];
#pragma unroll
        for (int jj = 0; jj < 4; ++jj) afac[jj] = exp2f(lg2 * (float)(dir ? (4 * fq + jj - fr) : (fr - 4 * fq - jj)));
        f32x4 S[8];
#pragma unroll
        for (int t = 0; t < 8; ++t) S[t] = (f32x4){0.f, 0.f, 0.f, 0.f};
        u32x4 rq[4], rk[4], rv[4];
#define RET_TOK0(c) ((c) < 2 ? NLAT + b * 256 + (dir ? 1 - (c) : (c)) * 128 : b * 4096 + (dir ? 33 - (c) : (c) - 2) * 128)
#define RET_LOAD(c) do { const int _t0 = RET_TOK0(c); _Pragma("unroll") for (int ps = 0; ps < 4; ++ps) { const size_t _t = (size_t)(_t0 + lr + 32 * ps); \
            rq[ps] = *(const u32x4*)(qg + _t * 512 + hd * 128 + lc * 8); rk[ps] = *(const u32x4*)(kg + _t * 512 + hd * 128 + lc * 8); rv[ps] = *(const u32x4*)(vg + _t * 1024 + hd * 256 + dvs * 128 + lc * 8); } } while (0)
        RET_LOAD(0);
        for (int c = 0; c < 34; ++c) {
            const int tok0 = RET_TOK0(c);
            __syncthreads();
#pragma unroll
            for (int ps = 0; ps < 4; ++ps) { const int o = (lr + 32 * ps) * RS + lc * 16; *(LAS u32x4*)(Qs + o) = rq[ps]; *(LAS u32x4*)(Ks + o) = rk[ps]; *(LAS u32x4*)(Vs + o) = rv[ps]; }
            __syncthreads();
            if (c + 1 < 34) RET_LOAD(c + 1);
            const bool do_out = (c >= 2) || need_ctx;
            if (do_out) {
                bf16x8 qf[4];
#pragma unroll
                for (int s = 0; s < 4; ++s) qf[s] = *(const LAS bf16x8*)(Qs + (16 * w + fr) * RS + (32 * s + 8 * fq) * 2);
                const int i = 16 * w + fr;
#pragma unroll
                for (int t = 0; t < 8; ++t) {
                    const bool live = dir ? (t >= w) : (t <= w);
                    f32x4 a = (f32x4){0.f, 0.f, 0.f, 0.f};
                    if (live) {
#pragma unroll
                        for (int s = 0; s < 4; ++s) { const bf16x8 kf = *(const LAS bf16x8*)(Ks + (16 * t + fr) * RS + (32 * s + 8 * fq) * 2); a = __builtin_amdgcn_mfma_f32_16x16x32_bf16(kf, qf[s], a, 0, 0, 0); }
                        const float bt = __builtin_amdgcn_exp2f(lg2 * 16.0f * (float)(dir ? t - w : w - t));
#pragma unroll
                        for (int jj = 0; jj < 4; ++jj) { const int dd = dir ? (4 * fq + jj - fr) : (fr - 4 * fq - jj); a[jj] = (t != w || dd >= 0) ? a[jj] * (afac[jj] * bt) : 0.f; }
                    }
                    u32x2 pw; pw.x = pk2(a[0], a[1]); pw.y = pk2(a[2], a[3]);
                    *(LAS u32x2*)(Ps + i * RS + (16 * t + 4 * fq) * 2) = pw;
                    if (t & 1) __builtin_amdgcn_sched_barrier(0);
                }
            }
            __syncthreads();
            bf16x8 vf[4];
#pragma unroll
            for (int s = 0; s < 4; ++s) { LAS unsigned char* a0 = Vs + (32 * s + 8 * fq + trq) * RS + (16 * w + 4 * trp) * 2;
                vf[s] = cat8(__builtin_amdgcn_ds_read_tr16_b64_v4i16((LAS v4i16_t*)a0), __builtin_amdgcn_ds_read_tr16_b64_v4i16((LAS v4i16_t*)(a0 + 4 * RS))); }
            if (do_out) {
                bf16x8 Sb[4];
#pragma unroll
                for (int s = 0; s < 4; ++s) { u32x4 t4; t4.x = pk2(S[2 * s][0], S[2 * s][1]); t4.y = pk2(S[2 * s][2], S[2 * s][3]); t4.z = pk2(S[2 * s + 1][0], S[2 * s + 1][1]); t4.w = pk2(S[2 * s + 1][2], S[2 * s + 1][3]); Sb[s] = __builtin_bit_cast(bf16x8, t4); }
#pragma unroll
                for (int it = 0; it < 8; ++it) {
                    const int i = 16 * it + fr;
                    f32x4 a = (f32x4){0.f, 0.f, 0.f, 0.f};
#pragma unroll
                    for (int s = 0; s < 4; ++s) { const u32x2 lo = *(const LAS u32x2*)(Qs + i * RS + (32 * s + 4 * fq) * 2), hi = *(const LAS u32x2*)(Qs + i * RS + (32 * s + 16 + 4 * fq) * 2);
                        u32x4 t4; t4.x = lo.x; t4.y = lo.y; t4.z = hi.x; t4.w = hi.y; a = __builtin_amdgcn_mfma_f32_16x16x32_bf16(Sb[s], __builtin_bit_cast(bf16x8, t4), a, 0, 0, 0); }
                    a *= tqd[i];
#pragma unroll
                    for (int s = 0; s < 4; ++s) if (dir ? (2 * s + 1 >= it) : (2 * s <= it)) { const bf16x8 pb = *(const LAS bf16x8*)(Ps + i * RS + (32 * s + 8 * fq) * 2); a = __builtin_amdgcn_mfma_f32_16x16x32_bf16(vf[s], pb, a, 0, 0, 0); }
                    u32x2 ow; ow.x = pk2(a[0], a[1]); ow.y = pk2(a[2], a[3]);
                    *(u32x2*)(og + (size_t)(tok0 + i) * 1024 + hd * 256 + dvs * 128 + 16 * w + 4 * fq) = ow;
                    if (it & 1) __builtin_amdgcn_sched_barrier(0);
                }
            }
#pragma unroll
            for (int t = 0; t < 8; ++t) S[t] *= cdec;
#pragma unroll
            for (int s = 0; s < 4; ++s) {
                const f32x4 k0 = *(const LAS f32x4*)(tkd + 32 * s + 8 * fq), k1 = *(const LAS f32x4*)(tkd + 32 * s + 8 * fq + 4);
                const u32x4 vv = __builtin_bit_cast(u32x4, vf[s]); u32x4 t4;
                t4.x = pk2(bflo(vv.x) * k0[0], bfhi(vv.x) * k0[1]); t4.y = pk2(bflo(vv.y) * k0[2], bfhi(vv.y) * k0[3]);
                t4.z = pk2(bflo(vv.z) * k1[0], bfhi(vv.z) * k1[1]); t4.w = pk2(bflo(vv.w) * k1[2], bfhi(vv.w) * k1[3]);
                const bf16x8 vsc = __builtin_bit_cast(bf16x8, t4);
#pragma unroll
                for (int t = 0; t < 8; ++t) {
                    LAS unsigned char* a0 = Ks + (32 * s + 8 * fq + trq) * RS + (16 * t + 4 * trp) * 2;
                    const bf16x8 kt = cat8(__builtin_amdgcn_ds_read_tr16_b64_v4i16((LAS v4i16_t*)a0), __builtin_amdgcn_ds_read_tr16_b64_v4i16((LAS v4i16_t*)(a0 + 4 * RS)));
                    S[t] = __builtin_amdgcn_mfma_f32_16x16x32_bf16(kt, vsc, S[t], 0, 0, 0);
                }
                __builtin_amdgcn_sched_barrier(0);
            }
        }
#undef RET_TOK0
#undef RET_LOAD
    }
    __syncthreads();
}

__global__ void __launch_bounds__(512, 2) fwd_kernel(Params p) {
    extern __shared__ __attribute__((aligned(16))) unsigned char lds_raw[];
    LAS unsigned char* lds = (LAS unsigned char*)lds_raw;
    const int tid = threadIdx.x, G = gridDim.x, lo = p.ph_lo, hi = p.ph_hi;
    volatile LAS unsigned* xst = (volatile LAS unsigned*)(lds + LDS_CTL);
    if (tid < 4) xst[tid] = 0u;
    __syncthreads();
    XcdBarrier bar; bar.bar = (unsigned*)(p.ws + WS_CTL) + CW_BAR; bar.x = 0; bar.st = xst;
    const bool multi = (hi - lo) > 1;
    if (multi) bar = xcd_barrier_post((unsigned*)(p.ws + WS_CTL) + CW_BAR, xst);
#ifndef PHM
#define PHM 0xFFFFFFFFu
#endif
#define PM(q) ((PHM >> (q)) & 1u)
#define IN(k) (lo <= (k) && (k) < hi)
#define SEAM(k) do { if ((k) + 1 < hi) xcd_barrier(bar); } while (0)
    unsigned char* big = p.ws + WS_BIG;
    const char* wmix = (const char*)(p.ws + WS_WMIX);

    if (PM(13) && IN(PH_PRO_A)) { adaln_phase(p, lds); rope_phase(p); __syncthreads(); convert_mixer_weights(p, lds, 0); SEAM(PH_PRO_A); }
    if (PM(14) && IN(PH_PRO_B)) { modulate0_phase(p); SEAM(PH_PRO_B); }

    for (int l = 0; l < DEPTH; ++l) {
        const int pb = PH_L0 + l * PH_PER_L;
        if (hi <= pb || lo >= pb + PH_PER_L) continue;
        const bool need_ctx = l < DEPTH - 1;
        const int Tact = need_ctx ? T : NLAT, nMact = Tact / 256;
        const float* modl = (const float*)(p.ws + WS_MOD) + (size_t)l * 17 * 6144;

        if (PM(0) && IN(pb + Q_IN)) {
            EpiIn E{(bf16_t*)big, (const float*)(p.ws + WS_ROPE)};
            if (need_ctx) { SchedRect S{(const char*)(p.ws + WS_A), wmix + WMIX_IN, T / 256, INW / 256, G, (int)blockIdx.x, (size_t)256 * 1024 * 2}; gemm_phase(lds, 1024, S, E); }
            else { SchedIn3 S{(const char*)(p.ws + WS_A), wmix + WMIX_IN, G, (int)blockIdx.x, (size_t)256 * 1024 * 2}; gemm_phase(lds, 1024, S, E); }
            SEAM(pb + Q_IN);
        }
        if (PM(1) && IN(pb + Q_POOLV)) { poolv_phase(p, Tact); SEAM(pb + Q_POOLV); }
        if (PM(2) && IN(pb + Q_RET)) { retention_phase(p, lds, l, need_ctx); SEAM(pb + Q_RET); }
        if (PM(3) && IN(pb + Q_COMB)) { combine_phase(p, Tact); poolh_phase(p, Tact); SEAM(pb + Q_COMB); }
        if (PM(4) && IN(pb + Q_MIX)) {
            { SchedRect S{(const char*)(big + B_U), wmix + WMIX_POOL, nMact, 4, G, (int)blockIdx.x, (size_t)256 * 512 * 2};
              EpiGate<0> E{(bf16_t*)(big + B_Y1), (const bf16_t*)(big + B_GP), nullptr}; gemm_phase(lds, 512, S, E); }
            __syncthreads();
            { SchedRect S{(const char*)(big + B_URET), wmix + WMIX_RET, nMact, 4, G, (int)blockIdx.x, (size_t)256 * 1024 * 2};
              EpiGate<1> E{(bf16_t*)(big + B_MIX), (const bf16_t*)(big + B_GR), (const bf16_t*)(big + B_Y1)}; gemm_phase(lds, 1024, S, E); }
            SEAM(pb + Q_MIX);
        }
        if (PM(5) && IN(pb + Q_OUT)) {
            SchedRect S{(const char*)(big + B_MIX), wmix + WMIX_OUT, nMact, 4, G, (int)blockIdx.x, (size_t)256 * 1024 * 2};
            EpiRes E{l == 0 ? p.in[I_X] : p.out, l == 0 ? p.in[I_CTX] : (const float*)(p.ws + WS_CTXS), p.out, (float*)(p.ws + WS_CTXS), modl, 2};
            gemm_phase(lds, 1024, S, E);
            SEAM(pb + Q_OUT);
        }
        if (PM(6) && IN(pb + Q_LN1)) {
            ln1_phase(p, lds, l, Tact);
            convert_ffn_weights(p, lds, l);
            if (l + 1 < DEPTH) convert_mixer_weights(p, lds, l + 1);
            SEAM(pb + Q_LN1);
        }
        if ((l & 1) == 0) {
            if (PM(7) && IN(pb + Q_F0)) {
                SchedRect S{(const char*)(p.ws + WS_A), (const char*)(big + F_W), nMact, 2 * DFF / 256, G, (int)blockIdx.x, (size_t)256 * 1024 * 2};
                EpiSwiglu E{(bf16_t*)(big + F_ACT), DFF, 0}; gemm_phase(lds, 1024, S, E);
                SEAM(pb + Q_F0);
            }
            if (PM(8) && IN(pb + Q_F1)) {
                SchedRect S{(const char*)(big + F_ACT), (const char*)(big + F_DW2), nMact, 4, G, (int)blockIdx.x, (size_t)256 * DFF * 2};
                EpiRes E{p.out, (const float*)(p.ws + WS_CTXS), p.out, (float*)(p.ws + WS_CTXS), modl, 5};
                gemm_phase(lds, DFF, S, E);
                SEAM(pb + Q_F1);
            }
        } else {
            if (PM(9) && IN(pb + Q_F0)) { moe_scatter_phase(p, lds, Tact); SEAM(pb + Q_F0); }
            const int* blke = (const int*)(p.ws + WS_BLKE);
            for (int g = 0; g < NGRP; ++g) {
                if (PM(10) && IN(pb + Q_F1 + 2 * g)) {
                    const int nb = min(blke[0], MAXRB), rb0 = g * RBG, nrb = min(RBG, nb - rb0);
                    if (nrb > 0) {
                        SchedMoe S{(const char*)(big + F_XS), (const char*)(big + F_W), blke, rb0, 0, nrb, 2 * EFF / 256, G, (int)blockIdx.x, (size_t)256 * 1024 * 2, F_EW13};
                        EpiSwiglu E{(bf16_t*)(big + F_ACT), EFF, rb0}; gemm_phase(lds, 1024, S, E);
                    }
                    SEAM(pb + Q_F1 + 2 * g);
                }
                if (PM(11) && IN(pb + Q_F1 + 2 * g + 1)) {
                    const int nb = min(blke[0], MAXRB), rb0 = g * RBG, nrb = min(RBG, nb - rb0);
                    if (nrb > 0) {
                        SchedMoe S{(const char*)(big + F_ACT), (const char*)(big + F_W + (size_t)NEXP * F_EW13), blke, rb0, rb0, nrb, 4, G, (int)blockIdx.x, (size_t)256 * EFF * 2, F_EW2};
                        EpiGate<2> E{(bf16_t*)(big + F_XS), nullptr, nullptr}; gemm_phase(lds, EFF, S, E);
                    }
                    SEAM(pb + Q_F1 + 2 * g + 1);
                }
            }
        }
        if (PM(12) && IN(pb + Q_LN2)) { ln2_phase(p, l, Tact); SEAM(pb + Q_LN2); }
    }
#undef IN
#undef SEAM
}

#if MK_CHECK
constexpr size_t WS_DBGF = AL(WS_END);
DEVINL unsigned hsh(unsigned x) { x ^= x >> 16; x *= 0x7feb352du; x ^= x >> 15; x *= 0x846ca68bu; x ^= x >> 16; return x; }
DEVINL void chk_rep(const Params& p, int id, float got, float ex, float tol) {
    float e = fabsf(got - ex) / tol; if (!(e == e) || e > 1e30f) e = 1e30f;
    atomicMax((unsigned*)(p.ws + WS_CTL) + CW_DBG + id, __float_as_uint(e));
}
DEVINL float in_stream(const Params& p, int l, int t, int c) { return row_in(p, l, t)[c]; }
DEVINL float modv(const Params& p, int l, int t, int which, int c) { return mod_row(p, l, t, which)[c]; }
DEVINL float bfr(float x) { return bf2f(f2bf(x)); }

enum { C_MOD = 0, C_ROPE, C_WCVT, C_H, C_IN, C_VM, C_RET, C_URET, C_DPOOL, C_MIX, C_OUT, C_LN1X, C_LN1H, C_ROUTE, C_UP, C_DOWN, C_LN2X, C_LN2H, C_SCAT, C_MUP, C_MDOWN, C_FWCVT };

__global__ void chk_pro(Params p) {
    const int s = blockIdx.x * blockDim.x + threadIdx.x; if (s >= 256) return;
    { const unsigned h = hsh(s * 3 + 1); const int l = h & 3, r = (h >> 2) % 17, n = (h >> 8) % 6144;
      float a = 0.f; for (int k = 0; k < 1024; ++k) { const float c = r < 16 ? p.in[I_C][r * 1024 + k] : p.in[I_CCTX][k]; a += c / (1.f + expf(-c)) * p.in[I_ADAW][((size_t)l * 1024 + k) * 6144 + n]; }
      a += p.in[I_ADAB][l * 6144 + n];
      chk_rep(p, C_MOD, ((const float*)(p.ws + WS_MOD))[((size_t)l * 17 + r) * 6144 + n], a, 2e-3f); }
    { const unsigned h = hsh(s * 3 + 2); const int pos = h & 4095, f = (h >> 12) & 63;
      const float inv = expf(-logf(10000.0f) * (float)(f & 31) / 32.0f), ang = (float)(f < 32 ? (pos >> 6) : (pos & 63)) * inv;
      const float* tb = (const float*)(p.ws + WS_ROPE) + ((size_t)pos * 64 + f) * 2;
      chk_rep(p, C_ROPE, tb[0], cosf(ang), 1e-4f); chk_rep(p, C_ROPE, tb[1], sinf(ang), 1e-4f); }
}
__global__ void chk_wmix(Params p, int l) {
    const int s = blockIdx.x * blockDim.x + threadIdx.x; if (s >= 512) return;
    const unsigned h = hsh(s * 5 + 7 + l); const int k = h & 1023, n = (h >> 10) % INW;
    const unsigned char* wm = p.ws + WS_WMIX;
    { const int np = MapIn()(n); const float ex = p.in[I_WIN][((size_t)l * 1024 + k) * INW + n]; chk_rep(p, l * 22 + C_WCVT, bf2f(((const bf16_t*)(wm + WMIX_IN))[(size_t)np * 1024 + k]), ex, 0.01f * fabsf(ex) + 1e-5f); }
    { const int n2 = n & 1023; const float ex = p.in[I_WRETOUT][((size_t)l * 1024 + k) * 1024 + n2]; chk_rep(p, l * 22 + C_WCVT, bf2f(((const bf16_t*)(wm + WMIX_RET))[(size_t)n2 * 1024 + k]), ex, 0.01f * fabsf(ex) + 1e-5f); }
    { const int n2 = n & 1023; const float ex = p.in[I_WOUT][((size_t)l * 1024 + k) * 1024 + n2]; chk_rep(p, l * 22 + C_WCVT, bf2f(((const bf16_t*)(wm + WMIX_OUT))[(size_t)n2 * 1024 + k]), ex, 0.01f * fabsf(ex) + 1e-5f); }
    { const int n2 = n & 1023, kc = k & 511, g = kc >> 7, c = kc & 127; float a = 0.f;
      for (int d = 0; d < 128; ++d) a += p.in[I_POOLW][(((size_t)l * 4 + g) * 128 + c) * 128 + d] * p.in[I_POOLS][l * 512 + g * 128 + d] * p.in[I_WPOOLOUT][((size_t)l * 512 + g * 128 + d) * 1024 + n2];
      chk_rep(p, l * 22 + C_WCVT, bf2f(((const bf16_t*)(wm + WMIX_POOL))[(size_t)n2 * 512 + kc]), a, 0.01f * fabsf(a) + 2e-5f); }
}
__global__ void chk_h(Params p, int l) {
    const int s = blockIdx.x * blockDim.x + threadIdx.x; if (s >= 512) return;
    const unsigned h = hsh(s * 7 + 3 + l); const int t = h % T, c = (h >> 17) & 1023;
    const float ex = in_stream(p, l, t, c) * (1.f + modv(p, l, t, 1, c)) + modv(p, l, t, 0, c);
    chk_rep(p, l * 22 + C_H, bf2f(((const bf16_t*)(p.ws + WS_A))[(size_t)t * 1024 + c]), ex, 0.02f + 0.01f * fabsf(ex));
}
DEVINL float dot_h_win(const Params& p, int l, int t, int n) { const bf16_t* h = (const bf16_t*)(p.ws + WS_A) + (size_t)t * 1024; const float* w = p.in[I_WIN] + (size_t)l * 1024 * INW + n; float a = 0.f; for (int k = 0; k < 1024; ++k) a += bf2f(h[k]) * w[(size_t)k * INW]; return a; }
__global__ void chk_in(Params p, int l) {
    const int s = blockIdx.x * blockDim.x + threadIdx.x; if (s >= 768) return;
    const unsigned h = hsh(s * 11 + 5 + l); int t = h % T; if ((s & 7) == 7) t = NLAT + (h % NCTX);
    int n = (h >> 9) % INW; if ((s & 3) == 1) n = 512 + (h >> 9) % 1024;
    const bool lat = t < NLAT;
    if (l == DEPTH - 1 && !lat && (n < 1024 || n >= 2560)) return;
    const unsigned char* big = p.ws + WS_BIG; const float tol = 0.04f;
    float ex, got;
    if (n < 512) { ex = dot_h_win(p, l, t, n); got = bf2f(((const bf16_t*)(big + B_U))[(size_t)t * 512 + n]); }
    else if (n < 1536) {
        const bool isk = n >= 1024; const int nb = isk ? 1024 : 512, hd = (n - nb) >> 7, j = (n - nb) & 127, i = j & 63;
        const float t1 = dot_h_win(p, l, t, nb + hd * 128 + i), t2 = dot_h_win(p, l, t, nb + hd * 128 + i + 64);
        float cs = 1.f, sn = 0.f;
        if (lat) { const int pos = t & 4095; const float inv = expf(-logf(10000.0f) * (float)(i & 31) / 32.0f), ang = (float)(i < 32 ? (pos >> 6) : (pos & 63)) * inv; cs = cosf(ang); sn = sinf(ang); }
        ex = (j < 64) ? (t1 * cs - t2 * sn) : (t1 * sn + t2 * cs); if (isk) ex *= KSCALE;
        got = bf2f(((const bf16_t*)(big + (isk ? B_K : B_Q)))[(size_t)t * 512 + hd * 128 + 2 * i + (j >= 64 ? 1 : 0)]);
    }
    else if (n < 2560) { ex = dot_h_win(p, l, t, n); got = bf2f(((const bf16_t*)(big + B_V))[(size_t)t * 1024 + n - 1536]); }
    else if (n < 3584) { const float a = dot_h_win(p, l, t, n); ex = a / (1.f + expf(-a)); got = bf2f(((const bf16_t*)(big + B_SG))[(size_t)t * 1024 + n - 2560]); }
    else if (n < 4608) { const float a = dot_h_win(p, l, t, n); ex = 1.f / (1.f + expf(-a)); got = bf2f(((const bf16_t*)(big + B_GP))[(size_t)t * 1024 + n - 3584]); }
    else { const float a = dot_h_win(p, l, t, n); ex = 1.f / (1.f + expf(-a)); got = bf2f(((const bf16_t*)(big + B_GR))[(size_t)t * 1024 + n - 4608]); }
    chk_rep(p, l * 22 + C_IN, got, ex, tol + 0.01f * fabsf(ex));
}
DEVINL float box1(const bf16_t* u, int t, int ch, int stride, int pos, int last, int w) {
    const int left = w >> 1, right = w - 1 - left, lo = max(pos - left, 0), hi = min(pos + right, last); float a = 0.f;
    for (int q = lo; q <= hi; ++q) a += bf2f(u[(size_t)(t + (q - pos) * stride) * 512 + ch]);
    return a / (float)(hi - lo + 1);
}
__global__ void chk_poolv(Params p, int l, int Tact) {
    const int s = blockIdx.x * blockDim.x + threadIdx.x; if (s >= 512) return;
    const unsigned h = hsh(s * 13 + 1 + l); int t = h % NLAT; if ((s & 7) == 7 && Tact > NLAT) t = NLAT + (h % NCTX);
    const int ch = (h >> 7) & 511, w = 2 << (ch >> 7);
    const bf16_t* u = (const bf16_t*)(p.ws + WS_BIG + B_U); const bf16_t* vm = (const bf16_t*)(p.ws + WS_A);
    float* dex = (float*)(p.ws + WS_DBGF);
    if (t < NLAT) {
        const float ex = box1(u, t, ch, 64, (t >> 6) & 63, 63, w);
        chk_rep(p, l * 22 + C_VM, bf2f(vm[(size_t)t * 512 + ch]), ex, 0.02f + 0.01f * fabsf(ex));
        const int left = w >> 1, right = w - 1 - left, c = t & 63, lo = max(c - left, 0), hi = min(c + right, 63); float a = 0.f;
        for (int cc = lo; cc <= hi; ++cc) a += box1(u, t + (cc - c), ch, 64, (t >> 6) & 63, 63, w);
        dex[s] = a / (float)(hi - lo + 1) - bf2f(u[(size_t)t * 512 + ch]);
    } else {
        chk_rep(p, l * 22 + C_VM, bf2f(vm[(size_t)t * 512 + ch]), bf2f(u[(size_t)t * 512 + ch]), 1e-6f);
        dex[s] = box1(u, t, ch, 1, (t - NLAT) & 255, 255, w) - bf2f(u[(size_t)t * 512 + ch]);
    }
}
__global__ void chk_ret(Params p, int l, int need_ctx) {
    __shared__ float red[256];
    const int s = blockIdx.x; const unsigned h = hsh(s * 17 + 9 + l);
    const int dir = s & 1; int t = h % NLAT; int typ = 2;
    if ((s & 7) >= 4 && need_ctx) { typ = ((s & 7) >= 6) ? 1 : 0; const int firstchunk = dir ? 1 : 0; const int ch = typ == 0 ? firstchunk : 1 - firstchunk; t = NLAT + ((h >> 3) % BATCH) * 256 + ch * 128 + (h % 128); }
    const int hd = (h >> 20) & 3, dv = (h >> 22) & 255;
    const unsigned char* big = p.ws + WS_BIG;
    const bf16_t* qg = (const bf16_t*)(big + B_Q); const bf16_t* kg = (const bf16_t*)(big + B_K); const bf16_t* vg = (const bf16_t*)(big + B_V);
    const float zl = p.in[I_DECAY][l * 8 + dir * 4 + hd]; const float lg = -log1pf(expf(-zl));
    const bool lat = t < NLAT; const int b = lat ? t >> 12 : (t - NLAT) >> 8;
    const int tpos = lat ? 256 + (dir ? 4095 - (t & 4095) : (t & 4095)) : (dir ? 255 - ((t - NLAT) & 255) : ((t - NLAT) & 255));
    float acc = 0.f;
    for (int j = threadIdx.x; j < 4352; j += 256) {
        const bool jl = j >= 256; const int tok = jl ? b * 4096 + (dir ? 4095 - (j - 256) : (j - 256)) : NLAT + b * 256 + (dir ? 255 - j : j);
        if (j > tpos) continue;
        if (!lat && jl) continue;
        float d = 0.f; for (int c = 0; c < 128; ++c) d += bf2f(qg[(size_t)t * 512 + hd * 128 + c]) * bf2f(kg[(size_t)tok * 512 + hd * 128 + c]);
        acc += d * expf(lg * (float)(tpos - j)) * bf2f(vg[(size_t)tok * 1024 + hd * 256 + dv]);
    }
    red[threadIdx.x] = acc; __syncthreads();
    for (int o = 128; o > 0; o >>= 1) { if ((int)threadIdx.x < o) red[threadIdx.x] += red[threadIdx.x + o]; __syncthreads(); }
    if (threadIdx.x == 0) { const float ex = red[0]; const float got = bf2f(((const bf16_t*)(big + (dir ? B_OB : B_OF)))[(size_t)t * 1024 + hd * 256 + dv]); if (!(fabsf(got) < 1e30f)) chk_rep(p, 5, 1e6f, 0.f, 1.f); if (!(fabsf(ex) < 1e30f)) chk_rep(p, 4, 1e6f, 0.f, 1.f);
        chk_rep(p, l * 22 + C_RET + typ * 2 + dir, got, ex, 0.1f + 0.03f * fabsf(ex)); }
}
__global__ void chk_comb(Params p, int l, int Tact) {
    const int s = blockIdx.x * blockDim.x + threadIdx.x; if (s >= 512) return;
    const unsigned char* big = p.ws + WS_BIG;
    { const unsigned h = hsh(s * 19 + 4 + l); const int t = h % Tact, col = (h >> 17) & 1023, hb = col & ~255;
      const bf16_t* of = (const bf16_t*)(big + B_OF) + (size_t)t * 1024; const bf16_t* ob = (const bf16_t*)(big + B_OB) + (size_t)t * 1024;
      float m = 0.f; for (int c = 0; c < 256; ++c) m += bf2f(of[hb + c]) + bf2f(ob[hb + c]); m /= 256.f;
      float v = 0.f; for (int c = 0; c < 256; ++c) { const float d = bf2f(of[hb + c]) + bf2f(ob[hb + c]) - m; v += d * d; } v /= 256.f;
      const float ex = bf2f(((const bf16_t*)(big + B_SG))[(size_t)t * 1024 + col]) * (bf2f(of[col]) + bf2f(ob[col]) - m) * rsqrtf(v + LN_EPS);
      chk_rep(p, l * 22 + C_URET, bf2f(((const bf16_t*)(big + B_URET))[(size_t)t * 1024 + col]), ex, 0.02f + 0.01f * fabsf(ex)); }
    { const unsigned h = hsh(s * 13 + 1 + l); int t = h % NLAT; if ((s & 7) == 7 && Tact > NLAT) t = NLAT + (h % NCTX); const int ch = (h >> 7) & 511;
      const float ex = ((const float*)(p.ws + WS_DBGF))[s];
      chk_rep(p, l * 22 + C_DPOOL, bf2f(((const bf16_t*)(big + B_U))[(size_t)t * 512 + ch]), ex, 0.03f + 0.01f * fabsf(ex)); }
}
__global__ void chk_mix(Params p, int l, int Tact) {
    const int s = blockIdx.x * blockDim.x + threadIdx.x; if (s >= 256) return;
    const unsigned char* big = p.ws + WS_BIG; const unsigned h = hsh(s * 23 + 2 + l); const int t = h % Tact, n = (h >> 17) & 1023;
    const bf16_t* d = (const bf16_t*)(big + B_U) + (size_t)t * 512; float yp = 0.f;
    for (int g = 0; g < 4; ++g) for (int dd = 0; dd < 128; ++dd) { float a = 0.f; for (int c = 0; c < 128; ++c) a += bf2f(d[g * 128 + c]) * p.in[I_POOLW][(((size_t)l * 4 + g) * 128 + c) * 128 + dd];
        yp += a * p.in[I_POOLS][l * 512 + g * 128 + dd] * p.in[I_WPOOLOUT][((size_t)l * 512 + g * 128 + dd) * 1024 + n]; }
    float yr = 0.f; const bf16_t* ur = (const bf16_t*)(big + B_URET) + (size_t)t * 1024;
    for (int k = 0; k < 1024; ++k) yr += bf2f(ur[k]) * p.in[I_WRETOUT][((size_t)l * 1024 + k) * 1024 + n];
    const float ex = bf2f(((const bf16_t*)(big + B_GP))[(size_t)t * 1024 + n]) * yp + bf2f(((const bf16_t*)(big + B_GR))[(size_t)t * 1024 + n]) * yr;
    chk_rep(p, l * 22 + C_MIX, bf2f(((const bf16_t*)(big + B_MIX))[(size_t)t * 1024 + n]), ex, 0.03f + 0.02f * fabsf(ex));
}
__global__ void chk_out(Params p, int l, int Tact, int post) {
    const int s = blockIdx.x * blockDim.x + threadIdx.x; if (s >= 256) return;
    const unsigned char* big = p.ws + WS_BIG; const unsigned h = hsh(s * 29 + 6 + l); const int t = h % Tact, n = (h >> 17) & 1023;
    float* st = (float*)(p.ws + WS_DBGF) + 1024;
    if (!post) { float y = 0.f; const bf16_t* mx = (const bf16_t*)(big + B_MIX) + (size_t)t * 1024; for (int k = 0; k < 1024; ++k) y += bf2f(mx[k]) * p.in[I_WOUT][((size_t)l * 1024 + k) * 1024 + n];
        st[s] = ALPHA * in_stream(p, l, t, n) + modv(p, l, t, 2, n) * y; }
    else chk_rep(p, l * 22 + C_OUT, row_st(p, t)[n], st[s], 0.01f + 0.003f * fabsf(st[s]));
}
__global__ void chk_ln(Params p, int l, int Tact, int which  , int post) {
    __shared__ float red[256]; __shared__ float stat[2];
    const int s = blockIdx.x; const unsigned h = hsh(s * 31 + 8 + l + which * 77); const int t = h % Tact; const bool moe = (l & 1) != 0;
    float* st = (float*)(p.ws + WS_DBGF) + 2048 + (size_t)(which - 1) * 8 * 2048 + (size_t)s * 2048;
    const float* gam = p.in[which == 1 ? I_LNMG : I_LNFG] + l * 1024; const float* bet = p.in[which == 1 ? I_LNMB : I_LNFB] + l * 1024;
    if (!post) {
        float z[4]; float a = 0.f;
        for (int q = 0; q < 4; ++q) { const int c = threadIdx.x + 256 * q; float zz = row_st(p, t)[c];
            if (which == 2 && moe) { const int d0 = ((const int*)(p.ws + WS_TOKD))[2 * t], d1 = ((const int*)(p.ws + WS_TOKD))[2 * t + 1]; const float w0 = ((const float*)(p.ws + WS_TOKW))[2 * t], w1 = ((const float*)(p.ws + WS_TOKW))[2 * t + 1];
                const bf16_t* yk = (const bf16_t*)(p.ws + WS_BIG + F_XS); zz = ALPHA * zz + modv(p, l, t, 5, c) * (w0 * bf2f(yk[(size_t)d0 * 1024 + c]) + w1 * bf2f(yk[(size_t)d1 * 1024 + c])); }
            z[q] = zz; a += zz; }
        red[threadIdx.x] = a; __syncthreads(); for (int o = 128; o > 0; o >>= 1) { if ((int)threadIdx.x < o) red[threadIdx.x] += red[threadIdx.x + o]; __syncthreads(); }
        if (threadIdx.x == 0) stat[0] = red[0] / 1024.f; __syncthreads(); const float m = stat[0]; a = 0.f;
        for (int q = 0; q < 4; ++q) a += (z[q] - m) * (z[q] - m);
        __syncthreads(); red[threadIdx.x] = a; __syncthreads(); for (int o = 128; o > 0; o >>= 1) { if ((int)threadIdx.x < o) red[threadIdx.x] += red[threadIdx.x + o]; __syncthreads(); }
        const float rstd = rsqrtf(red[0] / 1024.f + LN_EPS);
        for (int q = 0; q < 4; ++q) { const int c = threadIdx.x + 256 * q; const float x = (z[q] - m) * rstd * gam[c] + bet[c]; st[c] = x;
            float hv = 0.f; if (which == 1) hv = x * (1.f + modv(p, l, t, 4, c)) + modv(p, l, t, 3, c); else if (l + 1 < DEPTH) hv = x * (1.f + modv(p, l + 1, t, 1, c)) + modv(p, l + 1, t, 0, c);
            st[1024 + c] = hv; }
    } else {
        for (int q = 0; q < 4; ++q) { const int c = threadIdx.x + 256 * q;
            chk_rep(p, l * 22 + (which == 1 ? C_LN1X : C_LN2X), row_st(p, t)[c], st[c], 2e-3f + 1e-3f * fabsf(st[c]));
            if (which == 1 || l + 1 < DEPTH) chk_rep(p, l * 22 + (which == 1 ? C_LN1H : C_LN2H), bf2f(((const bf16_t*)(p.ws + WS_A))[(size_t)t * 1024 + c]), st[1024 + c], 0.02f + 0.01f * fabsf(st[1024 + c])); }
        if (which == 1 && moe && threadIdx.x == 0) {
            float lgv[8]; for (int e = 0; e < 8; ++e) { float a = 0.f; for (int c = 0; c < 1024; ++c) a += st[1024 + c] * p.in[I_ROUTER][((size_t)(l >> 1) * 1024 + c) * 8 + e]; lgv[e] = a; }
            int e0 = 0; for (int e = 1; e < 8; ++e) if (lgv[e] > lgv[e0]) e0 = e; int e1 = -1; for (int e = 0; e < 8; ++e) if (e != e0 && (e1 < 0 || lgv[e] > lgv[e1])) e1 = e;
            const float ex = expf(lgv[e1] - lgv[e0]);
            const int* te = (const int*)(p.ws + WS_TOKE); const float* tw = (const float*)(p.ws + WS_TOKW);
            chk_rep(p, l * 22 + C_ROUTE, (float)te[2 * t], (float)e0, 0.5f); chk_rep(p, l * 22 + C_ROUTE, (float)te[2 * t + 1], (float)e1, 0.5f);
            chk_rep(p, l * 22 + C_ROUTE, tw[2 * t], 1.f / (1.f + ex), 2e-3f); chk_rep(p, l * 22 + C_ROUTE, tw[2 * t + 1], ex / (1.f + ex), 2e-3f);
        }
    }
}
__global__ void chk_fw(Params p, int l) {
    const int s = blockIdx.x * blockDim.x + threadIdx.x; if (s >= 512) return;
    const unsigned h = hsh(s * 37 + 11 + l); const unsigned char* fw = p.ws + WS_BIG + F_W; const int li = l >> 1, k = h & 1023;
    if ((l & 1) == 0) { const int n = (h >> 10) % DFF;
        float ex = p.in[I_FW1][((size_t)li * 1024 + k) * DFF + n]; chk_rep(p, l * 22 + C_FWCVT, bf2f(((const bf16_t*)fw)[(size_t)((n >> 7) * 256 + (n & 127)) * 1024 + k]), ex, 0.01f * fabsf(ex) + 1e-5f);
        ex = p.in[I_FW3][((size_t)li * 1024 + k) * DFF + n]; chk_rep(p, l * 22 + C_FWCVT, bf2f(((const bf16_t*)fw)[(size_t)((n >> 7) * 256 + 128 + (n & 127)) * 1024 + k]), ex, 0.01f * fabsf(ex) + 1e-5f);
        ex = p.in[I_FW2][((size_t)li * DFF + n) * 1024 + k]; chk_rep(p, l * 22 + C_FWCVT, bf2f(((const bf16_t*)(fw + F_DW2))[(size_t)k * DFF + n]), ex, 0.01f * fabsf(ex) + 1e-5f);
    } else { const int n = (h >> 10) % EFF, e = (h >> 24) & 7; const size_t so = ((size_t)li * NEXP + e) * 1024 * EFF;
        float ex = p.in[I_MW1][so + (size_t)k * EFF + n]; chk_rep(p, l * 22 + C_FWCVT, bf2f(((const bf16_t*)(fw + (size_t)e * F_EW13))[(size_t)((n >> 7) * 256 + (n & 127)) * 1024 + k]), ex, 0.01f * fabsf(ex) + 1e-5f);
        ex = p.in[I_MW3][so + (size_t)k * EFF + n]; chk_rep(p, l * 22 + C_FWCVT, bf2f(((const bf16_t*)(fw + (size_t)e * F_EW13))[(size_t)((n >> 7) * 256 + 128 + (n & 127)) * 1024 + k]), ex, 0.01f * fabsf(ex) + 1e-5f);
        ex = p.in[I_MW2][so + (size_t)n * 1024 + k]; chk_rep(p, l * 22 + C_FWCVT, bf2f(((const bf16_t*)(fw + (size_t)NEXP * F_EW13 + (size_t)e * F_EW2))[(size_t)k * EFF + n]), ex, 0.01f * fabsf(ex) + 1e-5f);
    }
}
__global__ void chk_up(Params p, int l, int Tact) {
    const int s = blockIdx.x * blockDim.x + threadIdx.x; if (s >= 256) return;
    const unsigned h = hsh(s * 41 + 12 + l); const int t = h % Tact, n = (h >> 17) % DFF, li = l >> 1;
    const bf16_t* h2 = (const bf16_t*)(p.ws + WS_A) + (size_t)t * 1024; float a = 0.f, b = 0.f;
    for (int k = 0; k < 1024; ++k) { const float x = bf2f(h2[k]); a += x * p.in[I_FW1][((size_t)li * 1024 + k) * DFF + n]; b += x * p.in[I_FW3][((size_t)li * 1024 + k) * DFF + n]; }
    const float ex = a / (1.f + expf(-a)) * b;
    chk_rep(p, l * 22 + C_UP, bf2f(((const bf16_t*)(p.ws + WS_BIG + F_ACT))[(size_t)t * DFF + n]), ex, 0.04f + 0.02f * fabsf(ex));
}
__global__ void chk_down(Params p, int l, int Tact, int post) {
    const int s = blockIdx.x * blockDim.x + threadIdx.x; if (s >= 256) return;
    const unsigned h = hsh(s * 43 + 13 + l); const int t = h % Tact, n = (h >> 17) & 1023, li = l >> 1;
    float* st = (float*)(p.ws + WS_DBGF) + 1280;
    if (!post) { const bf16_t* ac = (const bf16_t*)(p.ws + WS_BIG + F_ACT) + (size_t)t * DFF; float y = 0.f; for (int k = 0; k < DFF; ++k) y += bf2f(ac[k]) * p.in[I_FW2][((size_t)li * DFF + k) * 1024 + n];
        st[s] = ALPHA * row_st(p, t)[n] + modv(p, l, t, 5, n) * y; }
    else chk_rep(p, l * 22 + C_DOWN, row_st(p, t)[n], st[s], 0.01f + 0.003f * fabsf(st[s]));
}
__global__ void chk_scat(Params p, int l, int Tact) {
    const int s = blockIdx.x * blockDim.x + threadIdx.x; if (s >= 512) return;
    const unsigned h = hsh(s * 47 + 14 + l); const int t = h % Tact, k = (h >> 20) & 1, c = (h >> 21) & 1023;
    const int d = ((const int*)(p.ws + WS_TOKD))[2 * t + k], e = ((const int*)(p.ws + WS_TOKE))[2 * t + k]; const int* blke = (const int*)(p.ws + WS_BLKE);
    const bool ok = d >= 0 && d < MAXRB * 256 && d < blke[0] * 256;
    chk_rep(p, l * 22 + C_SCAT, ok ? 0.f : 1e6f, 0.f, 1.f);
    if (ok) { chk_rep(p, l * 22 + C_SCAT, (float)blke[8 + (d >> 8)], (float)e, 0.5f);
        chk_rep(p, l * 22 + C_SCAT, bf2f(((const bf16_t*)(p.ws + WS_BIG + F_XS))[(size_t)d * 1024 + c]), bf2f(((const bf16_t*)(p.ws + WS_A))[(size_t)t * 1024 + c]), 1e-6f); }
    if (s == 0) { int tot = 0; for (int i = 0; i < 256 * 8; ++i) tot += ((const int*)(p.ws + WS_WGCNT))[i]; chk_rep(p, l * 22 + C_SCAT, (float)tot, (float)(2 * Tact), 0.5f); chk_rep(p, l * 22 + C_SCAT, (float)(blke[0] >= 2 * Tact / 256 && blke[0] <= MAXRB), 1.f, 0.5f); }
}
__global__ void chk_mup(Params p, int l, int g) {
    const int s = blockIdx.x * blockDim.x + threadIdx.x; if (s >= 256) return;
    const int* blke = (const int*)(p.ws + WS_BLKE); const int nb = blke[0], rb0 = g * RBG, nrb = min(RBG, nb - rb0); if (nrb <= 0) return;
    const unsigned h = hsh(s * 53 + 15 + l + g * 5); const int r = rb0 * 256 + h % (nrb * 256), n = (h >> 17) % EFF, e = blke[8 + (r >> 8)], li = l >> 1;
    const size_t so = ((size_t)li * NEXP + e) * 1024 * EFF; const bf16_t* x = (const bf16_t*)(p.ws + WS_BIG + F_XS) + (size_t)r * 1024; float a = 0.f, b = 0.f;
    for (int k = 0; k < 1024; ++k) { const float xv = bf2f(x[k]); a += xv * p.in[I_MW1][so + (size_t)k * EFF + n]; b += xv * p.in[I_MW3][so + (size_t)k * EFF + n]; }
    const float ex = a / (1.f + expf(-a)) * b;
    if (ex == ex && fabsf(ex) < 1e20f) chk_rep(p, l * 22 + C_MUP, bf2f(((const bf16_t*)(p.ws + WS_BIG + F_ACT))[(size_t)(r - rb0 * 256) * EFF + n]), ex, 0.04f + 0.02f * fabsf(ex));
}
__global__ void chk_mdown(Params p, int l, int g) {
    const int s = blockIdx.x * blockDim.x + threadIdx.x; if (s >= 256) return;
    const int* blke = (const int*)(p.ws + WS_BLKE); const int nb = blke[0], rb0 = g * RBG, nrb = min(RBG, nb - rb0); if (nrb <= 0) return;
    const unsigned h = hsh(s * 59 + 16 + l + g * 5); const int r = rb0 * 256 + h % (nrb * 256), n = (h >> 17) & 1023, e = blke[8 + (r >> 8)], li = l >> 1;
    const size_t so = ((size_t)li * NEXP + e) * 1024 * EFF; const bf16_t* ac = (const bf16_t*)(p.ws + WS_BIG + F_ACT) + (size_t)(r - rb0 * 256) * EFF; float y = 0.f;
    for (int k = 0; k < EFF; ++k) y += bf2f(ac[k]) * p.in[I_MW2][so + (size_t)k * 1024 + n];
    if (y == y && fabsf(y) < 1e20f) chk_rep(p, l * 22 + C_MDOWN, bf2f(((const bf16_t*)(p.ws + WS_BIG + F_XS))[(size_t)r * 1024 + n]), y, 0.02f + 0.02f * fabsf(y));
}
__global__ void chk_encode(Params p, int nslots) {
    const unsigned* dbg = (const unsigned*)(p.ws + WS_CTL) + CW_DBG;
    int first = -1; float e = 0.f;
    for (int i = 0; i < nslots; ++i) { const float v = __uint_as_float(dbg[i]); if (v > 1.0f) { first = i; e = v; break; } }
    if (first < 0) return;
    const size_t n = (size_t)NLAT * 1024;
    for (size_t i = (size_t)blockIdx.x * blockDim.x + threadIdx.x; i < n; i += (size_t)gridDim.x * blockDim.x) p.out[i] = 0.f;
    if (blockIdx.x == 0 && threadIdx.x == 0) {
        int ex = 1 + (int)(4.f * log10f(e)); if (ex > 31) ex = 31; if (ex < 1) ex = 1;
        const double rv = (double)(10 + first) * pow(10.0, (double)ex);
        p.out[0] = (float)sqrt(rv * (double)n);
    }
}
#endif

static bool phase_active(int ph) {
    if (ph < PH_L0) return true;
    const int l = (ph - PH_L0) / PH_PER_L, q = (ph - PH_L0) % PH_PER_L;
    if (q <= Q_F0 || q == Q_LN2) return true;
    if (q >= Q_F1 && q < Q_LN2) { if ((l & 1) == 0) return q == Q_F1; return q < Q_F1 + 2 * NGRP; }
    return false;
}

extern "C" void kernel_launch(void* const* d_in, const int* in_sizes, int n_in, void* d_out, int out_size, void* d_ws, size_t ws_size, hipStream_t stream) {
    static int grid = 0;
    if (grid == 0) {
        if (n_in != 24 || out_size != NLAT * 1024 || ws_size < WS_END) { fprintf(stderr, "kernel_launch: unexpected shapes (n_in %d out %d ws %zu need %zu)\n", n_in, out_size, ws_size, (size_t)WS_END); grid = -1; return; }
        int dev = 0, cus = 0, per_cu = 0;
        if (hipGetDevice(&dev) != hipSuccess || hipDeviceGetAttribute(&cus, hipDeviceAttributeMultiprocessorCount, dev) != hipSuccess) { grid = -1; return; }
        if (hipFuncSetAttribute((const void*)fwd_kernel, hipFuncAttributeMaxDynamicSharedMemorySize, LDS_BYTES) != hipSuccess) { fprintf(stderr, "kernel_launch: hipFuncSetAttribute failed\n"); grid = -1; return; }
        if (hipOccupancyMaxActiveBlocksPerMultiprocessor(&per_cu, (const void*)fwd_kernel, 512, LDS_BYTES) != hipSuccess || per_cu < 1) { fprintf(stderr, "kernel_launch: occupancy query says %d\n", per_cu); (void)hipGetLastError(); per_cu = 1; }
        grid = cus;
    }
    if (grid < 0) return;
    (void)hipMemsetAsync((char*)d_ws + WS_CTL, 0, CTL_BYTES, stream);
    Params p{};
    for (int i = 0; i < 24; ++i) p.in[i] = (const float*)d_in[i];
    p.out = (float*)d_out; p.ws = (unsigned char*)d_ws;
#if MK_MULTI
#ifndef MAXPH
#define MAXPH NPH
#endif
    for (int ph = 0; ph < MAXPH; ++ph) {
        if (!phase_active(ph)) continue;
        p.ph_lo = ph; p.ph_hi = ph + 1;
#if MK_CHECK
        const int cl = ph < PH_L0 ? 0 : (ph - PH_L0) / PH_PER_L, cq = ph < PH_L0 ? -1 : (ph - PH_L0) % PH_PER_L; const bool cmoe = (cl & 1) != 0; const int cT = cl < DEPTH - 1 ? T : NLAT;
        if (cq == Q_OUT) chk_out<<<1, 256, 0, stream>>>(p, cl, cT, 0);
        if (cq == Q_LN1) chk_ln<<<8, 256, 0, stream>>>(p, cl, cT, 1, 0);
        if (cq == Q_F1 && !cmoe) chk_down<<<1, 256, 0, stream>>>(p, cl, cT, 0);
        if (cq == Q_LN2) chk_ln<<<8, 256, 0, stream>>>(p, cl, cT, 2, 0);
#endif
        hipLaunchKernelGGL(fwd_kernel, dim3(grid), dim3(512), LDS_BYTES, stream, p);
#if MK_CHECK
        if (ph == PH_PRO_A) { chk_pro<<<1, 256, 0, stream>>>(p); chk_wmix<<<2, 256, 0, stream>>>(p, 0); }
        if (ph == PH_PRO_B) chk_h<<<2, 256, 0, stream>>>(p, 0);
        if (cq == Q_IN) chk_in<<<3, 256, 0, stream>>>(p, cl);
        if (cq == Q_POOLV) chk_poolv<<<2, 256, 0, stream>>>(p, cl, cT);
        if (cq == Q_RET) chk_ret<<<128, 256, 0, stream>>>(p, cl, cl < DEPTH - 1 ? 1 : 0);
        if (cq == Q_COMB) chk_comb<<<2, 256, 0, stream>>>(p, cl, cT);
        if (cq == Q_MIX) chk_mix<<<1, 256, 0, stream>>>(p, cl, cT);
        if (cq == Q_OUT) chk_out<<<1, 256, 0, stream>>>(p, cl, cT, 1);
        if (cq == Q_LN1) { chk_ln<<<8, 256, 0, stream>>>(p, cl, cT, 1, 1); chk_fw<<<2, 256, 0, stream>>>(p, cl); if (cl + 1 < DEPTH) chk_wmix<<<2, 256, 0, stream>>>(p, cl + 1); }
        if (cq == Q_F0 && !cmoe) chk_up<<<1, 256, 0, stream>>>(p, cl, cT);
        if (cq == Q_F1 && !cmoe) chk_down<<<1, 256, 0, stream>>>(p, cl, cT, 1);
        if (cq == Q_F0 && cmoe) chk_scat<<<2, 256, 0, stream>>>(p, cl, cT);
        if (cmoe && cq >= Q_F1 && cq < Q_F1 + 2 * NGRP) { const int g = (cq - Q_F1) >> 1; if (((cq - Q_F1) & 1) == 0) chk_mup<<<1, 256, 0, stream>>>(p, cl, g); else chk_mdown<<<1, 256, 0, stream>>>(p, cl, g); }
        if (cq == Q_LN2) { chk_ln<<<8, 256, 0, stream>>>(p, cl, cT, 2, 1); if (cl + 1 < DEPTH) chk_h<<<2, 256, 0, stream>>>(p, cl + 1); }
#endif
    }
#if MK_CHECK
    chk_encode<<<1024, 256, 0, stream>>>(p, 88);
#endif
#else
    p.ph_lo = 0; p.ph_hi = NPH;
    hipLaunchKernelGGL(fwd_kernel, dim3(grid), dim3(512), LDS_BYTES, stream, p);
#endif
}
```

```cpp
#include <hip/hip_runtime.h>
#include <stdint.h>
#include <cstdio>

#define MAXPH NPH
#ifndef MK_MULTI
#define MK_MULTI 0
#endif

#define DEVINL __device__ __forceinline__
#define LAS __attribute__((address_space(3)))
typedef unsigned short bf16_t;
typedef short bf16x8 __attribute__((ext_vector_type(8)));
typedef short v4i16_t __attribute__((ext_vector_type(4)));
typedef float f32x4 __attribute__((ext_vector_type(4)));
typedef unsigned u32x4 __attribute__((ext_vector_type(4)));
typedef unsigned u32x2 __attribute__((ext_vector_type(2)));

constexpr int D = 1024, BATCH = 16, SEQ = 4096, DEPTH = 4, CTXL = 256, GRIDW = 64;
constexpr int NLAT = BATCH * SEQ, NCTX = BATCH * CTXL, T = NLAT + NCTX;
constexpr int INW = 5632, DFF = 2816, NEXP = 8, EFF = 3584;
constexpr int MAXRB = 552;
constexpr int RBG = 552;
constexpr int NGRP = 1;
constexpr float ALPHA = 1.6817928305074290f;
constexpr float LN_EPS = 1e-5f;
constexpr float KSCALE = 0.08838834764831845f;

constexpr size_t AL(size_t x) { return (x + 255) & ~(size_t)255; }
constexpr size_t U = (size_t)T * 1024 * 2;
constexpr size_t WS_CTL = 0;
constexpr size_t CTL_BYTES = 65536;
constexpr size_t WS_MOD = WS_CTL + CTL_BYTES;
constexpr size_t WS_ROPE = AL(WS_MOD + (size_t)4 * 17 * 6144 * 4);
constexpr size_t WS_CTXS = AL(WS_ROPE + (size_t)4096 * 64 * 8);
constexpr size_t WS_TOKE = AL(WS_CTXS + (size_t)NCTX * 1024 * 4);
constexpr size_t WS_TOKW = AL(WS_TOKE + (size_t)T * 8);
constexpr size_t WS_TOKD = AL(WS_TOKW + (size_t)T * 8);
constexpr size_t WS_WGCNT = AL(WS_TOKD + (size_t)T * 8);
constexpr size_t WS_BLKE = AL(WS_WGCNT + 256 * 8 * 4);
constexpr size_t WS_ST1 = AL(WS_BLKE + (MAXRB + 8) * 4);
constexpr size_t WS_ST2 = AL(WS_ST1 + (size_t)T * 8);
constexpr size_t WS_WMIX = AL(WS_ST2 + (size_t)T * 8);
constexpr size_t WMIX_IN = 0, WMIX_POOL = (size_t)INW * 1024 * 2, WMIX_RET = WMIX_POOL + (size_t)1024 * 512 * 2, WMIX_OUT = WMIX_RET + (size_t)1024 * 1024 * 2, WMIX_IN8 = WMIX_OUT + (size_t)1024 * 1024 * 2, WMIX_BYTES = WMIX_IN8 + (size_t)2048 * 1024;
constexpr size_t WS_A = AL(WS_WMIX + WMIX_BYTES);
constexpr size_t WS_BIG = AL(WS_A + U);
constexpr size_t B_U = 0, B_Q = U / 2, B_K = U, B_V = U + U / 2, B_SG = 2 * U + U / 2, B_GP = 3 * U + U / 2, B_GR = 4 * U + U / 2, B_OF = 5 * U + U / 2, B_OB = 6 * U + U / 2, B_END = 7 * U + U / 2;
constexpr size_t B_URET = B_V, B_Y1 = B_Q, B_MIX = B_OF;
constexpr size_t F_W = 0;
constexpr size_t F_DW2 = (size_t)2 * DFF * 1024 * 2;
constexpr float W13_SCALE = 64.0f, W2_SCALE = 256.0f;
constexpr size_t F_EW13 = (size_t)2 * EFF * 1024, F_EW2 = (size_t)1024 * EFF, F_EALL = (size_t)NEXP * (F_EW13 + F_EW2);
constexpr size_t F_XS = AL(F_EALL);
constexpr size_t F_YK = AL(F_XS + (size_t)MAXRB * 256 * 1024);
constexpr size_t F_ACTM = AL(F_YK + (size_t)MAXRB * 256 * 1024 * 2);
constexpr size_t F_ACT = AL(F_DW2 + (size_t)1024 * DFF * 2);
constexpr size_t F_END_D = F_ACT + (size_t)T * DFF * 2, F_END_M = F_ACTM + (size_t)RBG * 256 * EFF;
constexpr size_t WS_END = WS_BIG + B_END;
static_assert(F_END_D <= B_END && F_END_M <= B_END, "FFN stage must fit in BIG");
static_assert(WS_END <= (size_t)1295298688, "workspace budget");

constexpr int CW_BAR = 0;
constexpr int CW_DBG = 4096;

constexpr int LDS_MAIN = 139264;
constexpr int LDS_TAB = LDS_MAIN;
constexpr int LDS_CTL = LDS_MAIN + 1024;
constexpr int LDS_BYTES = LDS_CTL + 256;

DEVINL float bf2f(unsigned b) { return __uint_as_float(b << 16); }
DEVINL float bflo(unsigned w) { return __uint_as_float(w << 16); }
DEVINL float bfhi(unsigned w) { return __uint_as_float(w & 0xffff0000u); }
typedef __bf16 bf16v2_t __attribute__((ext_vector_type(2)));
typedef float f32v2_t __attribute__((ext_vector_type(2)));
DEVINL unsigned pk2(float lo, float hi) { const f32v2_t v = {lo, hi}; return __builtin_bit_cast(unsigned, __builtin_convertvector(v, bf16v2_t)); }
DEVINL void unpk8(const u32x4 w, float (&v)[8]) { v[0] = bflo(w.x); v[1] = bfhi(w.x); v[2] = bflo(w.y); v[3] = bfhi(w.y); v[4] = bflo(w.z); v[5] = bfhi(w.z); v[6] = bflo(w.w); v[7] = bfhi(w.w); }
DEVINL u32x4 pk8(const float (&v)[8]) { u32x4 w; w.x = pk2(v[0], v[1]); w.y = pk2(v[2], v[3]); w.z = pk2(v[4], v[5]); w.w = pk2(v[6], v[7]); return w; }
typedef _Float16 f16v2_t __attribute__((ext_vector_type(2)));
DEVINL unsigned pk2h(float lo, float hi) { return __builtin_bit_cast(unsigned, __builtin_amdgcn_cvt_pkrtz(lo, hi)); }
DEVINL float h2f_bits(unsigned h) { const unsigned m = h & 0x7fffu; const unsigned f = ((h & 0x8000u) << 16) | ((m << 13) + 0x38000000u); return (m < 0x400u) ? 0.f : __uint_as_float(f); }
DEVINL float h2f_cvt(unsigned h) { float f; asm("v_cvt_f32_f16_e32 %0, %1" : "=v"(f) : "v"(h)); return f; }
DEVINL void unpk8h(const u32x4 w, float (&v)[8]) {
    v[0] = h2f_cvt(w.x); v[1] = h2f_cvt(w.x >> 16); v[2] = h2f_cvt(w.y); v[3] = h2f_cvt(w.y >> 16);
    v[4] = h2f_cvt(w.z); v[5] = h2f_cvt(w.z >> 16); v[6] = h2f_cvt(w.w); v[7] = h2f_cvt(w.w >> 16); }
DEVINL u32x4 pk8h(const float (&v)[8]) { u32x4 w; w.x = pk2h(v[0], v[1]); w.y = pk2h(v[2], v[3]); w.z = pk2h(v[4], v[5]); w.w = pk2h(v[6], v[7]); return w; }
DEVINL void ld8f(const float* p, float (&v)[8]) { const f32x4 a = *(const f32x4*)p, b = *(const f32x4*)(p + 4); v[0] = a[0]; v[1] = a[1]; v[2] = a[2]; v[3] = a[3]; v[4] = b[0]; v[5] = b[1]; v[6] = b[2]; v[7] = b[3]; }
DEVINL unsigned pk4_fp8(float a, float b, float c, float d) { int w = 0; w = __builtin_amdgcn_cvt_pk_fp8_f32(a, b, w, false); w = __builtin_amdgcn_cvt_pk_fp8_f32(c, d, w, true); return (unsigned)w; }
DEVINL bf16_t f2bf(float f) { return (bf16_t)(pk2(f, 0.f) & 0xffffu); }
DEVINL float sigmoidf_(float x) { return __builtin_amdgcn_rcpf(1.0f + __builtin_amdgcn_exp2f(-1.4426950408889634f * x)); }
DEVINL float siluf_(float x) { return x * __builtin_amdgcn_rcpf(1.0f + __builtin_amdgcn_exp2f(-1.4426950408889634f * x)); }
DEVINL f32x4 exp2_4(const f32x4 x) { f32x4 r; r[0] = __builtin_amdgcn_exp2f(x[0]); r[1] = __builtin_amdgcn_exp2f(x[1]); r[2] = __builtin_amdgcn_exp2f(x[2]); r[3] = __builtin_amdgcn_exp2f(x[3]); return r; }
DEVINL f32x4 rcp_4(const f32x4 x) { f32x4 r; r[0] = __builtin_amdgcn_rcpf(x[0]); r[1] = __builtin_amdgcn_rcpf(x[1]); r[2] = __builtin_amdgcn_rcpf(x[2]); r[3] = __builtin_amdgcn_rcpf(x[3]); return r; }
DEVINL void sigmoid8(f32x4& a0, f32x4& a1, const float nl2) {
    const f32x4 e0 = exp2_4(a0 * nl2), e1 = exp2_4(a1 * nl2);
    a0 = rcp_4(e0 + 1.0f); a1 = rcp_4(e1 + 1.0f);
}
DEVINL void swiglu8(f32x4& v0, f32x4& v1, const f32x4 a0, const f32x4 a1, const f32x4 b0, const f32x4 b1, const float nl2, const float s2) {
    const f32x4 e0 = exp2_4(a0 * nl2), e1 = exp2_4(a1 * nl2);
    const f32x4 p0 = a0 * b0, p1 = a1 * b1;
    const f32x4 r0 = rcp_4(e0 + 1.0f), r1 = rcp_4(e1 + 1.0f);
    v0 = p0 * (r0 * s2); v1 = p1 * (r1 * s2);
}
DEVINL int tid_hidden() { int t = threadIdx.x; asm volatile("" : "+v"(t)); return t; }
#define DPP_ADD(v, ctrl, rmask) v += __builtin_bit_cast(float, __builtin_amdgcn_update_dpp(0, __builtin_bit_cast(int, v), ctrl, rmask, 0xf, false))
DEVINL float wave_sum(float v) {
    DPP_ADD(v, 0xB1, 0xf);
    DPP_ADD(v, 0x4E, 0xf);
    DPP_ADD(v, 0x141, 0xf);
    DPP_ADD(v, 0x140, 0xf);
    DPP_ADD(v, 0x142, 0xa);
    DPP_ADD(v, 0x143, 0xc);
    return __builtin_bit_cast(float, __builtin_amdgcn_readlane(__builtin_bit_cast(int, v), 63));
}

#define XB_TMO      128
#define XB_XCNT(j)  (256  + 64 * (j))
#define XB_XSUB(j)  (1280 + 64 * (j))
#define XB_XGEN(j)  (2304 + 64 * (j))
#define XB_TOP      3328
#define XB_TOPGEN   3392
#define XCD_BAR_WORDS 3456
#define XB_SPIN_CAP (1u << 20)
DEVINL unsigned xb_ld(unsigned* p)              { return __hip_atomic_load(p, __ATOMIC_RELAXED, __HIP_MEMORY_SCOPE_AGENT); }
DEVINL unsigned xb_add(unsigned* p, unsigned v) { return __hip_atomic_fetch_add(p, v, __ATOMIC_RELAXED, __HIP_MEMORY_SCOPE_AGENT); }
DEVINL unsigned xb_xcc_id() { return (unsigned)__builtin_amdgcn_s_getreg((3 << 11) | 20) & 0xFu; }
#define XB_SPIN(cond, bar) do { unsigned _sp = 0; while (cond) { __builtin_amdgcn_s_sleep(1); \
    if ((++_sp & 255u) == 0u) { if (xb_ld(&(bar)[XB_TMO])) break; if (_sp > XB_SPIN_CAP) { atomicAdd(&(bar)[XB_TMO], 1u); break; } } } } while (0)
struct XcdBarrier { unsigned* bar; unsigned x; volatile LAS unsigned* st; };
DEVINL XcdBarrier xcd_barrier_post(unsigned* bar, volatile LAS unsigned* st) {
    XcdBarrier b; b.bar = bar; b.x = xb_xcc_id(); b.st = st;
    if (threadIdx.x == 0) (void)xb_add(&bar[XB_XCNT(b.x)], 1u);
    return b;
}
DEVINL void xcd_barrier_complete(unsigned* bar, unsigned x, unsigned& nloc, unsigned& nx) {
    const unsigned G = gridDim.x * gridDim.y * gridDim.z;
    unsigned sum, cnt, mine, sp = 0u;
    for (;;) {
        sum = 0u; cnt = 0u; mine = 0u;
#pragma unroll
        for (unsigned j = 0; j < 16; ++j) { const unsigned c = xb_ld(&bar[XB_XCNT(j)]); sum += c; cnt += (c > 0u) ? 1u : 0u; mine = (j == x) ? c : mine; }
        if (sum == G) break;
        __builtin_amdgcn_s_sleep(1);
        if ((++sp & 255u) == 0u) { if (xb_ld(&bar[XB_TMO])) break; if (sp > XB_SPIN_CAP) { atomicAdd(&bar[XB_TMO], 1u); break; } }
    }
    nloc = mine > 0u ? mine : 1u; nx = cnt > 0u ? cnt : 1u;
}
DEVINL void xcd_barrier(const XcdBarrier& b) {
    asm volatile("s_waitcnt vmcnt(0)" ::: "memory");
    __syncthreads();
    if (threadIdx.x == 0) {
        unsigned* bar = b.bar;
        __builtin_amdgcn_s_waitcnt(0);
        unsigned nloc = b.st[0], nx = b.st[1];
        if (nloc == 0u) { xcd_barrier_complete(bar, b.x, nloc, nx); b.st[0] = nloc; b.st[1] = nx; }
        const unsigned old = xb_add(&bar[XB_XSUB(b.x)], 1u);
        const unsigned gen = old / nloc;
        if (old + 1u == (gen + 1u) * nloc) {
            __builtin_amdgcn_fence(__ATOMIC_RELEASE, "agent");
            asm volatile("s_waitcnt vmcnt(0)" ::: "memory");
            const unsigned og = xb_add(&bar[XB_TOP], 1u);
            const unsigned tg = og / nx;
            if (og + 1u == (tg + 1u) * nx) xb_add(&bar[XB_TOPGEN], 1u);
            else XB_SPIN(xb_ld(&bar[XB_TOPGEN]) == tg, bar);
            __builtin_amdgcn_fence(__ATOMIC_ACQUIRE, "agent");
            xb_add(&bar[XB_XGEN(b.x)], 1u);
            asm volatile("s_waitcnt vmcnt(0)" ::: "memory");
        } else {
            XB_SPIN(xb_ld(&bar[XB_XGEN(b.x)]) == gen, bar);
            __builtin_amdgcn_fence(__ATOMIC_ACQUIRE, "agent");
            asm volatile("s_waitcnt vmcnt(0)" ::: "memory");
        }
    }
    __syncthreads();
}

constexpr int BM = 256, BK = 64, HALF = 128, HTB = HALF * BK * 2, NXCD = 8, WGM = 8;
DEVINL int lds_byte(int r, int c) { const int st = (r >> 4) * 2 + (c >> 5), rr = r & 15, cc = c & 31, ob = rr * 64 + cc * 2; return st * 1024 + (ob ^ (((ob >> 9) & 1) << 5)); }
DEVINL void stage_rc(int b, int& R, int& C) { const int st = b / 1024, sb = b % 1024, swz = sb ^ (((sb >> 9) & 1) << 5); R = (st >> 1) * 16 + swz / 64; C = (st & 1) * 32 + (swz % 64) / 2; }
DEVINL int perm32(int rho) { const int n = rho >> 4, i = rho & 15; return 8 * (i >> 2) + 4 * n + (i & 3); }

struct Unit { int pm, pn; const char* a; const char* b; };

DEVINL bool rect_next(long L, int nM, int nN, int& pm, int& pn) {
    const int nwg = nM * nN; if (L >= nwg) return false;
    int wgid = (int)L; { const int q = nwg / NXCD, r = nwg % NXCD, xcd = wgid % NXCD, off = wgid / NXCD; wgid = (xcd < r ? xcd * (q + 1) : r * (q + 1) + (xcd - r) * q) + off; }
    const int nig = WGM * nN, gid = wgid / nig, fm = gid * WGM, gsz = (nM - fm) < WGM ? (nM - fm) : WGM;
    pm = fm + ((wgid % nig) % gsz); pn = (wgid % nig) / gsz; return true;
}
struct SchedRect {
    const char* A; const char* B; int nM, nN, G, c; size_t tstep;
    DEVINL bool next(int i, Unit& u) const { if (!rect_next((long)i * G + c, nM, nN, u.pm, u.pn)) return false; u.a = A + (size_t)u.pm * tstep; u.b = B + (size_t)u.pn * tstep; return true; }
};
struct SchedIn3 {
    const char* A; const char* B; int G, c; size_t tstep;
    DEVINL bool next(int i, Unit& u) const {
        const long L = (long)i * G + c;
        if (L < 256 * 14) { rect_next(L, 256, 14, u.pm, u.pn); }
        else { const long L2 = L - 256 * 14; if (L2 >= 16 * 6) return false; u.pm = 256 + (int)(L2 / 6); u.pn = 4 + (int)(L2 % 6); }
        u.a = A + (size_t)u.pm * tstep; u.b = B + (size_t)u.pn * tstep; return true; }
};
struct SchedMoe {
    const char* abase; const char* wbase; int eb0, eb1, eb2; int rb0, arb0, nrb, nN, G, c; size_t tstep, estride;
    DEVINL bool next(int i, Unit& u) const {
        int pm, pn; if (!rect_next((long)i * G + c, nrb, nN, pm, pn)) return false;
        u.pm = rb0 + pm; u.pn = pn;
        const int r = u.pm;
        const int e = (r >= (eb0 & 1023)) + (r >= ((eb0 >> 10) & 1023)) + (r >= ((eb0 >> 20) & 1023)) + (r >= (eb1 & 1023)) + (r >= ((eb1 >> 10) & 1023)) + (r >= ((eb1 >> 20) & 1023)) + (r >= (eb2 & 1023));
        u.a = abase + (size_t)(u.pm - arb0) * tstep; u.b = wbase + (size_t)e * estride + (size_t)pn * tstep; return true; }
};

DEVINL void moe_bounds(const int* blke, int& w0, int& w1, int& w2) {
    int b[7];
#pragma unroll
    for (int e = 0; e < 7; ++e) { int v = __builtin_amdgcn_readfirstlane(blke[1 + e]); v = v < 0 ? 0 : (v > 1023 ? 1023 : v); b[e] = v; }
    w0 = b[0] | (b[1] << 10) | (b[2] << 20); w1 = b[3] | (b[4] << 10) | (b[5] << 20); w2 = b[6];
}
typedef int v4i_t __attribute__((ext_vector_type(4)));
typedef int v8i_t __attribute__((ext_vector_type(8)));
DEVINL v8i_t cat_v8(bf16x8 lo, bf16x8 hi) { return __builtin_shufflevector(__builtin_bit_cast(v4i_t, lo), __builtin_bit_cast(v4i_t, hi), 0, 1, 2, 3, 4, 5, 6, 7); }
template <class Epi, class Sched>
DEVINL void gemm_phase(LAS unsigned char* lds, const int K, const Sched& S, const Epi& E) {
    int tid = threadIdx.x; asm volatile("" : "+v"(tid));
    const int wid = __builtin_amdgcn_readfirstlane(tid >> 6), lane = tid & 63, wr = wid >> 2, wc = wid & 3, fr = lane & 15, fq = lane >> 4;
    const int nt = K / BK;
    unsigned voffA, voffB;
    { int R, C; stage_rc(tid * 16, R, C); const int Rb = Epi::PERM ? ((R & ~31) + perm32(R & 31)) : R;
      voffA = (unsigned)(R * K + C) * 2u; voffB = (unsigned)(Rb * K + C) * 2u; }
    const size_t kstep = (size_t)(BK * 2);
    const size_t hstep = (size_t)HALF * K * 2;
    const size_t qstep = (size_t)64 * K * 2;
    const unsigned ldsw = (unsigned)wid * 1024u;
    const int aoff = lds_byte(wr * 64 + fr, fq * 8), boff = lds_byte(wc * 32 + fr, fq * 8);
#define PG8_SA(b, h) (((b) * 2 + (h)) * HTB)
#define PG8_SB(b, h) ((4 + (b) * 2 + (h)) * HTB)
#define PG8_STAGE(bufoff, gbase, voff) do { _Pragma("unroll") for (int _i = 0; _i < 2; ++_i) \
        __builtin_amdgcn_global_load_lds((const unsigned*)((const char*)(gbase) + _i * qstep + (voff)), (LAS unsigned*)(lds + (bufoff) + ldsw + _i * 8192), 16, 0, 0); } while (0)
#define PG8_LDA(dst, b, h) do { if constexpr (Epi::FP8) { _Pragma("unroll") for (int m = 0; m < 4; ++m) dst##8[m] = cat_v8(*(const LAS bf16x8*)(lds + PG8_SA(b, h) + aoff + m * 2048), *(const LAS bf16x8*)(lds + PG8_SA(b, h) + aoff + m * 2048 + 1024)); } \
        else { _Pragma("unroll") for (int m = 0; m < 4; ++m) _Pragma("unroll") for (int k = 0; k < 2; ++k) dst[m][k] = *(const LAS bf16x8*)(lds + PG8_SA(b, h) + aoff + m * 2048 + k * 1024); } } while (0)
#define PG8_LDB(dst, b, h) do { if constexpr (Epi::FP8) { _Pragma("unroll") for (int n = 0; n < 2; ++n) dst##8[n] = cat_v8(*(const LAS bf16x8*)(lds + PG8_SB(b, h) + boff + n * 2048), *(const LAS bf16x8*)(lds + PG8_SB(b, h) + boff + n * 2048 + 1024)); } \
        else { _Pragma("unroll") for (int n = 0; n < 2; ++n) _Pragma("unroll") for (int k = 0; k < 2; ++k) dst[n][k] = *(const LAS bf16x8*)(lds + PG8_SB(b, h) + boff + n * 2048 + k * 1024); } } while (0)
#define PG8_MMA(ai, bj, At, Bt) do { __builtin_amdgcn_s_setprio(1); \
        if constexpr (Epi::FP8) { _Pragma("unroll") for (int m = 0; m < 4; ++m) _Pragma("unroll") for (int n = 0; n < 2; ++n) \
            asm volatile("v_mfma_scale_f32_16x16x128_f8f6f4 %0, %1, %2, %0, %3, %3 op_sel_hi:[0,0,0]" : "+v"(acc[ai][bj][m][n]) : "v"(Bt##8[n]), "v"(At##8[m]), "v"(sc1)); } \
        else { _Pragma("unroll") for (int m = 0; m < 4; ++m) _Pragma("unroll") for (int n = 0; n < 2; ++n) _Pragma("unroll") for (int k = 0; k < 2; ++k) \
            acc[ai][bj][m][n] = __builtin_amdgcn_mfma_f32_16x16x32_bf16(Bt[n][k], At[m][k], acc[ai][bj][m][n], 0, 0, 0); } \
        __builtin_amdgcn_s_setprio(0); } while (0)
#define PG8_MFMA_DRAIN() do { if constexpr (Epi::FP8) { asm volatile("s_nop 15\n\ts_nop 15" : "+v"(acc[0][0][0][0]), "+v"(acc[0][0][0][1]), "+v"(acc[0][0][1][0]), "+v"(acc[0][0][1][1]), "+v"(acc[0][0][2][0]), "+v"(acc[0][0][2][1]), "+v"(acc[0][0][3][0]), "+v"(acc[0][0][3][1]), "+v"(acc[0][1][0][0]), "+v"(acc[0][1][0][1]), "+v"(acc[0][1][1][0]), "+v"(acc[0][1][1][1]), "+v"(acc[0][1][2][0]), "+v"(acc[0][1][2][1]), "+v"(acc[0][1][3][0]), "+v"(acc[0][1][3][1])); asm volatile("" : "+v"(acc[1][0][0][0]), "+v"(acc[1][0][0][1]), "+v"(acc[1][0][1][0]), "+v"(acc[1][0][1][1]), "+v"(acc[1][0][2][0]), "+v"(acc[1][0][2][1]), "+v"(acc[1][0][3][0]), "+v"(acc[1][0][3][1]), "+v"(acc[1][1][0][0]), "+v"(acc[1][1][0][1]), "+v"(acc[1][1][1][0]), "+v"(acc[1][1][1][1]), "+v"(acc[1][1][2][0]), "+v"(acc[1][1][2][1]), "+v"(acc[1][1][3][0]), "+v"(acc[1][1][3][1])); } } while (0)
#define PG8_WAIT_V(n) asm volatile("s_waitcnt vmcnt(" #n ")" ::: "memory")
#define PG8_WAIT_L(n) asm volatile("s_waitcnt lgkmcnt(" #n ")" ::: "memory")
#define PG8_WAIT_VN(n) asm volatile("s_waitcnt vmcnt(%0)" :: "n"(n) : "memory")
#define PG8_BAR __builtin_amdgcn_s_barrier()
#define PG8_SCHED __builtin_amdgcn_sched_barrier(0)
    Unit cur, nxt; int ui = 0;
    if (!S.next(0, cur)) return;
    f32x4 acc[2][2][4][2];
#pragma unroll
    for (int a = 0; a < 2; ++a)
#pragma unroll
        for (int b = 0; b < 2; ++b)
#pragma unroll
            for (int m = 0; m < 4; ++m)
#pragma unroll
                for (int n = 0; n < 2; ++n) acc[a][b][m][n] = (f32x4){0.f, 0.f, 0.f, 0.f};
    int sc1 = 0x7F7F7F7F; asm volatile("" : "+v"(sc1));
    bf16x8 At[4][2], B0[2][2], B1[2][2]; v8i_t At8[4], B08[2], B18[2];
    const char* cA = cur.a; const char* cB = cur.b;
    PG8_STAGE(PG8_SB(0, 0), cB, voffB); PG8_STAGE(PG8_SA(0, 0), cA, voffA); PG8_STAGE(PG8_SB(0, 1), cB + hstep, voffB); PG8_STAGE(PG8_SA(0, 1), cA + hstep, voffA);
    PG8_STAGE(PG8_SB(1, 0), cB + kstep, voffB); PG8_STAGE(PG8_SA(1, 0), cA + kstep, voffA); PG8_STAGE(PG8_SB(1, 1), cB + hstep + kstep, voffB);
    PG8_WAIT_V(6); PG8_BAR;
    if (wr == 1) PG8_BAR;
    for (;;) {
        const bool has_next = S.next(ui + 1, nxt);
        const char* nA = has_next ? nxt.a : cA; const char* nB = has_next ? nxt.b : cB;
        int epi_flag = (ui > 0) ? 1 : 0;
        for (int t = 0; t < nt; t += 2) {
            const bool last = (t == nt - 2);
            const char* a1 = cA + (size_t)(t + 1) * kstep;
            const char* a2 = last ? nA : cA + (size_t)(t + 2) * kstep; const char* b2 = last ? nB : cB + (size_t)(t + 2) * kstep;
            const char* a3 = a2 + kstep; const char* b3 = b2 + kstep;
            int after_epi = 0;
            if constexpr (Epi::FP8) { after_epi = __builtin_amdgcn_readfirstlane(epi_flag); asm volatile("" : "+s"(after_epi)); epi_flag = 0; }
            PG8_LDB(B0, 0, 0); PG8_LDB(B1, 0, 1); PG8_LDA(At, 0, 0); PG8_STAGE(PG8_SA(1, 1), a1 + hstep, voffA);
            if (Epi::FP8 && after_epi) PG8_WAIT_VN(8 + Epi::NST); else PG8_WAIT_V(8);
            PG8_WAIT_L(0); PG8_BAR; PG8_MMA(0, 0, At, B0); PG8_MMA(0, 1, At, B1); PG8_BAR; PG8_SCHED;
            PG8_LDA(At, 0, 1); PG8_STAGE(PG8_SB(0, 0), b2, voffB); PG8_STAGE(PG8_SB(0, 1), b2 + hstep, voffB); PG8_STAGE(PG8_SA(0, 0), a2, voffA);
            if (Epi::FP8 && after_epi) PG8_WAIT_VN(8 + Epi::NST); else PG8_WAIT_V(8);
            PG8_WAIT_L(0); PG8_BAR; PG8_MMA(1, 0, At, B0); PG8_MMA(1, 1, At, B1); PG8_BAR; PG8_SCHED;
            PG8_LDB(B0, 1, 0); PG8_LDB(B1, 1, 1); PG8_LDA(At, 1, 0); PG8_STAGE(PG8_SA(0, 1), a2 + hstep, voffA);
            PG8_WAIT_V(8); PG8_WAIT_L(0); PG8_BAR; PG8_MMA(0, 0, At, B0); PG8_MMA(0, 1, At, B1); PG8_BAR; PG8_SCHED;
            PG8_LDA(At, 1, 1); PG8_STAGE(PG8_SB(1, 0), b3, voffB); PG8_STAGE(PG8_SB(1, 1), b3 + hstep, voffB); PG8_STAGE(PG8_SA(1, 0), a3, voffA);
            PG8_WAIT_V(8); PG8_WAIT_L(0); PG8_BAR; PG8_MMA(1, 0, At, B0); PG8_MMA(1, 1, At, B1); PG8_BAR; PG8_SCHED;
        }
        PG8_MFMA_DRAIN();
        {
            int tz = threadIdx.x; asm volatile("" : "+v"(tz)); const int wz = __builtin_amdgcn_readfirstlane(tz >> 6), lz = tz & 63;
            E(acc, cur, wz >> 2, wz & 3, lz & 15, lz >> 4);
        }
        if (!has_next) break;
#pragma unroll
        for (int a = 0; a < 2; ++a)
#pragma unroll
            for (int b = 0; b < 2; ++b)
#pragma unroll
                for (int m = 0; m < 4; ++m)
#pragma unroll
                    for (int n = 0; n < 2; ++n) acc[a][b][m][n] = (f32x4){0.f, 0.f, 0.f, 0.f};
        cur = nxt; cA = nA; cB = nB; ++ui;
    }
    PG8_WAIT_V(0);
    if (wr == 0) PG8_BAR;
    PG8_BAR;
#undef PG8_SA
#undef PG8_SB
#undef PG8_STAGE
#undef PG8_LDA
#undef PG8_LDB
#undef PG8_MMA
#undef PG8_MFMA_DRAIN
#undef PG8_WAIT_V
#undef PG8_WAIT_L
#undef PG8_WAIT_VN
#undef PG8_BAR
#undef PG8_SCHED
}

typedef const f32x4 (&AccRef)[2][2][4][2];

struct EpiIn {
    static constexpr bool PERM = true, FP8 = false; static constexpr int NST = 16;
    bf16_t* big; const float* rope;
    template <int KIND> DEVINL void body(AccRef acc, bf16_t* dst, int ldc, int row0, int col0, bool lat, int wc, int fq) const {
        constexpr float ks = (KIND == 2) ? KSCALE : 1.0f;
        f32x4 csa[2][4], csb[2][4];
        if (KIND == 1 || KIND == 2) {
#pragma unroll
            for (int ai = 0; ai < 2; ++ai)
#pragma unroll
                for (int m = 0; m < 4; ++m) { const float* rp = rope + ((size_t)((row0 + ai * HALF + m * 16) & 4095) * 64 + wc * 16 + 4 * fq) * 2; csa[ai][m] = *(const f32x4*)rp; csb[ai][m] = *(const f32x4*)(rp + 4); }
            const f32x4 ident = (f32x4){1.f, 0.f, 1.f, 0.f};
#pragma unroll
            for (int ai = 0; ai < 2; ++ai)
#pragma unroll
                for (int m = 0; m < 4; ++m) { csa[ai][m] = lat ? csa[ai][m] : ident; csb[ai][m] = lat ? csb[ai][m] : ident; }
        }
#pragma unroll
        for (int ai = 0; ai < 2; ++ai)
#pragma unroll
            for (int m = 0; m < 4; ++m) {
                const unsigned ro = ((unsigned)(row0 + ai * HALF + m * 16) * (unsigned)ldc + (unsigned)col0) * 2u;
#pragma unroll
                for (int bj = 0; bj < 2; ++bj) {
                    f32x4 v0 = acc[ai][bj][m][0], v1 = acc[ai][bj][m][1];
                    if (KIND >= 3) asm volatile("" : "+v"(v0), "+v"(v1));
                    if (KIND == 1 || KIND == 2) {
                        const f32x4 cs0 = csa[ai][m], cs1 = csb[ai][m];
                        f32x4 r0, r1;
                        r0[0] = (v0[0] * cs0[0] - v0[1] * cs0[1]) * ks; r0[1] = (v0[0] * cs0[1] + v0[1] * cs0[0]) * ks;
                        r0[2] = (v0[2] * cs0[2] - v0[3] * cs0[3]) * ks; r0[3] = (v0[2] * cs0[3] + v0[3] * cs0[2]) * ks;
                        r1[0] = (v1[0] * cs1[0] - v1[1] * cs1[1]) * ks; r1[1] = (v1[0] * cs1[1] + v1[1] * cs1[0]) * ks;
                        r1[2] = (v1[2] * cs1[2] - v1[3] * cs1[3]) * ks; r1[3] = (v1[2] * cs1[3] + v1[3] * cs1[2]) * ks;
                        v0 = r0; v1 = r1;
                    } else if (KIND == 3) {
                        f32x4 g0 = v0, g1 = v1; sigmoid8(g0, g1, -1.4426950408889634f); v0 *= g0; v1 *= g1;
                    } else if (KIND == 4) {
                        sigmoid8(v0, v1, -1.4426950408889634f);
                    }
                    u32x4 w; w.x = pk2(v0[0], v0[1]); w.y = pk2(v0[2], v0[3]); w.z = pk2(v1[0], v1[1]); w.w = pk2(v1[2], v1[3]);
                    *(u32x4*)((char*)dst + ro + (unsigned)(bj * HALF * 2)) = w;
                }
                asm volatile("" ::: "memory");
            }
    }
    DEVINL void operator()(AccRef acc, const Unit& u, int wr, int wc, int fr, int fq) const {
        const int pn = u.pn; bf16_t* dst; int ldc, colt, kind;
        if (pn < 2)       { dst = (bf16_t*)((char*)big + B_U);  ldc = 512;  colt = pn * 256;        kind = 0; }
        else if (pn < 4)  { dst = (bf16_t*)((char*)big + B_Q);  ldc = 512;  colt = (pn - 2) * 256;  kind = 1; }
        else if (pn < 6)  { dst = (bf16_t*)((char*)big + B_K);  ldc = 512;  colt = (pn - 4) * 256;  kind = 2; }
        else if (pn < 10) { dst = (bf16_t*)((char*)big + B_V);  ldc = 1024; colt = (pn - 6) * 256;  kind = 0; }
        else if (pn < 14) { dst = (bf16_t*)((char*)big + B_SG); ldc = 1024; colt = (pn - 10) * 256; kind = 3; }
        else if (pn < 18) { dst = (bf16_t*)((char*)big + B_GP); ldc = 1024; colt = (pn - 14) * 256; kind = 4; }
        else              { dst = (bf16_t*)((char*)big + B_GR); ldc = 1024; colt = (pn - 18) * 256; kind = 4; }
        const int row0 = u.pm * BM + wr * 64 + fr, col0 = colt + wc * 32 + 8 * fq;
        const bool lat = u.pm < 256;
        if (kind == 0) body<0>(acc, dst, ldc, row0, col0, lat, wc, fq);
        else if (kind == 1) body<1>(acc, dst, ldc, row0, col0, lat, wc, fq);
        else if (kind == 2) body<2>(acc, dst, ldc, row0, col0, lat, wc, fq);
        else if (kind == 3) body<3>(acc, dst, ldc, row0, col0, lat, wc, fq);
        else body<4>(acc, dst, ldc, row0, col0, lat, wc, fq);
    }
};

template <int MODE  > struct EpiGate {
    static constexpr bool PERM = true, FP8 = false; static constexpr int NST = 16;
    bf16_t* out; const bf16_t* gate; const bf16_t* y1;
    DEVINL void operator()(AccRef acc, const Unit& u, int wr, int wc, int fr, int fq) const {
        const int row0 = u.pm * BM + wr * 64 + fr, col0 = u.pn * BM + wc * 32 + 8 * fq;
#pragma unroll
        for (int ai = 0; ai < 2; ++ai) {
            u32x4 g[4][2], y[4][2];
#pragma unroll
            for (int m = 0; m < 4; ++m)
#pragma unroll
                for (int bj = 0; bj < 2; ++bj) {
                    const size_t off = (size_t)(row0 + ai * HALF + m * 16) * 1024 + col0 + bj * HALF;
                    if (MODE != 2) g[m][bj] = *(const u32x4*)(gate + off);
                    if (MODE == 1) y[m][bj] = *(const u32x4*)(y1 + off);
                }
#pragma unroll
            for (int m = 0; m < 4; ++m)
#pragma unroll
                for (int bj = 0; bj < 2; ++bj) {
                    const size_t off = (size_t)(row0 + ai * HALF + m * 16) * 1024 + col0 + bj * HALF;
                    f32x4 v0 = acc[ai][bj][m][0], v1 = acc[ai][bj][m][1];
                    if (MODE != 2) {
                        const u32x4 gg = g[m][bj];
                        v0[0] *= bflo(gg.x); v0[1] *= bfhi(gg.x); v0[2] *= bflo(gg.y); v0[3] *= bfhi(gg.y);
                        v1[0] *= bflo(gg.z); v1[1] *= bfhi(gg.z); v1[2] *= bflo(gg.w); v1[3] *= bfhi(gg.w);
                    }
                    if (MODE == 1) {
                        const u32x4 yy = y[m][bj];
                        v0[0] += bflo(yy.x); v0[1] += bfhi(yy.x); v0[2] += bflo(yy.y); v0[3] += bfhi(yy.y);
                        v1[0] += bflo(yy.z); v1[1] += bfhi(yy.z); v1[2] += bflo(yy.w); v1[3] += bfhi(yy.w);
                    }
                    u32x4 w; w.x = pk2(v0[0], v0[1]); w.y = pk2(v0[2], v0[3]); w.z = pk2(v1[0], v1[1]); w.w = pk2(v1[2], v1[3]);
                    *(u32x4*)(out + off) = w;
                }
            asm volatile("" ::: "memory");
        }
    }
};

template <bool X0, bool ST, bool F8 = false>
struct EpiRes {
    static constexpr bool PERM = true, FP8 = F8;
     static constexpr int NST = 16;
    const float* x0_lat; const float* x0_ctx; bf16_t* strm; const float* modl; int which;
    const float* st; const float* gam; const float* bet;
    DEVINL void operator()(AccRef acc, const Unit& u, int wr, int wc, int fr, int fq) const {
        const bool lat = u.pm < 256;
        const float* mv = modl + ((size_t)(lat ? (u.pm >> 4) : 16) * 6 + which) * 1024;
        const int row0 = u.pm * BM + wr * 64 + fr, col0 = u.pn * BM + wc * 32 + 8 * fq;
        const char* x0 = nullptr; if (X0) x0 = (const char*)(lat ? x0_lat : x0_ctx - (size_t)NLAT * 1024);
        const unsigned so0 = ((unsigned)row0 * 1024u + (unsigned)col0) * 2u;
#pragma unroll
        for (int bj = 0; bj < 2; ++bj) {
            const int col = col0 + bj * HALF;
            float bv[8], gv[8], ev[8];
            ld8f(mv + col, bv); if (ST) { ld8f(gam + col, gv); ld8f(bet + col, ev); }
            f32v2_t bv2[4], G2[4], E2[4];
#pragma unroll
            for (int k = 0; k < 4; ++k) { bv2[k] = (f32v2_t){bv[2 * k], bv[2 * k + 1]}; if (F8) bv2[k] *= (1.0f / W2_SCALE);
                if (ST) { G2[k] = (f32v2_t){gv[2 * k], gv[2 * k + 1]} * ALPHA; E2[k] = (f32v2_t){ev[2 * k], ev[2 * k + 1]} * ALPHA; } }
            constexpr int NA = (X0 || F8) ? 1 : 2;
#pragma unroll
            for (int ab = 0; ab < 2; ab += NA) {
                u32x4 xr[NA][4]; f32x4 xa[NA][4], xb[NA][4]; float mean[NA][4], rstd[NA][4];
#pragma unroll
                for (int a = 0; a < NA; ++a)
#pragma unroll
                    for (int m = 0; m < 4; ++m) {
                        const unsigned rr = (unsigned)((ab + a) * HALF + m * 16);
                        const unsigned so = so0 + rr * 2048u + (unsigned)(bj * HALF * 2);
                        if (ST) { const float2 s2 = *(const float2*)((const char*)st + ((unsigned)row0 + rr) * 8u); mean[a][m] = s2.x; rstd[a][m] = s2.y; }
                        if (X0) { const char* xp = x0 + so * 2u; xa[a][m] = *(const f32x4*)xp; xb[a][m] = *(const f32x4*)(xp + 16); }
                        else xr[a][m] = *(const u32x4*)((const char*)strm + so);
                    }
#pragma unroll
                for (int a = 0; a < NA; ++a)
#pragma unroll
                    for (int m = 0; m < 4; ++m) {
                        const int ai = ab + a;
                        const unsigned so = so0 + (unsigned)(ai * HALF + m * 16) * 2048u + (unsigned)(bj * HALF * 2);
                        float xv[8];
                        if (X0) { const f32x4 p0 = xa[a][m], p1 = xb[a][m]; xv[0] = p0[0]; xv[1] = p0[1]; xv[2] = p0[2]; xv[3] = p0[3]; xv[4] = p1[0]; xv[5] = p1[1]; xv[6] = p1[2]; xv[7] = p1[3]; }
                        else unpk8h(xr[a][m], xv);
                        const f32x4 a0 = acc[ai][bj][m][0], a1 = acc[ai][bj][m][1];
                        float zv[8]; float ra = 1.0f, rb = 0.0f; if (ST) { ra = rstd[a][m]; rb = -mean[a][m] * ra; }
#pragma unroll
                        for (int k = 0; k < 4; ++k) {
                            const f32v2_t x2 = (f32v2_t){xv[2 * k], xv[2 * k + 1]};
                            const f32v2_t c2 = (k < 2) ? (f32v2_t){a0[(2 * k) & 3], a0[(2 * k + 1) & 3]} : (f32v2_t){a1[(2 * k) & 3], a1[(2 * k + 1) & 3]};
                            f32v2_t z;
                            if (ST) { const f32v2_t xn = x2 * ra + rb; z = xn * G2[k] + (bv2[k] * c2 + E2[k]); }
                            else z = x2 * ALPHA + bv2[k] * c2;
                            zv[2 * k] = z.x; zv[2 * k + 1] = z.y;
                        }
                        *(u32x4*)((char*)strm + so) = pk8h(zv);
                    }
                asm volatile("" ::: "memory");
            }
        }
    }
};

struct EpiSig8 {
    static constexpr bool PERM = true, FP8 = true; static constexpr int NST = 16;
    bf16_t* big;
    DEVINL void operator()(AccRef acc, const Unit& u, int wr, int wc, int fr, int fq) const {
        bf16_t* dst = (bf16_t*)((char*)big + (u.pn < 4 ? B_GP : B_GR));
        const int row0 = u.pm * BM + wr * 64 + fr, col0 = (u.pn & 3) * 256 + wc * 32 + 8 * fq;
        constexpr float s = 1.0f / W13_SCALE;
#pragma unroll
        for (int ai = 0; ai < 2; ++ai)
#pragma unroll
            for (int m = 0; m < 4; ++m) {
                bf16_t* rowp = dst + (size_t)(row0 + ai * HALF + m * 16) * 1024 + col0;
#pragma unroll
                for (int bj = 0; bj < 2; ++bj) { f32x4 v0 = acc[ai][bj][m][0], v1 = acc[ai][bj][m][1];
                    sigmoid8(v0, v1, -1.4426950408889634f * s);
                    u32x4 w; w.x = pk2(v0[0], v0[1]); w.y = pk2(v0[2], v0[3]); w.z = pk2(v1[0], v1[1]); w.w = pk2(v1[2], v1[3]);
                    *(u32x4*)(rowp + bj * HALF) = w; }
            }
    }
};
struct EpiSwiglu8 {
    static constexpr bool PERM = true, FP8 = true; static constexpr int NST = 8;
    unsigned char* act; int ldc; int rb0;
    DEVINL void operator()(AccRef acc, const Unit& u, int wr, int wc, int fr, int fq) const {
        const int row0 = (u.pm - rb0) * BM + wr * 64 + fr, col0 = u.pn * HALF + wc * 32 + 8 * fq;
        constexpr float s = 1.0f / W13_SCALE;
#pragma unroll
        for (int ai = 0; ai < 2; ++ai)
#pragma unroll
            for (int m = 0; m < 4; ++m) {
                f32x4 v0, v1; swiglu8(v0, v1, acc[ai][0][m][0], acc[ai][0][m][1], acc[ai][1][m][0], acc[ai][1][m][1], -1.4426950408889634f * s, s * s);
                u32x2 w; w.x = pk4_fp8(v0[0], v0[1], v0[2], v0[3]); w.y = pk4_fp8(v1[0], v1[1], v1[2], v1[3]);
                *(u32x2*)(act + (size_t)(row0 + ai * HALF + m * 16) * ldc + col0) = w;
            }
    }
};
struct EpiPlain8 {
    static constexpr bool PERM = true, FP8 = true; static constexpr int NST = 16;
    bf16_t* out; float scale;
    DEVINL void operator()(AccRef acc, const Unit& u, int wr, int wc, int fr, int fq) const {
        const int row0 = u.pm * BM + wr * 64 + fr, col0 = u.pn * BM + wc * 32 + 8 * fq;
#pragma unroll
        for (int ai = 0; ai < 2; ++ai)
#pragma unroll
            for (int m = 0; m < 4; ++m) {
                const size_t off = (size_t)(row0 + ai * HALF + m * 16) * 1024 + col0;
#pragma unroll
                for (int bj = 0; bj < 2; ++bj) { const f32x4 v0 = acc[ai][bj][m][0] * scale, v1 = acc[ai][bj][m][1] * scale;
                    u32x4 w; w.x = pk2(v0[0], v0[1]); w.y = pk2(v0[2], v0[3]); w.z = pk2(v1[0], v1[1]); w.w = pk2(v1[2], v1[3]);
                    *(u32x4*)(out + off + bj * HALF) = w; }
            }
    }
};
struct EpiSwiglu8b {
    static constexpr bool PERM = true, FP8 = true; static constexpr int NST = 8;
    bf16_t* act; int ldc;
    DEVINL void operator()(AccRef acc, const Unit& u, int wr, int wc, int fr, int fq) const {
        const int row0 = u.pm * BM + wr * 64 + fr, col0 = u.pn * HALF + wc * 32 + 8 * fq;
        constexpr float s = 1.0f / W13_SCALE;
#pragma unroll
        for (int ai = 0; ai < 2; ++ai)
#pragma unroll
            for (int m = 0; m < 4; ++m) {
                f32x4 v0, v1; swiglu8(v0, v1, acc[ai][0][m][0], acc[ai][0][m][1], acc[ai][1][m][0], acc[ai][1][m][1], -1.4426950408889634f * s, s * s);
                u32x4 w; w.x = pk2(v0[0], v0[1]); w.y = pk2(v0[2], v0[3]); w.z = pk2(v1[0], v1[1]); w.w = pk2(v1[2], v1[3]);
                *(u32x4*)(act + (size_t)(row0 + ai * HALF + m * 16) * ldc + col0) = w;
            }
    }
};

struct Params { const float* in[24]; float* out; unsigned char* ws; int ph_lo, ph_hi; };
enum { I_X = 0, I_C, I_CTX, I_CCTX, I_ADAW, I_ADAB, I_WIN, I_POOLW, I_POOLS, I_WPOOLOUT, I_WRETOUT, I_DECAY, I_WOUT, I_LNMG, I_LNMB, I_LNFG, I_LNFB, I_FW1, I_FW3, I_FW2, I_ROUTER, I_MW1, I_MW3, I_MW2 };

constexpr int PH_PRO_A = 0, PH_PRO_B = 1, PH_L0 = 2, PH_PER_L = 20, NPH = PH_L0 + DEPTH * PH_PER_L;
enum { Q_IN = 0, Q_POOLV, Q_RET, Q_COMB, Q_MIX, Q_OUT, Q_LN1, Q_F0, Q_F1  , Q_LN2 = 18 };

template <class RowMap>
DEVINL void cvt_T(LAS float* tl, const float* __restrict__ src, int K, int N, bf16_t* __restrict__ dst, RowMap rm, int rot) {
    const int tid = tid_hidden(), G = gridDim.x;
    const int tn = N / 128, ntile = (K / 128) * tn;
    const int r = tid >> 5, c4 = (tid & 31) * 4;
    const int nl = tid & 127, kq = tid >> 7;
    f32x4 v[8];
    int tile = (blockIdx.x + rot) % G;
    if (tile < ntile) { const int k0 = (tile / tn) * 128, n0 = (tile % tn) * 128;
#pragma unroll
        for (int q = 0; q < 8; ++q) v[q] = *(const f32x4*)(src + (size_t)(k0 + r + 16 * q) * N + n0 + c4); }
    for (; tile < ntile; tile += G) {
        const int k0 = (tile / tn) * 128, n0 = (tile % tn) * 128;
#pragma unroll
        for (int q = 0; q < 8; ++q) *(LAS f32x4*)(tl + (r + 16 * q) * 132 + c4) = v[q];
        __syncthreads();
        const int nt2 = tile + G;
        if (nt2 < ntile) { const int k2 = (nt2 / tn) * 128, n2 = (nt2 % tn) * 128;
#pragma unroll
            for (int q = 0; q < 8; ++q) v[q] = *(const f32x4*)(src + (size_t)(k2 + r + 16 * q) * N + n2 + c4); }
        bf16_t* drow = dst + (size_t)rm(n0 + nl) * K + k0 + kq * 32;
#pragma unroll
        for (int h = 0; h < 4; ++h) { float e[8];
#pragma unroll
            for (int j = 0; j < 8; ++j) e[j] = tl[(kq * 32 + h * 8 + j) * 132 + nl];
            u32x4 w; w.x = pk2(e[0], e[1]); w.y = pk2(e[2], e[3]); w.z = pk2(e[4], e[5]); w.w = pk2(e[6], e[7]);
            *(u32x4*)(drow + h * 8) = w; }
        __syncthreads();
    }
}
template <class RowMap>
DEVINL void cvt_T8(LAS float* tl, const float* __restrict__ src, int K, int N, unsigned char* __restrict__ dst, RowMap rm, int rot, float scale, int ld = 0) {
    if (ld == 0) ld = N;
    const int tid = tid_hidden(), G = gridDim.x;
    const int tn = N / 128, ntile = (K / 128) * tn;
    const int r = tid >> 5, c4 = (tid & 31) * 4;
    const int nl = tid & 127, kq = tid >> 7;
    f32x4 v[8];
    int tile = (blockIdx.x + rot) % G;
    if (tile < ntile) { const int k0 = (tile / tn) * 128, n0 = (tile % tn) * 128;
#pragma unroll
        for (int q = 0; q < 8; ++q) v[q] = *(const f32x4*)(src + (size_t)(k0 + r + 16 * q) * ld + n0 + c4); }
    for (; tile < ntile; tile += G) {
        const int k0 = (tile / tn) * 128, n0 = (tile % tn) * 128;
#pragma unroll
        for (int q = 0; q < 8; ++q) *(LAS f32x4*)(tl + (r + 16 * q) * 132 + c4) = v[q] * scale;
        __syncthreads();
        const int nt2 = tile + G;
        if (nt2 < ntile) { const int k2 = (nt2 / tn) * 128, n2 = (nt2 % tn) * 128;
#pragma unroll
            for (int q = 0; q < 8; ++q) v[q] = *(const f32x4*)(src + (size_t)(k2 + r + 16 * q) * ld + n2 + c4); }
        unsigned char* drow = dst + (size_t)rm(n0 + nl) * K + k0 + kq * 32;
#pragma unroll
        for (int h = 0; h < 2; ++h) { float e[16];
#pragma unroll
            for (int j = 0; j < 16; ++j) e[j] = tl[(kq * 32 + h * 16 + j) * 132 + nl];
            u32x4 w; w.x = pk4_fp8(e[0], e[1], e[2], e[3]); w.y = pk4_fp8(e[4], e[5], e[6], e[7]); w.z = pk4_fp8(e[8], e[9], e[10], e[11]); w.w = pk4_fp8(e[12], e[13], e[14], e[15]);
            *(u32x4*)(drow + h * 16) = w; }
        __syncthreads();
    }
}
struct MapId { DEVINL int operator()(int n) const { return n; } };
struct MapIn { DEVINL int operator()(int n) const { if (n < 512 || n >= 1536) return n; const int j = (n - 512) & 127, base = n - j; return base + (j < 64 ? 2 * j : 2 * (j - 64) + 1); } };
struct MapGU { int off; DEVINL int operator()(int n) const { return (n >> 7) * 256 + (n & 127) + off; } };

DEVINL void convert_mixer_weights(const Params& p, LAS unsigned char* lds, int l) {
    LAS float* tl = (LAS float*)lds;
    unsigned char* wm = p.ws + WS_WMIX;
    cvt_T(tl, p.in[I_WIN] + (size_t)l * 1024 * INW, 1024, INW, (bf16_t*)(wm + WMIX_IN), MapIn(), 0);
    cvt_T(tl, p.in[I_WRETOUT] + (size_t)l * 1024 * 1024, 1024, 1024, (bf16_t*)(wm + WMIX_RET), MapId(), 128);
    cvt_T(tl, p.in[I_WOUT] + (size_t)l * 1024 * 1024, 1024, 1024, (bf16_t*)(wm + WMIX_OUT), MapId(), 0);
    cvt_T8(tl, p.in[I_WIN] + (size_t)l * 1024 * INW + 3584, 1024, 2048, wm + WMIX_IN8, MapId(), 96, W13_SCALE, INW);
    const int tid = tid_hidden(), G = gridDim.x;
    LAS float* sW = (LAS float*)lds;
    LAS float* sP = (LAS float*)(lds + 32768);
    const float* pw = p.in[I_POOLW] + (size_t)l * 4 * 128 * 128; const float* ps = p.in[I_POOLS] + (size_t)l * 512; const float* wo = p.in[I_WPOOLOUT] + (size_t)l * 512 * 1024;
    bf16_t* dst = (bf16_t*)(wm + WMIX_POOL);
    for (int item = (blockIdx.x + 64) % G; item < 64; item += G) {
        const int g = item >> 4, n0 = (item & 15) * 64;
        __syncthreads();
        for (int i = tid; i < 128 * 64; i += 512) { const int d = i >> 6, n = i & 63; sW[i] = ps[g * 128 + d] * wo[(size_t)(g * 128 + d) * 1024 + n0 + n]; }
        for (int i = tid; i < 128 * 128; i += 512) { const int c = i >> 7, d = i & 127; sP[c * 129 + d] = pw[(size_t)g * 16384 + i]; }
        __syncthreads();
        const int n = tid & 63, cq = tid >> 6;
        float a[16];
#pragma unroll
        for (int j = 0; j < 16; ++j) a[j] = 0.f;
        for (int d = 0; d < 128; ++d) { const float w = sW[d * 64 + n];
#pragma unroll
            for (int j = 0; j < 16; ++j) a[j] += sP[(cq * 16 + j) * 129 + d] * w; }
        u32x4 w0, w1; w0.x = pk2(a[0], a[1]); w0.y = pk2(a[2], a[3]); w0.z = pk2(a[4], a[5]); w0.w = pk2(a[6], a[7]);
        w1.x = pk2(a[8], a[9]); w1.y = pk2(a[10], a[11]); w1.z = pk2(a[12], a[13]); w1.w = pk2(a[14], a[15]);
        bf16_t* o = dst + (size_t)(n0 + n) * 512 + g * 128 + cq * 16;
        *(u32x4*)o = w0; *(u32x4*)(o + 8) = w1;
    }
    __syncthreads();
}
DEVINL void convert_ffn_weights(const Params& p, LAS unsigned char* lds, int l) {
    LAS float* tl = (LAS float*)lds;
    unsigned char* fw = p.ws + WS_BIG + F_W;
    const int li = l >> 1;
    if ((l & 1) == 0) {
        cvt_T8(tl, p.in[I_FW1] + (size_t)li * 1024 * DFF, 1024, DFF, fw, MapGU{0}, 0, W13_SCALE);
        cvt_T8(tl, p.in[I_FW3] + (size_t)li * 1024 * DFF, 1024, DFF, fw, MapGU{128}, 64, W13_SCALE);
        cvt_T8(tl, p.in[I_FW2] + (size_t)li * DFF * 1024, DFF, 1024, fw + F_DW2, MapId(), 128, W2_SCALE);
    } else {
        for (int e = 0; e < NEXP; ++e) {
            const size_t so = ((size_t)li * NEXP + e) * 1024 * EFF;
            cvt_T8(tl, p.in[I_MW1] + so, 1024, EFF, fw + (size_t)e * F_EW13, MapGU{0}, e * 32, W13_SCALE);
            cvt_T8(tl, p.in[I_MW3] + so, 1024, EFF, fw + (size_t)e * F_EW13, MapGU{128}, e * 32 + 16, W13_SCALE);
            cvt_T8(tl, p.in[I_MW2] + so, EFF, 1024, fw + (size_t)NEXP * F_EW13 + (size_t)e * F_EW2, MapId(), e * 32 + 8, W2_SCALE);
        }
    }
}

DEVINL void adaln_phase(const Params& p, LAS unsigned char* lds) {
    const int tid = tid_hidden(), G = gridDim.x;
    LAS float* s = (LAS float*)lds;
    LAS float* red = (LAS float*)(lds + 17 * 1024 * 4);
    for (int i = tid; i < 17 * 1024; i += 512) { const float v = i < 16 * 1024 ? p.in[I_C][i] : p.in[I_CCTX][i - 16 * 1024]; s[i] = v / (1.0f + __expf(-v)); }
    __syncthreads();
    float* mod = (float*)(p.ws + WS_MOD);
    for (int item = blockIdx.x; item < 4 * 96; item += G) {
        const int l = item / 96, n = (item % 96) * 64 + (tid & 63), kq = tid >> 6;
        const float* w = p.in[I_ADAW] + (size_t)l * 1024 * 6144 + n;
        float a[17];
#pragma unroll
        for (int r = 0; r < 17; ++r) a[r] = 0.f;
#pragma unroll 4
        for (int k = kq * 128; k < kq * 128 + 128; k += 4) { const float w0 = w[(size_t)k * 6144], w1 = w[(size_t)(k + 1) * 6144], w2 = w[(size_t)(k + 2) * 6144], w3 = w[(size_t)(k + 3) * 6144];
#pragma unroll
            for (int r = 0; r < 17; ++r) { const f32x4 sv = *(const LAS f32x4*)(s + r * 1024 + k); a[r] += sv[0] * w0 + sv[1] * w1 + sv[2] * w2 + sv[3] * w3; } }
#pragma unroll
        for (int r = 0; r < 17; ++r) red[(kq * 17 + r) * 64 + (tid & 63)] = a[r];
        __syncthreads();
        for (int i = tid; i < 17 * 64; i += 512) { const int r = i >> 6, c = i & 63; float v = 0.f;
#pragma unroll
            for (int q = 0; q < 8; ++q) v += red[(q * 17 + r) * 64 + c];
            const int nn = (item % 96) * 64 + c; mod[((size_t)l * 17 + r) * 6144 + nn] = v + p.in[I_ADAB][(size_t)l * 6144 + nn]; }
        __syncthreads();
    }
}
DEVINL void rope_phase(const Params& p) {
    float* tab = (float*)(p.ws + WS_ROPE);
    for (int i = blockIdx.x * 512 + tid_hidden(); i < 4096 * 64; i += gridDim.x * 512) {
        const int pos = i >> 6, f = i & 63;
        const float inv = expf(-logf(10000.0f) * (float)(f & 31) / 32.0f);
        const float ang = (float)(f < 32 ? (pos >> 6) : (pos & 63)) * inv;
        float sn, cs; sincosf(ang, &sn, &cs);
        tab[2 * i] = cs; tab[2 * i + 1] = sn;
    }
}

DEVINL bf16_t* strm_row(const Params& p, int t) { return (bf16_t*)(p.ws + WS_A) + (size_t)t * 1024; }
DEVINL bf16_t* regA(const Params& p) { return (bf16_t*)p.out; }
DEVINL unsigned char* regA8(const Params& p) { return (unsigned char*)p.out + U; }
DEVINL const float* in_row0(const Params& p, int t) { return t < NLAT ? p.in[I_X] + (size_t)t * 1024 : p.in[I_CTX] + (size_t)(t - NLAT) * 1024; }
DEVINL const float* mod_row(const Params& p, int l, int t, int which) { const int r = t < NLAT ? (t >> 12) : 16; return (const float*)(p.ws + WS_MOD) + (((size_t)l * 17 + r) * 6 + which) * 1024; }

DEVINL void modulate0_phase(const Params& p) {
    const int tid = tid_hidden(), lane = tid & 63, gw = blockIdx.x * 8 + (tid >> 6), nw = gridDim.x * 8;
    bf16_t* h = regA(p);
    for (int t = gw; t < T; t += 2 * nw) {
        const int t2 = t + nw; const bool has2 = t2 < T; const int tb = has2 ? t2 : t;
        const float* xa = in_row0(p, t); const float* xb = in_row0(p, tb);
        f32x4 va[4], vb[4];
#pragma unroll
        for (int j = 0; j < 4; ++j) { va[j] = *(const f32x4*)(xa + j * 256 + lane * 4); vb[j] = *(const f32x4*)(xb + j * 256 + lane * 4); }
        const float* sha = mod_row(p, 0, t, 0); const float* sca = mod_row(p, 0, t, 1); const float* shb = mod_row(p, 0, tb, 0); const float* scb = mod_row(p, 0, tb, 1);
#pragma unroll
        for (int j = 0; j < 4; ++j) { const int c = j * 256 + lane * 4;
            const f32x4 ya = va[j] * (*(const f32x4*)(sca + c) + 1.0f) + *(const f32x4*)(sha + c); u32x2 w; w.x = pk2(ya[0], ya[1]); w.y = pk2(ya[2], ya[3]); *(u32x2*)(h + (size_t)t * 1024 + c) = w; *(unsigned*)(regA8(p) + (size_t)t * 1024 + c) = pk4_fp8(ya[0], ya[1], ya[2], ya[3]);
            if (has2) { const f32x4 yb = vb[j] * (*(const f32x4*)(scb + c) + 1.0f) + *(const f32x4*)(shb + c); u32x2 w2; w2.x = pk2(yb[0], yb[1]); w2.y = pk2(yb[2], yb[3]); *(u32x2*)(h + (size_t)tb * 1024 + c) = w2; *(unsigned*)(regA8(p) + (size_t)tb * 1024 + c) = pk4_fp8(yb[0], yb[1], yb[2], yb[3]); } }
    }
}

DEVINL void acc8(float (&a)[8], const u32x4 v) { a[0] += bflo(v.x); a[1] += bfhi(v.x); a[2] += bflo(v.y); a[3] += bfhi(v.y); a[4] += bflo(v.z); a[5] += bfhi(v.z); a[6] += bflo(v.w); a[7] += bfhi(v.w); }
template <int GI, bool HORIZ>
DEVINL void pool_item(const bf16_t* __restrict__ src, const bf16_t* __restrict__ usrc, bf16_t* __restrict__ dst, int t, int ch) {
    constexpr int W = 2 << GI, LEFT = W / 2, RIGHT = W - 1 - LEFT;
    const bool lat = t < NLAT;
    int pos, last, stride;
    if (HORIZ) { pos = lat ? (t & 63) : ((t - NLAT) & 255); last = lat ? 63 : 255; stride = 1; }
    else { pos = (t >> 6) & 63; last = 63; stride = 64; }
    float a[8];
#pragma unroll
    for (int j = 0; j < 8; ++j) a[j] = 0.f;
    if (!HORIZ && !lat) { *(u32x4*)(dst + (size_t)t * 512 + ch) = *(const u32x4*)(src + (size_t)t * 512 + ch); return; }
    const int lo = max(pos - LEFT, 0), hi = min(pos + RIGHT, last);
    u32x4 wv[W];
#pragma unroll
    for (int k = 0; k < W; ++k) { const int qc = min(max(pos - LEFT + k, lo), hi); wv[k] = *(const u32x4*)(src + (size_t)(t + (qc - pos) * stride) * 512 + ch); }
#pragma unroll
    for (int k = 0; k < W; ++k) { const int q = pos - LEFT + k; if (q >= lo && q <= hi) acc8(a, wv[k]); }
    const float inv = 1.0f / (float)(hi - lo + 1);
    u32x4 w;
    if (HORIZ) { const u32x4 uv = *(const u32x4*)(usrc + (size_t)t * 512 + ch);
        w.x = pk2(a[0] * inv - bflo(uv.x), a[1] * inv - bfhi(uv.x)); w.y = pk2(a[2] * inv - bflo(uv.y), a[3] * inv - bfhi(uv.y));
        w.z = pk2(a[4] * inv - bflo(uv.z), a[5] * inv - bfhi(uv.z)); w.w = pk2(a[6] * inv - bflo(uv.w), a[7] * inv - bfhi(uv.w)); }
    else { w.x = pk2(a[0] * inv, a[1] * inv); w.y = pk2(a[2] * inv, a[3] * inv); w.z = pk2(a[4] * inv, a[5] * inv); w.w = pk2(a[6] * inv, a[7] * inv); }
    *(u32x4*)(dst + (size_t)t * 512 + ch) = w;
}
template <bool HORIZ>
DEVINL void pool_phase(const Params& p, int Tact) {
    const int tid = tid_hidden(), lane = tid & 63, gw = blockIdx.x * 8 + (tid >> 6), nw = gridDim.x * 8;
    bf16_t* u = (bf16_t*)(p.ws + WS_BIG + B_U); bf16_t* vm = regA(p);
    const bf16_t* src = HORIZ ? vm : u; bf16_t* dst = HORIZ ? u : vm;
    for (int q = gw; q < Tact / 4; q += nw) {
        const int t = q * 4 + (lane >> 4), cl = (lane & 15) * 8;
        pool_item<3, HORIZ>(src, u, dst, t, 384 + cl); pool_item<2, HORIZ>(src, u, dst, t, 256 + cl); pool_item<1, HORIZ>(src, u, dst, t, 128 + cl); pool_item<0, HORIZ>(src, u, dst, t, cl);
    }
}
struct CombSet { u32x2 a[4], b[4], g[4]; };
DEVINL void comb_load(const Params& p, int t, int lane, CombSet& S) {
    const bf16_t* of = (const bf16_t*)(p.ws + WS_BIG + B_OF); const bf16_t* ob = (const bf16_t*)(p.ws + WS_BIG + B_OB); const bf16_t* sg = (const bf16_t*)(p.ws + WS_BIG + B_SG);
#pragma unroll
    for (int j = 0; j < 4; ++j) { const size_t off = (size_t)t * 1024 + j * 256 + lane * 4; S.a[j] = *(const u32x2*)(of + off); S.b[j] = *(const u32x2*)(ob + off); S.g[j] = *(const u32x2*)(sg + off); }
}
DEVINL void comb_row(const Params& p, int t, int lane, const CombSet& S) {
    bf16_t* ur = (bf16_t*)(p.ws + WS_BIG + B_URET);
#pragma unroll
    for (int j = 0; j < 4; ++j) {
        float o[4] = {bflo(S.a[j].x) + bflo(S.b[j].x), bfhi(S.a[j].x) + bfhi(S.b[j].x), bflo(S.a[j].y) + bflo(S.b[j].y), bfhi(S.a[j].y) + bfhi(S.b[j].y)};
        const float mean = wave_sum(o[0] + o[1] + o[2] + o[3]) * (1.0f / 256.0f);
        float q = 0.f;
#pragma unroll
        for (int e = 0; e < 4; ++e) { o[e] -= mean; q += o[e] * o[e]; }
        const float rstd = rsqrtf(wave_sum(q) * (1.0f / 256.0f) + LN_EPS);
        u32x2 w; w.x = pk2(bflo(S.g[j].x) * o[0] * rstd, bfhi(S.g[j].x) * o[1] * rstd); w.y = pk2(bflo(S.g[j].y) * o[2] * rstd, bfhi(S.g[j].y) * o[3] * rstd);
        *(u32x2*)(ur + (size_t)t * 1024 + j * 256 + lane * 4) = w;
    }
}
DEVINL void combine_phase(const Params& p, int Tact) {
    const int tid = tid_hidden(), lane = tid & 63, gw = blockIdx.x * 8 + (tid >> 6), nw = gridDim.x * 8;
    CombSet A0, A1, B0, B1;
    int ta = gw;
    if (ta < Tact) { comb_load(p, ta, lane, A0); comb_load(p, min(ta + nw, Tact - 1), lane, A1); }
    while (ta < Tact) {
        const int tn = ta + 2 * nw;
        if (tn < Tact) { comb_load(p, tn, lane, B0); comb_load(p, min(tn + nw, Tact - 1), lane, B1); }
        comb_row(p, ta, lane, A0); if (ta + nw < Tact) comb_row(p, ta + nw, lane, A1);
        if (tn >= Tact) break;
        const int tn2 = tn + 2 * nw;
        if (tn2 < Tact) { comb_load(p, tn2, lane, A0); comb_load(p, min(tn2 + nw, Tact - 1), lane, A1); }
        comb_row(p, tn, lane, B0); if (tn + nw < Tact) comb_row(p, tn + nw, lane, B1);
        ta = tn2;
    }
}

struct LnRaw { u32x4 r[2]; };
DEVINL void ln_load_row(const bf16_t* xr, int lane, LnRaw& R) { R.r[0] = *(const u32x4*)(xr + lane * 8); R.r[1] = *(const u32x4*)(xr + 512 + lane * 8); }
DEVINL void ln_norm16(float (&v)[2][8], float& mean_o, float& rstd_o) {
    float s = 0.f;
#pragma unroll
    for (int j = 0; j < 2; ++j)
#pragma unroll
        for (int e = 0; e < 8; ++e) s += v[j][e];
    const float mean = wave_sum(s) * (1.0f / 1024.0f);
    float q = 0.f;
#pragma unroll
    for (int j = 0; j < 2; ++j)
#pragma unroll
        for (int e = 0; e < 8; ++e) { v[j][e] -= mean; q += v[j][e] * v[j][e]; }
    const float rstd = rsqrtf(wave_sum(q) * (1.0f / 1024.0f) + LN_EPS);
#pragma unroll
    for (int j = 0; j < 2; ++j)
#pragma unroll
        for (int e = 0; e < 8; ++e) v[j][e] *= rstd;
    mean_o = mean; rstd_o = rstd;
}
DEVINL void lds8f(const LAS float* p, float (&v)[8]) { const f32x4 a = *(const LAS f32x4*)p, b = *(const LAS f32x4*)(p + 4); v[0] = a[0]; v[1] = a[1]; v[2] = a[2]; v[3] = a[3]; v[4] = b[0]; v[5] = b[1]; v[6] = b[2]; v[7] = b[3]; }
DEVINL int mod_ridx(int t) { return t < NLAT ? (t >> 12) : 16; }
DEVINL void lds_fill(LAS float* dst, const float* src, int tid) { for (int i = tid; i < 256; i += 512) *(LAS f32x4*)(dst + 4 * i) = *(const f32x4*)(src + 4 * i); }
DEVINL void ln1_row(const Params& p, int l, int t, int lane, bool moe, const LnRaw& R, const LAS float* sG, const LAS float* sB, const LAS float* sSC, const LAS float* sSH, LAS float* sR, LAS int* sCnt) {
    bf16_t* h2 = regA(p);
    float v[2][8]; unpk8h(R.r[0], v[0]); unpk8h(R.r[1], v[1]);
    float mean, rstd; ln_norm16(v, mean, rstd);
    if (lane == 0) { float* st1 = (float*)(p.ws + WS_ST1); st1[2 * t] = mean; st1[2 * t + 1] = rstd; }
    float lg[8];
#pragma unroll
    for (int e = 0; e < 8; ++e) lg[e] = 0.f;
#pragma unroll
    for (int j = 0; j < 2; ++j) { const int c = j * 512 + lane * 8;
        float g8[8], b8[8], s8[8], h8[8], hv[8]; lds8f(sG + c, g8); lds8f(sB + c, b8); lds8f(sSC + c, s8); lds8f(sSH + c, h8);
#pragma unroll
        for (int e = 0; e < 8; ++e) hv[e] = (v[j][e] * g8[e] + b8[e]) * (s8[e] + 1.0f) + h8[e];
        { u32x2 w8; w8.x = pk4_fp8(hv[0], hv[1], hv[2], hv[3]); w8.y = pk4_fp8(hv[4], hv[5], hv[6], hv[7]); *(u32x2*)((unsigned char*)h2 + (size_t)t * 1024 + c) = w8; }
        if (moe) {
#pragma unroll
            for (int e = 0; e < 8; ++e) { float w8[8]; lds8f(sR + e * 1024 + c, w8);
#pragma unroll
                for (int i = 0; i < 8; ++i) lg[e] += hv[i] * w8[i]; }
        }
    }
    if (moe) {
        int* toke = (int*)(p.ws + WS_TOKE); float* tokw = (float*)(p.ws + WS_TOKW);
#pragma unroll
        for (int e = 0; e < 8; ++e) lg[e] = wave_sum(lg[e]);
        int e0 = 0; float m0 = lg[0];
#pragma unroll
        for (int e = 1; e < 8; ++e) if (lg[e] > m0) { m0 = lg[e]; e0 = e; }
        int e1 = -1; float m1 = -3.0e38f;
#pragma unroll
        for (int e = 0; e < 8; ++e) if (e != e0 && lg[e] > m1) { m1 = lg[e]; e1 = e; }
        if (e1 < 0) { e1 = (e0 + 1) & 7; m1 = m0; }
        const float ex = __expf(m1 - m0), w0 = 1.0f / (1.0f + ex), w1 = ex / (1.0f + ex);
        if (lane == 0) { toke[2 * t] = e0; toke[2 * t + 1] = e1; tokw[2 * t] = w0; tokw[2 * t + 1] = w1; __hip_atomic_fetch_add(&sCnt[e0], 1, __ATOMIC_RELAXED, __HIP_MEMORY_SCOPE_WORKGROUP); __hip_atomic_fetch_add(&sCnt[e1], 1, __ATOMIC_RELAXED, __HIP_MEMORY_SCOPE_WORKGROUP); }
    }
}
DEVINL void ln1_phase(const Params& p, LAS unsigned char* lds, int l, int Tact) {
    const int tid = tid_hidden(), lane = tid & 63, wv = tid >> 6, G = gridDim.x;
    const bool moe = (l & 1) != 0;
    LAS float* sR = (LAS float*)lds;
    LAS int* sCnt = (LAS int*)(lds + 32768);
    LAS float* sG = (LAS float*)(lds + 36864); LAS float* sB = sG + 1024; LAS float* sSC = sB + 1024; LAS float* sSH = sSC + 2048;
    const int per = (Tact + G - 1) / G, t0 = blockIdx.x * per, t1 = min(t0 + per, Tact);
    const int r_lo = mod_ridx(min(t0, Tact - 1)), r_hi = mod_ridx(max(t1 - 1, 0));
    if (moe) { const float* wr = p.in[I_ROUTER] + (size_t)(l >> 1) * 1024 * 8; for (int i = tid; i < 8192; i += 512) sR[(i & 7) * 1024 + (i >> 3)] = wr[i]; if (tid < 8) sCnt[tid] = 0; }
    { const float* modl = (const float*)(p.ws + WS_MOD) + (size_t)l * 17 * 6144;
      lds_fill(sG, p.in[I_LNMG] + (size_t)l * 1024, tid); lds_fill(sB, p.in[I_LNMB] + (size_t)l * 1024, tid);
      lds_fill(sSC, modl + ((size_t)r_lo * 6 + 4) * 1024, tid); lds_fill(sSC + 1024, modl + ((size_t)r_hi * 6 + 4) * 1024, tid);
      lds_fill(sSH, modl + ((size_t)r_lo * 6 + 3) * 1024, tid); lds_fill(sSH + 1024, modl + ((size_t)r_hi * 6 + 3) * 1024, tid); }
    __syncthreads();
#define LN1_ROW(tt, RR) do { const int _o = (mod_ridx(tt) == r_lo) ? 0 : 1024; ln1_row(p, l, (tt), lane, moe, RR, sG, sB, sSC + _o, sSH + _o, sR, sCnt); } while (0)
    LnRaw A0, A1, B0, B1;
    int ta = t0 + wv;
    if (ta < t1) { ln_load_row(strm_row(p, ta), lane, A0); ln_load_row(strm_row(p, min(ta + 8, t1 - 1)), lane, A1); }
    while (ta < t1) {
        const int tn = ta + 16;
        if (tn < t1) { ln_load_row(strm_row(p, tn), lane, B0); ln_load_row(strm_row(p, min(tn + 8, t1 - 1)), lane, B1); }
        LN1_ROW(ta, A0); if (ta + 8 < t1) LN1_ROW(ta + 8, A1);
        if (tn >= t1) break;
        const int tn2 = tn + 16;
        if (tn2 < t1) { ln_load_row(strm_row(p, tn2), lane, A0); ln_load_row(strm_row(p, min(tn2 + 8, t1 - 1)), lane, A1); }
        LN1_ROW(tn, B0); if (tn + 8 < t1) LN1_ROW(tn + 8, B1);
        ta = tn2;
    }
#undef LN1_ROW
    __syncthreads();
    if (moe && tid < 8) ((int*)(p.ws + WS_WGCNT))[blockIdx.x * 8 + tid] = sCnt[tid];
    __syncthreads();
}

DEVINL void moe_scatter_phase(const Params& p, LAS unsigned char* lds, int Tact) {
    const int tid = tid_hidden(), lane = tid & 63, wv = tid >> 6, G = gridDim.x;
    LAS int* sC = (LAS int*)lds;
    LAS int* sBase = (LAS int*)(lds + 16384);
    LAS int* sE = (LAS int*)(lds + 16384 + 256);
    LAS int* sD = (LAS int*)(lds + 16384 + 256 + 4096);
    const int* wgc = (const int*)(p.ws + WS_WGCNT);
    for (int i = tid; i < G * 8; i += 512) sC[i] = wgc[i];
    __syncthreads();
    if (tid < 8) { int tot = 0, before = 0; for (int g = 0; g < G; ++g) { const int c = sC[g * 8 + tid]; if (g < (int)blockIdx.x) before += c; tot += c; } sBase[tid] = before; sBase[8 + tid] = (tot + 255) / 256 * 256; }
    __syncthreads();
    if (tid == 0) { int acc = 0; for (int e = 0; e < 8; ++e) { const int pd = sBase[8 + e]; sBase[e] += acc; acc += pd; sBase[8 + e] = acc; } }
    __syncthreads();
    const int per = (Tact + G - 1) / G, t0 = blockIdx.x * per, t1 = min(t0 + per, Tact), na = max(t1 - t0, 0) * 2;
    const int* toke = (const int*)(p.ws + WS_TOKE); int* tokd = (int*)(p.ws + WS_TOKD);
    for (int a = tid; a < na; a += 512) sE[a] = toke[2 * t0 + a] & 7;
    __syncthreads();
    for (int a = tid; a < na; a += 512) { const int e = sE[a]; int r = 0; for (int b = 0; b < a; ++b) r += (sE[b] == e) ? 1 : 0; int d = sBase[e] + r; d = min(max(d, 0), MAXRB * 256 - 1); sD[a] = d; tokd[2 * t0 + a] = d; }
    if (blockIdx.x == 0) {
        int* blke = (int*)(p.ws + WS_BLKE);
        if (tid == 0) blke[0] = sBase[15] / 256;
        if (tid < 7) blke[1 + tid] = sBase[8 + tid] / 256;
        for (int rb = tid; rb < MAXRB; rb += 512) { int e = 0; while (e < 7 && rb * 256 >= sBase[8 + e]) ++e; blke[8 + rb] = e; }
    }
    __syncthreads();
    const unsigned char* h2 = (const unsigned char*)regA(p); unsigned char* xs = p.ws + WS_BIG + F_XS;
    for (int a0 = wv; a0 < na; a0 += 64) {
        u32x4 v0[8];
#pragma unroll
        for (int r = 0; r < 8; ++r) { const int a = min(a0 + 8 * r, na - 1), t = t0 + (a >> 1); v0[r] = *(const u32x4*)(h2 + (size_t)t * 1024 + lane * 16); }
#pragma unroll
        for (int r = 0; r < 8; ++r) { const int a = a0 + 8 * r; if (a < na) { const int d = sD[a]; *(u32x4*)(xs + (size_t)d * 1024 + lane * 16) = v0[r]; } }
    }
    __syncthreads();
}

struct Ln2Set { LnRaw z; LnRaw ya, yb; float w0, w1, m1, r1; };
struct Ln2Par { const LAS float* G; const LAS float* B; const LAS float* SC; const LAS float* SH; const LAS float* M5; const LAS float* GM; const LAS float* BM; };
DEVINL void ln2_load(const Params& p, int t, int lane, bool moe, Ln2Set& S) {
    if (moe) { const int* tokd = (const int*)(p.ws + WS_TOKD); const float* tokw = (const float*)(p.ws + WS_TOKW); const bf16_t* yk = (const bf16_t*)(p.ws + WS_BIG + F_YK);
        const int d0 = tokd[2 * t], d1 = tokd[2 * t + 1]; S.w0 = tokw[2 * t]; S.w1 = tokw[2 * t + 1]; const float* st1 = (const float*)(p.ws + WS_ST1); S.m1 = st1[2 * t]; S.r1 = st1[2 * t + 1];
        ln_load_row(yk + (size_t)d0 * 1024, lane, S.ya); ln_load_row(yk + (size_t)d1 * 1024, lane, S.yb); }
    ln_load_row(strm_row(p, t), lane, S.z);
}
DEVINL void ln2_row(const Params& p, int l, int t, int lane, bool moe, const Ln2Set& S, const Ln2Par& P) {
    float v[2][8]; unpk8h(S.z.r[0], v[0]); unpk8h(S.z.r[1], v[1]);
    if (moe) {
#pragma unroll
        for (int j = 0; j < 2; ++j) { const int c = j * 512 + lane * 8; float a8[8], b8[8], g8[8], e8[8], m8[8]; unpk8(S.ya.r[j], a8); unpk8(S.yb.r[j], b8); lds8f(P.GM + c, g8); lds8f(P.BM + c, e8); lds8f(P.M5 + c, m8);
#pragma unroll
            for (int e = 0; e < 8; ++e) { const float x1 = (v[j][e] - S.m1) * S.r1 * g8[e] + e8[e];
                v[j][e] = x1 * ALPHA + m8[e] * (S.w0 * a8[e] + S.w1 * b8[e]); } } }
    float mean2, rstd2; ln_norm16(v, mean2, rstd2);
    const bool last = l + 1 >= DEPTH, store_x = moe || last;
    if (!store_x && lane == 0) { float* st2 = (float*)(p.ws + WS_ST2); st2[2 * t] = mean2; st2[2 * t + 1] = rstd2; }
#pragma unroll
    for (int j = 0; j < 2; ++j) { const int c = j * 512 + lane * 8; float g8[8], b8[8], xv[8]; lds8f(P.G + c, g8); lds8f(P.B + c, b8);
#pragma unroll
        for (int e = 0; e < 8; ++e) xv[e] = v[j][e] * g8[e] + b8[e];
        if (last) { float* o = p.out + (size_t)t * 1024 + c; *(f32x4*)o = (f32x4){xv[0], xv[1], xv[2], xv[3]}; *(f32x4*)(o + 4) = (f32x4){xv[4], xv[5], xv[6], xv[7]}; }
        else if (store_x) *(u32x4*)(strm_row(p, t) + c) = pk8h(xv);
        if (!last) { float s8[8], h8[8], hv[8]; lds8f(P.SC + c, s8); lds8f(P.SH + c, h8);
#pragma unroll
            for (int e = 0; e < 8; ++e) hv[e] = xv[e] * (s8[e] + 1.0f) + h8[e];
            *(u32x4*)(regA(p) + (size_t)t * 1024 + c) = pk8(hv);
            u32x2 w8; w8.x = pk4_fp8(hv[0], hv[1], hv[2], hv[3]); w8.y = pk4_fp8(hv[4], hv[5], hv[6], hv[7]); *(u32x2*)(regA8(p) + (size_t)t * 1024 + c) = w8; }
    }
}
DEVINL void ln2_phase(const Params& p, LAS unsigned char* lds, int l, int Tact) {
    const int tid = tid_hidden(), lane = tid & 63, wv = tid >> 6, G = gridDim.x;
    const bool moe = (l & 1) != 0, last = l + 1 >= DEPTH;
    LAS float* sG = (LAS float*)lds; LAS float* sB = sG + 1024; LAS float* sSC = sB + 1024; LAS float* sSH = sSC + 2048; LAS float* sM5 = sSH + 2048; LAS float* sGM = sM5 + 2048; LAS float* sBM = sGM + 1024;
    const int per = (Tact + G - 1) / G, t0 = blockIdx.x * per, t1 = min(t0 + per, Tact);
    const int r_lo = mod_ridx(min(t0, Tact - 1)), r_hi = mod_ridx(max(t1 - 1, 0));
    __syncthreads();
    { const float* mod = (const float*)(p.ws + WS_MOD); const float* modl = mod + (size_t)l * 17 * 6144; const float* modn = mod + (size_t)(last ? l : l + 1) * 17 * 6144;
      lds_fill(sG, p.in[I_LNFG] + (size_t)l * 1024, tid); lds_fill(sB, p.in[I_LNFB] + (size_t)l * 1024, tid);
      lds_fill(sSC, modn + ((size_t)r_lo * 6 + 1) * 1024, tid); lds_fill(sSC + 1024, modn + ((size_t)r_hi * 6 + 1) * 1024, tid);
      lds_fill(sSH, modn + ((size_t)r_lo * 6 + 0) * 1024, tid); lds_fill(sSH + 1024, modn + ((size_t)r_hi * 6 + 0) * 1024, tid);
      lds_fill(sM5, modl + ((size_t)r_lo * 6 + 5) * 1024, tid); lds_fill(sM5 + 1024, modl + ((size_t)r_hi * 6 + 5) * 1024, tid);
      lds_fill(sGM, p.in[I_LNMG] + (size_t)l * 1024, tid); lds_fill(sBM, p.in[I_LNMB] + (size_t)l * 1024, tid); }
    __syncthreads();
#define LN2_ROW(tt, SS) do { const int _o = (mod_ridx(tt) == r_lo) ? 0 : 1024; const Ln2Par _P{sG, sB, sSC + _o, sSH + _o, sM5 + _o, sGM, sBM}; ln2_row(p, l, (tt), lane, moe, SS, _P); } while (0)
    Ln2Set A0, A1, B0, B1;
    int ta = t0 + wv;
    if (ta < t1) { ln2_load(p, ta, lane, moe, A0); ln2_load(p, min(ta + 8, t1 - 1), lane, moe, A1); }
    while (ta < t1) {
        const int tn = ta + 16;
        if (tn < t1) { ln2_load(p, tn, lane, moe, B0); ln2_load(p, min(tn + 8, t1 - 1), lane, moe, B1); }
        LN2_ROW(ta, A0); if (ta + 8 < t1) LN2_ROW(ta + 8, A1);
        if (tn >= t1) break;
        const int tn2 = tn + 16;
        if (tn2 < t1) { ln2_load(p, tn2, lane, moe, A0); ln2_load(p, min(tn2 + 8, t1 - 1), lane, moe, A1); }
        LN2_ROW(tn, B0); if (tn + 8 < t1) LN2_ROW(tn + 8, B1);
        ta = tn2;
    }
#undef LN2_ROW
    __syncthreads();
}

DEVINL bf16x8 cat8(v4i16_t a, v4i16_t b) { bf16x8 r; r[0] = a[0]; r[1] = a[1]; r[2] = a[2]; r[3] = a[3]; r[4] = b[0]; r[5] = b[1]; r[6] = b[2]; r[7] = b[3]; return r; }
DEVINL void retention_phase(const Params& p, LAS unsigned char* lds, int l, bool need_ctx) {
    constexpr int RS = 272;
    int tid = threadIdx.x; asm volatile("" : "+v"(tid));
    const int w = __builtin_amdgcn_readfirstlane(tid >> 6), lane = tid & 63, fr = lane & 15, fq = lane >> 4;
    LAS unsigned char* Qs = lds; LAS unsigned char* Ks = lds + 34816; LAS unsigned char* Vs = lds + 69632; LAS unsigned char* Ps = lds + 104448;
    LAS float* tqd = (LAS float*)(lds + LDS_TAB); LAS float* tkd = tqd + 128;
    const bf16_t* qg = (const bf16_t*)(p.ws + WS_BIG + B_Q); const bf16_t* kg = (const bf16_t*)(p.ws + WS_BIG + B_K); const bf16_t* vg = (const bf16_t*)(p.ws + WS_BIG + B_V);
    const int lr = tid >> 4, lc = tid & 15;
    const int trq = fr >> 2, trp = fr & 3;
    for (int item = blockIdx.x; item < 256; item += gridDim.x) {
        const int dvs = item & 1, dir = (item >> 1) & 1, hd = (item >> 2) & 3, b = item >> 4;
        bf16_t* og = (bf16_t*)(p.ws + WS_BIG + (dir ? B_OB : B_OF));
        const float zl = p.in[I_DECAY][l * 8 + dir * 4 + hd];
        const float lg2 = -log1pf(expf(-zl)) * 1.4426950408889634f;
        __syncthreads();
        if (tid < 128) { tqd[tid] = exp2f(lg2 * (float)(dir ? 128 - tid : tid + 1)); tkd[tid] = exp2f(lg2 * (float)(dir ? tid : 127 - tid)); }
        const float cdec = exp2f(lg2 * 128.0f);
        float afac[4];
#pragma unroll
        for (int jj = 0; jj < 4; ++jj) afac[jj] = exp2f(lg2 * (float)(dir ? (4 * fq + jj - fr) : (fr - 4 * fq - jj)));
        f32x4 S[8];
#pragma unroll
        for (int t = 0; t < 8; ++t) S[t] = (f32x4){0.f, 0.f, 0.f, 0.f};
        u32x4 rq[4], rk[4], rv[4];
#define RET_TOK0(c) ((c) < 2 ? NLAT + b * 256 + (dir ? 1 - (c) : (c)) * 128 : b * 4096 + (dir ? 33 - (c) : (c) - 2) * 128)
#define RET_LOAD(c) do { const int _t0 = RET_TOK0(c); _Pragma("unroll") for (int ps = 0; ps < 4; ++ps) { const size_t _t = (size_t)(_t0 + lr + 32 * ps); \
            rq[ps] = *(const u32x4*)(qg + _t * 512 + hd * 128 + lc * 8); rk[ps] = *(const u32x4*)(kg + _t * 512 + hd * 128 + lc * 8); rv[ps] = *(const u32x4*)(vg + _t * 1024 + hd * 256 + dvs * 128 + lc * 8); } } while (0)
        RET_LOAD(0);
        for (int c = 0; c < 34; ++c) {
            const int tok0 = RET_TOK0(c);
            __syncthreads();
#pragma unroll
            for (int ps = 0; ps < 4; ++ps) { const int o = (lr + 32 * ps) * RS + lc * 16; *(LAS u32x4*)(Qs + o) = rq[ps]; *(LAS u32x4*)(Ks + o) = rk[ps]; *(LAS u32x4*)(Vs + o) = rv[ps]; }
            __syncthreads();
            if (c + 1 < 34) RET_LOAD(c + 1);
            const bool do_out = (c >= 2) || need_ctx;
            if (do_out) {
                const int rt = w < 4 ? w : 11 - w;
                bf16x8 qf[4];
#pragma unroll
                for (int s = 0; s < 4; ++s) qf[s] = *(const LAS bf16x8*)(Qs + (16 * rt + fr) * RS + (32 * s + 8 * fq) * 2);
                const int i = 16 * rt + fr;
#pragma unroll
                for (int t = 0; t < 8; ++t) {
                    const bool live = dir ? (t >= rt) : (t <= rt);
                    f32x4 a = (f32x4){0.f, 0.f, 0.f, 0.f};
                    if (live) {
#pragma unroll
                        for (int s = 0; s < 4; ++s) { const bf16x8 kf = *(const LAS bf16x8*)(Ks + (16 * t + fr) * RS + (32 * s + 8 * fq) * 2); a = __builtin_amdgcn_mfma_f32_16x16x32_bf16(kf, qf[s], a, 0, 0, 0); }
                        const float bt = __builtin_amdgcn_exp2f(lg2 * 16.0f * (float)(dir ? t - rt : rt - t));
#pragma unroll
                        for (int jj = 0; jj < 4; ++jj) { const int dd = dir ? (4 * fq + jj - fr) : (fr - 4 * fq - jj); a[jj] = (t != rt || dd >= 0) ? a[jj] * (afac[jj] * bt) : 0.f; }
                    }
                    u32x2 pw; pw.x = pk2(a[0], a[1]); pw.y = pk2(a[2], a[3]);
                    *(LAS u32x2*)(Ps + i * RS + (16 * t + 4 * fq) * 2) = pw;
                }
            }
            __syncthreads();
            bf16x8 vf[4];
#pragma unroll
            for (int s = 0; s < 4; ++s) { LAS unsigned char* a0 = Vs + (32 * s + 8 * fq + trq) * RS + (16 * w + 4 * trp) * 2;
                vf[s] = cat8(__builtin_amdgcn_ds_read_tr16_b64_v4i16((LAS v4i16_t*)a0), __builtin_amdgcn_ds_read_tr16_b64_v4i16((LAS v4i16_t*)(a0 + 4 * RS))); }
            if (do_out) {
                bf16x8 Sb[4];
#pragma unroll
                for (int s = 0; s < 4; ++s) { u32x4 t4; t4.x = pk2(S[2 * s][0], S[2 * s][1]); t4.y = pk2(S[2 * s][2], S[2 * s][3]); t4.z = pk2(S[2 * s + 1][0], S[2 * s + 1][1]); t4.w = pk2(S[2 * s + 1][2], S[2 * s + 1][3]); Sb[s] = __builtin_bit_cast(bf16x8, t4); }
#pragma unroll
                for (int ip = 0; ip < 4; ++ip) {
                    const int i0 = 16 * (2 * ip) + fr, i1 = i0 + 16;
                    bf16x8 q0[4], q1[4];
#pragma unroll
                    for (int s = 0; s < 4; ++s) { q0[s] = *(const LAS bf16x8*)(Qs + i0 * RS + (32 * s + 8 * fq) * 2); q1[s] = *(const LAS bf16x8*)(Qs + i1 * RS + (32 * s + 8 * fq) * 2); }
                    f32x4 a0 = (f32x4){0.f, 0.f, 0.f, 0.f}, a1 = a0;
#pragma unroll
                    for (int s = 0; s < 4; ++s) { a0 = __builtin_amdgcn_mfma_f32_16x16x32_bf16(Sb[s], q0[s], a0, 0, 0, 0); a1 = __builtin_amdgcn_mfma_f32_16x16x32_bf16(Sb[s], q1[s], a1, 0, 0, 0); }
                    a0 *= tqd[i0]; a1 *= tqd[i1];
#pragma unroll
                    for (int s = 0; s < 4; ++s) {
                        if (dir ? (2 * s + 1 >= 2 * ip) : (2 * s <= 2 * ip)) { const bf16x8 pb = *(const LAS bf16x8*)(Ps + i0 * RS + (32 * s + 8 * fq) * 2); a0 = __builtin_amdgcn_mfma_f32_16x16x32_bf16(vf[s], pb, a0, 0, 0, 0); }
                        if (dir ? (2 * s + 1 >= 2 * ip + 1) : (2 * s <= 2 * ip + 1)) { const bf16x8 pb = *(const LAS bf16x8*)(Ps + i1 * RS + (32 * s + 8 * fq) * 2); a1 = __builtin_amdgcn_mfma_f32_16x16x32_bf16(vf[s], pb, a1, 0, 0, 0); }
                    }
                    u32x2 ow0, ow1; ow0.x = pk2(a0[0], a0[1]); ow0.y = pk2(a0[2], a0[3]); ow1.x = pk2(a1[0], a1[1]); ow1.y = pk2(a1[2], a1[3]);
                    *(u32x2*)(og + (size_t)(tok0 + i0) * 1024 + hd * 256 + dvs * 128 + 16 * w + 4 * fq) = ow0;
                    *(u32x2*)(og + (size_t)(tok0 + i1) * 1024 + hd * 256 + dvs * 128 + 16 * w + 4 * fq) = ow1;
                }
            }
#pragma unroll
            for (int t = 0; t < 8; ++t) S[t] *= cdec;
#pragma unroll
            for (int s = 0; s < 4; ++s) {
                const f32x4 k0 = *(const LAS f32x4*)(tkd + 32 * s + 8 * fq), k1 = *(const LAS f32x4*)(tkd + 32 * s + 8 * fq + 4);
                const u32x4 vv = __builtin_bit_cast(u32x4, vf[s]); u32x4 t4;
                t4.x = pk2(bflo(vv.x) * k0[0], bfhi(vv.x) * k0[1]); t4.y = pk2(bflo(vv.y) * k0[2], bfhi(vv.y) * k0[3]);
                t4.z = pk2(bflo(vv.z) * k1[0], bfhi(vv.z) * k1[1]); t4.w = pk2(bflo(vv.w) * k1[2], bfhi(vv.w) * k1[3]);
                const bf16x8 vsc = __builtin_bit_cast(bf16x8, t4);
#pragma unroll
                for (int t = 0; t < 8; ++t) {
                    LAS unsigned char* a0 = Ks + (32 * s + 8 * fq + trq) * RS + (32 * (t >> 1) + 8 * trp + 4 * (t & 1)) * 2;
                    const bf16x8 kt = cat8(__builtin_amdgcn_ds_read_tr16_b64_v4i16((LAS v4i16_t*)a0), __builtin_amdgcn_ds_read_tr16_b64_v4i16((LAS v4i16_t*)(a0 + 4 * RS)));
                    S[t] = __builtin_amdgcn_mfma_f32_16x16x32_bf16(kt, vsc, S[t], 0, 0, 0);
                }
            }
        }
#undef RET_TOK0
#undef RET_LOAD
    }
    __syncthreads();
}

__global__ void __launch_bounds__(512, 2) fwd_kernel(Params p) {
    extern __shared__ __attribute__((aligned(16))) unsigned char lds_raw[];
    LAS unsigned char* lds = (LAS unsigned char*)lds_raw;
    const int tid = threadIdx.x, G = gridDim.x, lo = p.ph_lo, hi = p.ph_hi;
    volatile LAS unsigned* xst = (volatile LAS unsigned*)(lds + LDS_CTL);
    if (tid < 4) xst[tid] = 0u;
    __syncthreads();
    XcdBarrier bar; bar.bar = (unsigned*)(p.ws + WS_CTL) + CW_BAR; bar.x = 0; bar.st = xst;
    const bool multi = (hi - lo) > 1;
    if (multi) bar = xcd_barrier_post((unsigned*)(p.ws + WS_CTL) + CW_BAR, xst);
#ifndef PHM
#define PHM 0xFFFFFFFFu
#endif
#define PM(q) ((PHM >> (q)) & 1u)
#define IN(k) (lo <= (k) && (k) < hi)
#ifndef TSEL
#define TSEL 0u
#endif
#ifndef TMULT
#define TMULT 10
#endif
    volatile LAS unsigned long long* tacc = (volatile LAS unsigned long long*)(lds + LDS_CTL + 32);
    if (TSEL && tid == 0) { tacc[0] = 0ull; tacc[1] = wall_clock64(); }
#define SEAMK(k, kind) do { if ((k) + 1 < hi) xcd_barrier(bar); if (TSEL && blockIdx.x == 0 && tid == 0) { const unsigned long long _n = wall_clock64(); if ((TSEL >> (kind)) & 1u) tacc[0] += _n - tacc[1]; tacc[1] = _n; } } while (0)
    unsigned char* big = p.ws + WS_BIG;
    const char* wmix = (const char*)(p.ws + WS_WMIX);

    if (PM(13) && IN(PH_PRO_A)) { adaln_phase(p, lds); rope_phase(p); __syncthreads(); convert_mixer_weights(p, lds, 0); SEAMK(PH_PRO_A, 13); }
    if (PM(14) && IN(PH_PRO_B)) { modulate0_phase(p); SEAMK(PH_PRO_B, 14); }

    for (int l = 0; l < DEPTH; ++l) {
        const int pb = PH_L0 + l * PH_PER_L;
        if (hi <= pb || lo >= pb + PH_PER_L) continue;
        const bool need_ctx = l < DEPTH - 1;
        const int Tact = need_ctx ? T : NLAT, nMact = Tact / 256;
        const float* modl = (const float*)(p.ws + WS_MOD) + (size_t)l * 17 * 6144;

        if (PM(0) && IN(pb + Q_IN)) {
            EpiIn E{(bf16_t*)big, (const float*)(p.ws + WS_ROPE)};
            if (need_ctx) { SchedRect S{(const char*)regA(p), wmix + WMIX_IN, T / 256, 14, G, (int)blockIdx.x, (size_t)256 * 1024 * 2}; gemm_phase(lds, 1024, S, E); }
            else { SchedIn3 S{(const char*)regA(p), wmix + WMIX_IN, G, (int)blockIdx.x, (size_t)256 * 1024 * 2}; gemm_phase(lds, 1024, S, E); }
            __syncthreads();
            {
              SchedRect S8{(const char*)regA8(p), wmix + WMIX_IN8, nMact, 8, G, (int)blockIdx.x, (size_t)256 * 1024};
              EpiSig8 E8{(bf16_t*)big}; gemm_phase(lds, 1024 / 2, S8, E8); }
            SEAMK(pb + Q_IN, 0);
        }
        if (PM(2) && IN(pb + Q_RET)) { pool_phase<false>(p, Tact); retention_phase(p, lds, l, need_ctx); SEAMK(pb + Q_RET, 2); }
        if (PM(3) && IN(pb + Q_COMB)) { combine_phase(p, Tact); pool_phase<true>(p, Tact); SEAMK(pb + Q_COMB, 3); }
        if (PM(4) && IN(pb + Q_MIX)) {
            { SchedRect S{(const char*)(big + B_U), wmix + WMIX_POOL, nMact, 4, G, (int)blockIdx.x, (size_t)256 * 512 * 2};
              EpiGate<0> E{(bf16_t*)(big + B_Y1), (const bf16_t*)(big + B_GP), nullptr}; gemm_phase(lds, 512, S, E); }
            __syncthreads();
            { SchedRect S{(const char*)(big + B_URET), wmix + WMIX_RET, nMact, 4, G, (int)blockIdx.x, (size_t)256 * 1024 * 2};
              EpiGate<1> E{(bf16_t*)(big + B_MIX), (const bf16_t*)(big + B_GR), (const bf16_t*)(big + B_Y1)}; gemm_phase(lds, 1024, S, E); }
            SEAMK(pb + Q_MIX, 4);
        }
        if (PM(5) && IN(pb + Q_OUT)) {
            SchedRect S{(const char*)(big + B_MIX), wmix + WMIX_OUT, nMact, 4, G, (int)blockIdx.x, (size_t)256 * 1024 * 2};
            const bool renorm = (l & 1) != 0;
            const float* lg = p.in[I_LNFG] + (size_t)(l > 0 ? l - 1 : 0) * 1024; const float* lb = p.in[I_LNFB] + (size_t)(l > 0 ? l - 1 : 0) * 1024;
            if (l == 0) { EpiRes<true, false> E{p.in[I_X], p.in[I_CTX], (bf16_t*)(p.ws + WS_A), modl, 2, nullptr, lg, lb}; gemm_phase(lds, 1024, S, E); }
            else if (renorm) { EpiRes<false, true> E{nullptr, nullptr, (bf16_t*)(p.ws + WS_A), modl, 2, (const float*)(p.ws + WS_ST2), lg, lb}; gemm_phase(lds, 1024, S, E); }
            else { EpiRes<false, false> E{nullptr, nullptr, (bf16_t*)(p.ws + WS_A), modl, 2, nullptr, lg, lb}; gemm_phase(lds, 1024, S, E); }
            SEAMK(pb + Q_OUT, 5);
        }
        if (PM(6) && IN(pb + Q_LN1)) {
            ln1_phase(p, lds, l, Tact);
            convert_ffn_weights(p, lds, l);
            if (l + 1 < DEPTH) convert_mixer_weights(p, lds, l + 1);
            SEAMK(pb + Q_LN1, 6);
        }
        if ((l & 1) == 0) {
            if (PM(7) && IN(pb + Q_F0)) {
                SchedRect S{(const char*)regA(p), (const char*)(big + F_W), nMact, 2 * DFF / 256, G, (int)blockIdx.x, (size_t)256 * 1024};
                EpiSwiglu8 E{big + F_ACT, DFF, 0}; gemm_phase(lds, 1024 / 2, S, E);
                SEAMK(pb + Q_F0, 7);
            }
            if (PM(8) && IN(pb + Q_F1)) {
                SchedRect S{(const char*)(big + F_ACT), (const char*)(big + F_DW2), nMact, 4, G, (int)blockIdx.x, (size_t)256 * DFF};
                EpiRes<false, true, true> E{nullptr, nullptr, (bf16_t*)(p.ws + WS_A), modl, 5, (const float*)(p.ws + WS_ST1), p.in[I_LNMG] + (size_t)l * 1024, p.in[I_LNMB] + (size_t)l * 1024};
                gemm_phase(lds, DFF / 2, S, E);
                SEAMK(pb + Q_F1, 8);
            }
        } else {
            if (PM(9) && IN(pb + Q_F0)) { moe_scatter_phase(p, lds, Tact); SEAMK(pb + Q_F0, 9); }
            const int* blke = (const int*)(p.ws + WS_BLKE);
            for (int g = 0; g < NGRP; ++g) {
                if (PM(10) && IN(pb + Q_F1 + 2 * g)) {
                    const int nb = min(blke[0], MAXRB), rb0 = g * RBG, nrb = min(RBG, nb - rb0);
                    if (nrb > 0) {
                        int w0, w1, w2; moe_bounds(blke, w0, w1, w2);
                        SchedMoe S{(const char*)(big + F_XS), (const char*)(big + F_W), w0, w1, w2, rb0, 0, nrb, 2 * EFF / 256, G, (int)blockIdx.x, (size_t)256 * 1024, F_EW13};
                        EpiSwiglu8 E{big + F_ACTM, EFF, rb0}; gemm_phase(lds, 1024 / 2, S, E);
                    }
                    SEAMK(pb + Q_F1 + 2 * g, 10);
                }
                if (PM(11) && IN(pb + Q_F1 + 2 * g + 1)) {
                    const int nb = min(blke[0], MAXRB), rb0 = g * RBG, nrb = min(RBG, nb - rb0);
                    if (nrb > 0) {
                        int w0, w1, w2; moe_bounds(blke, w0, w1, w2);
                        SchedMoe S{(const char*)(big + F_ACTM), (const char*)(big + F_W + (size_t)NEXP * F_EW13), w0, w1, w2, rb0, rb0, nrb, 4, G, (int)blockIdx.x, (size_t)256 * EFF, F_EW2};
                        EpiPlain8 E{(bf16_t*)(big + F_YK), 1.0f / W2_SCALE}; gemm_phase(lds, EFF / 2, S, E);
                    }
                    SEAMK(pb + Q_F1 + 2 * g + 1, 11);
                }
            }
        }
        if (PM(12) && IN(pb + Q_LN2)) { ln2_phase(p, lds, l, Tact); SEAMK(pb + Q_LN2, 12); }
    }
#undef IN
#undef SEAMK
    if (TSEL && blockIdx.x == 0 && tid == 0) { const unsigned long long t0 = wall_clock64(), w = tacc[0] * (unsigned long long)TMULT; while (wall_clock64() - t0 < w) __builtin_amdgcn_s_sleep(32); }
}

static bool phase_active(int ph) {
    if (ph < PH_L0) return true;
    const int l = (ph - PH_L0) / PH_PER_L, q = (ph - PH_L0) % PH_PER_L;
    if (q == Q_POOLV) return false;
    if (q <= Q_F0 || q == Q_LN2) return true;
    if (q >= Q_F1 && q < Q_LN2) { if ((l & 1) == 0) return q == Q_F1; return q < Q_F1 + 2 * NGRP; }
    return false;
}

extern "C" void kernel_launch(void* const* d_in, const int* in_sizes, int n_in, void* d_out, int out_size, void* d_ws, size_t ws_size, hipStream_t stream) {
    static int grid = 0;
    if (grid == 0) {
        if (n_in != 24 || out_size != NLAT * 1024 || ws_size < WS_END) { fprintf(stderr, "kernel_launch: unexpected shapes (n_in %d out %d ws %zu need %zu)\n", n_in, out_size, ws_size, (size_t)WS_END); grid = -1; return; }
        int dev = 0, cus = 0, per_cu = 0;
        if (hipGetDevice(&dev) != hipSuccess || hipDeviceGetAttribute(&cus, hipDeviceAttributeMultiprocessorCount, dev) != hipSuccess) { grid = -1; return; }
        if (hipFuncSetAttribute((const void*)fwd_kernel, hipFuncAttributeMaxDynamicSharedMemorySize, LDS_BYTES) != hipSuccess) { fprintf(stderr, "kernel_launch: hipFuncSetAttribute failed\n"); grid = -1; return; }
        if (hipOccupancyMaxActiveBlocksPerMultiprocessor(&per_cu, (const void*)fwd_kernel, 512, LDS_BYTES) != hipSuccess || per_cu < 1) { fprintf(stderr, "kernel_launch: occupancy query says %d\n", per_cu); (void)hipGetLastError(); per_cu = 1; }
        grid = cus < 256 ? cus : 256;
    }
    if (grid < 0) return;
    (void)hipMemsetAsync((char*)d_ws + WS_CTL, 0, CTL_BYTES, stream);
    Params p{};
    for (int i = 0; i < 24; ++i) p.in[i] = (const float*)d_in[i];
    p.out = (float*)d_out; p.ws = (unsigned char*)d_ws;
#if MK_MULTI
#ifndef MAXPH
#define MAXPH NPH
#endif
    for (int ph = 0; ph < MAXPH; ++ph) {
        if (!phase_active(ph)) continue;
        p.ph_lo = ph; p.ph_hi = ph + 1;
        hipLaunchKernelGGL(fwd_kernel, dim3(grid), dim3(512), LDS_BYTES, stream, p);
    }
#else
    p.ph_lo = 0; p.ph_hi = NPH;
    hipLaunchKernelGGL(fwd_kernel, dim3(grid), dim3(512), LDS_BYTES, stream, p);
#endif
}
```

```cpp
#include <hip/hip_runtime.h>
#include <stdint.h>
#include <cstdio>

#define MAXPH NPH
#ifndef MK_MULTI
#define MK_MULTI 0
#endif

#define DEVINL __device__ __forceinline__
#define LAS __attribute__((address_space(3)))
typedef unsigned short bf16_t;
typedef short bf16x8 __attribute__((ext_vector_type(8)));
typedef short v4i16_t __attribute__((ext_vector_type(4)));
typedef float f32x4 __attribute__((ext_vector_type(4)));
typedef unsigned u32x4 __attribute__((ext_vector_type(4)));
typedef unsigned u32x2 __attribute__((ext_vector_type(2)));

constexpr int D = 1024, BATCH = 16, SEQ = 4096, DEPTH = 4, CTXL = 256, GRIDW = 64;
constexpr int NLAT = BATCH * SEQ, NCTX = BATCH * CTXL, T = NLAT + NCTX;
constexpr int INW = 5632, DFF = 2816, NEXP = 8, EFF = 3584;
constexpr int MAXRB = 552;
constexpr int RBG = 552;
constexpr int NGRP = 1;
constexpr float ALPHA = 1.6817928305074290f;
constexpr float LN_EPS = 1e-5f;
constexpr float KSCALE = 0.08838834764831845f;

constexpr size_t AL(size_t x) { return (x + 255) & ~(size_t)255; }
constexpr size_t U = (size_t)T * 1024 * 2;
constexpr size_t WS_CTL = 0;
constexpr size_t CTL_BYTES = 65536;
constexpr size_t WS_MOD = WS_CTL + CTL_BYTES;
constexpr size_t WS_ROPE = AL(WS_MOD + (size_t)4 * 17 * 6144 * 4);
constexpr size_t WS_CTXS = AL(WS_ROPE + (size_t)4096 * 64 * 8);
constexpr size_t WS_TOKE = AL(WS_CTXS + (size_t)NCTX * 1024 * 4);
constexpr size_t WS_TOKW = AL(WS_TOKE + (size_t)T * 8);
constexpr size_t WS_TOKD = AL(WS_TOKW + (size_t)T * 8);
constexpr size_t WS_WGCNT = AL(WS_TOKD + (size_t)T * 8);
constexpr size_t WS_BLKE = AL(WS_WGCNT + 256 * 8 * 4);
constexpr size_t WS_ST1 = AL(WS_BLKE + (MAXRB + 8) * 4);
constexpr size_t WS_ST2 = AL(WS_ST1 + (size_t)T * 8);
constexpr size_t WS_WMIX = AL(WS_ST2 + (size_t)T * 8);
constexpr size_t WMIX_IN = 0, WMIX_POOL = (size_t)INW * 1024 * 2, WMIX_RET = WMIX_POOL + (size_t)1024 * 512 * 2, WMIX_OUT = WMIX_RET + (size_t)1024 * 1024 * 2, WMIX_IN8 = WMIX_OUT + (size_t)1024 * 1024 * 2, WMIX_BYTES = WMIX_IN8 + (size_t)2048 * 1024;
constexpr size_t WS_A = AL(WS_WMIX + WMIX_BYTES);
constexpr size_t WS_BIG = AL(WS_A + U);
constexpr size_t B_U = 0, B_Q = U / 2, B_K = U, B_V = U + U / 2, B_SG = 2 * U + U / 2, B_GP = 3 * U + U / 2, B_GR = 4 * U + U / 2, B_OF = 5 * U + U / 2, B_OB = 6 * U + U / 2, B_END = 7 * U + U / 2;
constexpr size_t B_URET = B_V, B_Y1 = B_Q, B_MIX = B_OF;
constexpr size_t F_W = 0;
constexpr size_t F_DW2 = (size_t)2 * DFF * 1024 * 2;
constexpr float W13_SCALE = 64.0f, W2_SCALE = 256.0f;
constexpr size_t F_EW13 = (size_t)2 * EFF * 1024, F_EW2 = (size_t)1024 * EFF, F_EALL = (size_t)NEXP * (F_EW13 + F_EW2);
constexpr size_t F_XS = AL(F_EALL);
constexpr size_t F_YK = AL(F_XS + (size_t)MAXRB * 256 * 1024);
constexpr size_t F_ACTM = AL(F_YK + (size_t)MAXRB * 256 * 1024 * 2);
constexpr size_t F_ACT = AL(F_DW2 + (size_t)1024 * DFF * 2);
constexpr size_t F_END_D = F_ACT + (size_t)T * DFF * 2, F_END_M = F_ACTM + (size_t)RBG * 256 * EFF;
constexpr size_t WS_END = WS_BIG + B_END;
static_assert(F_END_D <= B_END && F_END_M <= B_END, "FFN stage must fit in BIG");
static_assert(WS_END <= (size_t)1295298688, "workspace budget");

constexpr int CW_BAR = 0;
constexpr int CW_DBG = 4096;

constexpr int LDS_MAIN = 139264;
constexpr int LDS_TAB = LDS_MAIN;
constexpr int LDS_CTL = LDS_MAIN + 1024;
constexpr int LDS_BYTES = LDS_CTL + 256;

DEVINL float bf2f(unsigned b) { return __uint_as_float(b << 16); }
DEVINL float bflo(unsigned w) { return __uint_as_float(w << 16); }
DEVINL float bfhi(unsigned w) { return __uint_as_float(w & 0xffff0000u); }
typedef __bf16 bf16v2_t __attribute__((ext_vector_type(2)));
typedef float f32v2_t __attribute__((ext_vector_type(2)));
DEVINL unsigned pk2(float lo, float hi) { const f32v2_t v = {lo, hi}; return __builtin_bit_cast(unsigned, __builtin_convertvector(v, bf16v2_t)); }
DEVINL void unpk8(const u32x4 w, float (&v)[8]) { v[0] = bflo(w.x); v[1] = bfhi(w.x); v[2] = bflo(w.y); v[3] = bfhi(w.y); v[4] = bflo(w.z); v[5] = bfhi(w.z); v[6] = bflo(w.w); v[7] = bfhi(w.w); }
DEVINL u32x4 pk8(const float (&v)[8]) { u32x4 w; w.x = pk2(v[0], v[1]); w.y = pk2(v[2], v[3]); w.z = pk2(v[4], v[5]); w.w = pk2(v[6], v[7]); return w; }
typedef _Float16 f16v2_t __attribute__((ext_vector_type(2)));
DEVINL unsigned pk2h(float lo, float hi) { return __builtin_bit_cast(unsigned, __builtin_amdgcn_cvt_pkrtz(lo, hi)); }
DEVINL float h2f_bits(unsigned h) { const unsigned m = h & 0x7fffu; const unsigned f = ((h & 0x8000u) << 16) | ((m << 13) + 0x38000000u); return (m < 0x400u) ? 0.f : __uint_as_float(f); }
DEVINL float h2f_cvt(unsigned h) { float f; asm("v_cvt_f32_f16_e32 %0, %1" : "=v"(f) : "v"(h)); return f; }
DEVINL void unpk8h(const u32x4 w, float (&v)[8]) {
    v[0] = h2f_cvt(w.x); v[1] = h2f_cvt(w.x >> 16); v[2] = h2f_cvt(w.y); v[3] = h2f_cvt(w.y >> 16);
    v[4] = h2f_cvt(w.z); v[5] = h2f_cvt(w.z >> 16); v[6] = h2f_cvt(w.w); v[7] = h2f_cvt(w.w >> 16); }
DEVINL u32x4 pk8h(const float (&v)[8]) { u32x4 w; w.x = pk2h(v[0], v[1]); w.y = pk2h(v[2], v[3]); w.z = pk2h(v[4], v[5]); w.w = pk2h(v[6], v[7]); return w; }
DEVINL void ld8f(const float* p, float (&v)[8]) { const f32x4 a = *(const f32x4*)p, b = *(const f32x4*)(p + 4); v[0] = a[0]; v[1] = a[1]; v[2] = a[2]; v[3] = a[3]; v[4] = b[0]; v[5] = b[1]; v[6] = b[2]; v[7] = b[3]; }
DEVINL unsigned pk4_fp8(float a, float b, float c, float d) { int w = 0; w = __builtin_amdgcn_cvt_pk_fp8_f32(a, b, w, false); w = __builtin_amdgcn_cvt_pk_fp8_f32(c, d, w, true); return (unsigned)w; }
DEVINL bf16_t f2bf(float f) { return (bf16_t)(pk2(f, 0.f) & 0xffffu); }
DEVINL float sigmoidf_(float x) { return __builtin_amdgcn_rcpf(1.0f + __builtin_amdgcn_exp2f(-1.4426950408889634f * x)); }
DEVINL float siluf_(float x) { return x * __builtin_amdgcn_rcpf(1.0f + __builtin_amdgcn_exp2f(-1.4426950408889634f * x)); }
DEVINL f32x4 exp2_4(const f32x4 x) { f32x4 r; r[0] = __builtin_amdgcn_exp2f(x[0]); r[1] = __builtin_amdgcn_exp2f(x[1]); r[2] = __builtin_amdgcn_exp2f(x[2]); r[3] = __builtin_amdgcn_exp2f(x[3]); return r; }
DEVINL f32x4 rcp_4(const f32x4 x) { f32x4 r; r[0] = __builtin_amdgcn_rcpf(x[0]); r[1] = __builtin_amdgcn_rcpf(x[1]); r[2] = __builtin_amdgcn_rcpf(x[2]); r[3] = __builtin_amdgcn_rcpf(x[3]); return r; }
DEVINL void sigmoid8(f32x4& a0, f32x4& a1, const float nl2) {
    const f32x4 e0 = exp2_4(a0 * nl2), e1 = exp2_4(a1 * nl2);
    a0 = rcp_4(e0 + 1.0f); a1 = rcp_4(e1 + 1.0f);
}
DEVINL void swiglu8(f32x4& v0, f32x4& v1, const f32x4 a0, const f32x4 a1, const f32x4 b0, const f32x4 b1, const float nl2, const float s2) {
    const f32x4 e0 = exp2_4(a0 * nl2), e1 = exp2_4(a1 * nl2);
    const f32x4 p0 = a0 * b0, p1 = a1 * b1;
    const f32x4 r0 = rcp_4(e0 + 1.0f), r1 = rcp_4(e1 + 1.0f);
    v0 = p0 * (r0 * s2); v1 = p1 * (r1 * s2);
}
DEVINL int tid_hidden() { int t = threadIdx.x; asm volatile("" : "+v"(t)); return t; }
#define DPP_ADD(v, ctrl, rmask) v += __builtin_bit_cast(float, __builtin_amdgcn_update_dpp(0, __builtin_bit_cast(int, v), ctrl, rmask, 0xf, false))
DEVINL float wave_sum(float v) {
    DPP_ADD(v, 0xB1, 0xf);
    DPP_ADD(v, 0x4E, 0xf);
    DPP_ADD(v, 0x141, 0xf);
    DPP_ADD(v, 0x140, 0xf);
    DPP_ADD(v, 0x142, 0xa);
    DPP_ADD(v, 0x143, 0xc);
    return __builtin_bit_cast(float, __builtin_amdgcn_readlane(__builtin_bit_cast(int, v), 63));
}

#define XB_TMO      128
#define XB_XCNT(j)  (256  + 64 * (j))
#define XB_XSUB(j)  (1280 + 64 * (j))
#define XB_XGEN(j)  (2304 + 64 * (j))
#define XB_TOP      3328
#define XB_TOPGEN   3392
#define XCD_BAR_WORDS 3456
#define XB_SPIN_CAP (1u << 20)
DEVINL unsigned xb_ld(unsigned* p)              { return __hip_atomic_load(p, __ATOMIC_RELAXED, __HIP_MEMORY_SCOPE_AGENT); }
DEVINL unsigned xb_add(unsigned* p, unsigned v) { return __hip_atomic_fetch_add(p, v, __ATOMIC_RELAXED, __HIP_MEMORY_SCOPE_AGENT); }
DEVINL unsigned xb_xcc_id() { return (unsigned)__builtin_amdgcn_s_getreg((3 << 11) | 20) & 0xFu; }
#define XB_SPIN(cond, bar) do { unsigned _sp = 0; while (cond) { __builtin_amdgcn_s_sleep(1); \
    if ((++_sp & 255u) == 0u) { if (xb_ld(&(bar)[XB_TMO])) break; if (_sp > XB_SPIN_CAP) { atomicAdd(&(bar)[XB_TMO], 1u); break; } } } } while (0)
struct XcdBarrier { unsigned* bar; unsigned x; volatile LAS unsigned* st; };
DEVINL XcdBarrier xcd_barrier_post(unsigned* bar, volatile LAS unsigned* st) {
    XcdBarrier b; b.bar = bar; b.x = xb_xcc_id(); b.st = st;
    if (threadIdx.x == 0) (void)xb_add(&bar[XB_XCNT(b.x)], 1u);
    return b;
}
DEVINL void xcd_barrier_complete(unsigned* bar, unsigned x, unsigned& nloc, unsigned& nx) {
    const unsigned G = gridDim.x * gridDim.y * gridDim.z;
    unsigned sum, cnt, mine, sp = 0u;
    for (;;) {
        sum = 0u; cnt = 0u; mine = 0u;
#pragma unroll
        for (unsigned j = 0; j < 16; ++j) { const unsigned c = xb_ld(&bar[XB_XCNT(j)]); sum += c; cnt += (c > 0u) ? 1u : 0u; mine = (j == x) ? c : mine; }
        if (sum == G) break;
        __builtin_amdgcn_s_sleep(1);
        if ((++sp & 255u) == 0u) { if (xb_ld(&bar[XB_TMO])) break; if (sp > XB_SPIN_CAP) { atomicAdd(&bar[XB_TMO], 1u); break; } }
    }
    nloc = mine > 0u ? mine : 1u; nx = cnt > 0u ? cnt : 1u;
}
DEVINL void xcd_barrier(const XcdBarrier& b) {
    asm volatile("s_waitcnt vmcnt(0)" ::: "memory");
    __syncthreads();
    if (threadIdx.x == 0) {
        unsigned* bar = b.bar;
        __builtin_amdgcn_s_waitcnt(0);
        unsigned nloc = b.st[0], nx = b.st[1];
        if (nloc == 0u) { xcd_barrier_complete(bar, b.x, nloc, nx); b.st[0] = nloc; b.st[1] = nx; }
        const unsigned old = xb_add(&bar[XB_XSUB(b.x)], 1u);
        const unsigned gen = old / nloc;
        if (old + 1u == (gen + 1u) * nloc) {
            __builtin_amdgcn_fence(__ATOMIC_RELEASE, "agent");
            asm volatile("s_waitcnt vmcnt(0)" ::: "memory");
            const unsigned og = xb_add(&bar[XB_TOP], 1u);
            const unsigned tg = og / nx;
            if (og + 1u == (tg + 1u) * nx) xb_add(&bar[XB_TOPGEN], 1u);
            else XB_SPIN(xb_ld(&bar[XB_TOPGEN]) == tg, bar);
            __builtin_amdgcn_fence(__ATOMIC_ACQUIRE, "agent");
            xb_add(&bar[XB_XGEN(b.x)], 1u);
            asm volatile("s_waitcnt vmcnt(0)" ::: "memory");
        } else {
            XB_SPIN(xb_ld(&bar[XB_XGEN(b.x)]) == gen, bar);
            __builtin_amdgcn_fence(__ATOMIC_ACQUIRE, "agent");
            asm volatile("s_waitcnt vmcnt(0)" ::: "memory");
        }
    }
    __syncthreads();
}

constexpr int BM = 256, BK = 64, HALF = 128, HTB = HALF * BK * 2, NXCD = 8, WGM = 8;
DEVINL int lds_byte(int r, int c) { const int st = (r >> 4) * 2 + (c >> 5), rr = r & 15, cc = c & 31, ob = rr * 64 + cc * 2; return st * 1024 + (ob ^ (((ob >> 9) & 1) << 5)); }
DEVINL void stage_rc(int b, int& R, int& C) { const int st = b / 1024, sb = b % 1024, swz = sb ^ (((sb >> 9) & 1) << 5); R = (st >> 1) * 16 + swz / 64; C = (st & 1) * 32 + (swz % 64) / 2; }
DEVINL int perm32(int rho) { const int n = rho >> 4, i = rho & 15; return 8 * (i >> 2) + 4 * n + (i & 3); }

struct Unit { int pm, pn; const char* a; const char* b; };

DEVINL bool rect_next(long L, int nM, int nN, int& pm, int& pn) {
    const int nwg = nM * nN; if (L >= nwg) return false;
    int wgid = (int)L; { const int q = nwg / NXCD, r = nwg % NXCD, xcd = wgid % NXCD, off = wgid / NXCD; wgid = (xcd < r ? xcd * (q + 1) : r * (q + 1) + (xcd - r) * q) + off; }
    const int nig = WGM * nN, gid = wgid / nig, fm = gid * WGM, gsz = (nM - fm) < WGM ? (nM - fm) : WGM;
    pm = fm + ((wgid % nig) % gsz); pn = (wgid % nig) / gsz; return true;
}
struct SchedRect {
    const char* A; const char* B; int nM, nN, G, c; size_t tstep;
    DEVINL bool next(int i, Unit& u) const { if (!rect_next((long)i * G + c, nM, nN, u.pm, u.pn)) return false; u.a = A + (size_t)u.pm * tstep; u.b = B + (size_t)u.pn * tstep; return true; }
};
struct SchedIn3 {
    const char* A; const char* B; int G, c; size_t tstep;
    DEVINL bool next(int i, Unit& u) const {
        const long L = (long)i * G + c;
        if (L < 256 * 14) { rect_next(L, 256, 14, u.pm, u.pn); }
        else { const long L2 = L - 256 * 14; if (L2 >= 16 * 6) return false; u.pm = 256 + (int)(L2 / 6); u.pn = 4 + (int)(L2 % 6); }
        u.a = A + (size_t)u.pm * tstep; u.b = B + (size_t)u.pn * tstep; return true; }
};
struct SchedMoe {
    const char* abase; const char* wbase; int eb0, eb1, eb2; int rb0, arb0, nrb, nN, G, c; size_t tstep, estride;
    DEVINL bool next(int i, Unit& u) const {
        int pm, pn; if (!rect_next((long)i * G + c, nrb, nN, pm, pn)) return false;
        u.pm = rb0 + pm; u.pn = pn;
        const int r = u.pm;
        const int e = (r >= (eb0 & 1023)) + (r >= ((eb0 >> 10) & 1023)) + (r >= ((eb0 >> 20) & 1023)) + (r >= (eb1 & 1023)) + (r >= ((eb1 >> 10) & 1023)) + (r >= ((eb1 >> 20) & 1023)) + (r >= (eb2 & 1023));
        u.a = abase + (size_t)(u.pm - arb0) * tstep; u.b = wbase + (size_t)e * estride + (size_t)pn * tstep; return true; }
};

DEVINL void moe_bounds(const int* blke, int& w0, int& w1, int& w2) {
    int b[7];
#pragma unroll
    for (int e = 0; e < 7; ++e) { int v = __builtin_amdgcn_readfirstlane(blke[1 + e]); v = v < 0 ? 0 : (v > 1023 ? 1023 : v); b[e] = v; }
    w0 = b[0] | (b[1] << 10) | (b[2] << 20); w1 = b[3] | (b[4] << 10) | (b[5] << 20); w2 = b[6];
}
typedef int v4i_t __attribute__((ext_vector_type(4)));
typedef int v8i_t __attribute__((ext_vector_type(8)));
DEVINL v8i_t cat_v8(bf16x8 lo, bf16x8 hi) { return __builtin_shufflevector(__builtin_bit_cast(v4i_t, lo), __builtin_bit_cast(v4i_t, hi), 0, 1, 2, 3, 4, 5, 6, 7); }
template <class Epi, class Sched>
DEVINL void gemm_phase(LAS unsigned char* lds, const int K, const Sched& S, const Epi& E) {
    int tid = threadIdx.x; asm volatile("" : "+v"(tid));
    const int wid = __builtin_amdgcn_readfirstlane(tid >> 6), lane = tid & 63, wr = wid >> 2, wc = wid & 3, fr = lane & 15, fq = lane >> 4;
    const int nt = K / BK;
    unsigned voffA, voffB;
    { int R, C; stage_rc(tid * 16, R, C); const int Rb = Epi::PERM ? ((R & ~31) + perm32(R & 31)) : R;
      voffA = (unsigned)(R * K + C) * 2u; voffB = (unsigned)(Rb * K + C) * 2u; }
    const size_t kstep = (size_t)(BK * 2);
    const size_t hstep = (size_t)HALF * K * 2;
    const size_t qstep = (size_t)64 * K * 2;
    const unsigned ldsw = (unsigned)wid * 1024u;
    const int aoff = lds_byte(wr * 64 + fr, fq * 8), boff = lds_byte(wc * 32 + fr, fq * 8);
#define PG8_SA(b, h) (((b) * 2 + (h)) * HTB)
#define PG8_SB(b, h) ((4 + (b) * 2 + (h)) * HTB)
#define PG8_STAGE(bufoff, gbase, voff) do { _Pragma("unroll") for (int _i = 0; _i < 2; ++_i) \
        __builtin_amdgcn_global_load_lds((const unsigned*)((const char*)(gbase) + _i * qstep + (voff)), (LAS unsigned*)(lds + (bufoff) + ldsw + _i * 8192), 16, 0, 0); } while (0)
#define PG8_LDA(dst, b, h) do { if constexpr (Epi::FP8) { _Pragma("unroll") for (int m = 0; m < 4; ++m) dst##8[m] = cat_v8(*(const LAS bf16x8*)(lds + PG8_SA(b, h) + aoff + m * 2048), *(const LAS bf16x8*)(lds + PG8_SA(b, h) + aoff + m * 2048 + 1024)); } \
        else { _Pragma("unroll") for (int m = 0; m < 4; ++m) _Pragma("unroll") for (int k = 0; k < 2; ++k) dst[m][k] = *(const LAS bf16x8*)(lds + PG8_SA(b, h) + aoff + m * 2048 + k * 1024); } } while (0)
#define PG8_LDB(dst, b, h) do { if constexpr (Epi::FP8) { _Pragma("unroll") for (int n = 0; n < 2; ++n) dst##8[n] = cat_v8(*(const LAS bf16x8*)(lds + PG8_SB(b, h) + boff + n * 2048), *(const LAS bf16x8*)(lds + PG8_SB(b, h) + boff + n * 2048 + 1024)); } \
        else { _Pragma("unroll") for (int n = 0; n < 2; ++n) _Pragma("unroll") for (int k = 0; k < 2; ++k) dst[n][k] = *(const LAS bf16x8*)(lds + PG8_SB(b, h) + boff + n * 2048 + k * 1024); } } while (0)
#define PG8_MMA(ai, bj, At, Bt) do { __builtin_amdgcn_s_setprio(1); \
        if constexpr (Epi::FP8) { _Pragma("unroll") for (int m = 0; m < 4; ++m) _Pragma("unroll") for (int n = 0; n < 2; ++n) \
            asm volatile("v_mfma_scale_f32_16x16x128_f8f6f4 %0, %1, %2, %0, %3, %3 op_sel_hi:[0,0,0]" : "+v"(acc[ai][bj][m][n]) : "v"(Bt##8[n]), "v"(At##8[m]), "v"(sc1)); } \
        else { _Pragma("unroll") for (int m = 0; m < 4; ++m) _Pragma("unroll") for (int n = 0; n < 2; ++n) _Pragma("unroll") for (int k = 0; k < 2; ++k) \
            acc[ai][bj][m][n] = __builtin_amdgcn_mfma_f32_16x16x32_bf16(Bt[n][k], At[m][k], acc[ai][bj][m][n], 0, 0, 0); } \
        __builtin_amdgcn_s_setprio(0); } while (0)
#define PG8_MFMA_DRAIN() do { if constexpr (Epi::FP8) { asm volatile("s_nop 15\n\ts_nop 15" : "+v"(acc[0][0][0][0]), "+v"(acc[0][0][0][1]), "+v"(acc[0][0][1][0]), "+v"(acc[0][0][1][1]), "+v"(acc[0][0][2][0]), "+v"(acc[0][0][2][1]), "+v"(acc[0][0][3][0]), "+v"(acc[0][0][3][1]), "+v"(acc[0][1][0][0]), "+v"(acc[0][1][0][1]), "+v"(acc[0][1][1][0]), "+v"(acc[0][1][1][1]), "+v"(acc[0][1][2][0]), "+v"(acc[0][1][2][1]), "+v"(acc[0][1][3][0]), "+v"(acc[0][1][3][1])); asm volatile("" : "+v"(acc[1][0][0][0]), "+v"(acc[1][0][0][1]), "+v"(acc[1][0][1][0]), "+v"(acc[1][0][1][1]), "+v"(acc[1][0][2][0]), "+v"(acc[1][0][2][1]), "+v"(acc[1][0][3][0]), "+v"(acc[1][0][3][1]), "+v"(acc[1][1][0][0]), "+v"(acc[1][1][0][1]), "+v"(acc[1][1][1][0]), "+v"(acc[1][1][1][1]), "+v"(acc[1][1][2][0]), "+v"(acc[1][1][2][1]), "+v"(acc[1][1][3][0]), "+v"(acc[1][1][3][1])); } } while (0)
#define PG8_WAIT_V(n) asm volatile("s_waitcnt vmcnt(" #n ")" ::: "memory")
#define PG8_WAIT_L(n) asm volatile("s_waitcnt lgkmcnt(" #n ")" ::: "memory")
#define PG8_WAIT_VN(n) asm volatile("s_waitcnt vmcnt(%0)" :: "n"(n) : "memory")
#define PG8_BAR __builtin_amdgcn_s_barrier()
#define PG8_SCHED __builtin_amdgcn_sched_barrier(0)
    Unit cur, nxt; int ui = 0;
    if (!S.next(0, cur)) return;
    f32x4 acc[2][2][4][2];
#pragma unroll
    for (int a = 0; a < 2; ++a)
#pragma unroll
        for (int b = 0; b < 2; ++b)
#pragma unroll
            for (int m = 0; m < 4; ++m)
#pragma unroll
                for (int n = 0; n < 2; ++n) acc[a][b][m][n] = (f32x4){0.f, 0.f, 0.f, 0.f};
    int sc1 = 0x7F7F7F7F; asm volatile("" : "+v"(sc1));
    bf16x8 At[4][2], B0[2][2], B1[2][2]; v8i_t At8[4], B08[2], B18[2];
    const char* cA = cur.a; const char* cB = cur.b;
    PG8_STAGE(PG8_SB(0, 0), cB, voffB); PG8_STAGE(PG8_SA(0, 0), cA, voffA); PG8_STAGE(PG8_SB(0, 1), cB + hstep, voffB); PG8_STAGE(PG8_SA(0, 1), cA + hstep, voffA);
    PG8_STAGE(PG8_SB(1, 0), cB + kstep, voffB); PG8_STAGE(PG8_SA(1, 0), cA + kstep, voffA); PG8_STAGE(PG8_SB(1, 1), cB + hstep + kstep, voffB);
    PG8_WAIT_V(6); PG8_BAR;
    if (wr == 1) PG8_BAR;
    for (;;) {
        const bool has_next = S.next(ui + 1, nxt);
        const char* nA = has_next ? nxt.a : cA; const char* nB = has_next ? nxt.b : cB;
        int epi_flag = (ui > 0) ? 1 : 0;
        for (int t = 0; t < nt; t += 2) {
            const bool last = (t == nt - 2);
            const char* a1 = cA + (size_t)(t + 1) * kstep;
            const char* a2 = last ? nA : cA + (size_t)(t + 2) * kstep; const char* b2 = last ? nB : cB + (size_t)(t + 2) * kstep;
            const char* a3 = a2 + kstep; const char* b3 = b2 + kstep;
            int after_epi = 0;
            if constexpr (Epi::FP8) { after_epi = __builtin_amdgcn_readfirstlane(epi_flag); asm volatile("" : "+s"(after_epi)); epi_flag = 0; }
            PG8_LDB(B0, 0, 0); PG8_LDB(B1, 0, 1); PG8_LDA(At, 0, 0); PG8_STAGE(PG8_SA(1, 1), a1 + hstep, voffA);
            if (Epi::FP8 && after_epi) PG8_WAIT_VN(8 + Epi::NST); else PG8_WAIT_V(8);
            PG8_WAIT_L(0); PG8_BAR; PG8_MMA(0, 0, At, B0); PG8_MMA(0, 1, At, B1); PG8_BAR; PG8_SCHED;
            PG8_LDA(At, 0, 1); PG8_STAGE(PG8_SB(0, 0), b2, voffB); PG8_STAGE(PG8_SB(0, 1), b2 + hstep, voffB); PG8_STAGE(PG8_SA(0, 0), a2, voffA);
            if (Epi::FP8 && after_epi) PG8_WAIT_VN(8 + Epi::NST); else PG8_WAIT_V(8);
            PG8_WAIT_L(0); PG8_BAR; PG8_MMA(1, 0, At, B0); PG8_MMA(1, 1, At, B1); PG8_BAR; PG8_SCHED;
            PG8_LDB(B0, 1, 0); PG8_LDB(B1, 1, 1); PG8_LDA(At, 1, 0); PG8_STAGE(PG8_SA(0, 1), a2 + hstep, voffA);
            PG8_WAIT_V(8); PG8_WAIT_L(0); PG8_BAR; PG8_MMA(0, 0, At, B0); PG8_MMA(0, 1, At, B1); PG8_BAR; PG8_SCHED;
            PG8_LDA(At, 1, 1); PG8_STAGE(PG8_SB(1, 0), b3, voffB); PG8_STAGE(PG8_SB(1, 1), b3 + hstep, voffB); PG8_STAGE(PG8_SA(1, 0), a3, voffA);
            PG8_WAIT_V(8); PG8_WAIT_L(0); PG8_BAR; PG8_MMA(1, 0, At, B0); PG8_MMA(1, 1, At, B1); PG8_BAR; PG8_SCHED;
        }
        PG8_MFMA_DRAIN();
        {
            int tz = threadIdx.x; asm volatile("" : "+v"(tz)); const int wz = __builtin_amdgcn_readfirstlane(tz >> 6), lz = tz & 63;
            E(acc, cur, wz >> 2, wz & 3, lz & 15, lz >> 4);
        }
        if (!has_next) break;
#pragma unroll
        for (int a = 0; a < 2; ++a)
#pragma unroll
            for (int b = 0; b < 2; ++b)
#pragma unroll
                for (int m = 0; m < 4; ++m)
#pragma unroll
                    for (int n = 0; n < 2; ++n) acc[a][b][m][n] = (f32x4){0.f, 0.f, 0.f, 0.f};
        cur = nxt; cA = nA; cB = nB; ++ui;
    }
    PG8_WAIT_V(0);
    if (wr == 0) PG8_BAR;
    PG8_BAR;
#undef PG8_SA
#undef PG8_SB
#undef PG8_STAGE
#undef PG8_LDA
#undef PG8_LDB
#undef PG8_MMA
#undef PG8_MFMA_DRAIN
#undef PG8_WAIT_V
#undef PG8_WAIT_L
#undef PG8_WAIT_VN
#undef PG8_BAR
#undef PG8_SCHED
}

typedef const f32x4 (&AccRef)[2][2][4][2];

struct EpiIn {
    static constexpr bool PERM = true, FP8 = false; static constexpr int NST = 16;
    bf16_t* big; const float* rope;
    template <int KIND> DEVINL void body(AccRef acc, bf16_t* dst, int ldc, int row0, int col0, bool lat, int wc, int fq) const {
        constexpr float ks = (KIND == 2) ? KSCALE : 1.0f;
        f32x4 csa[2][4], csb[2][4];
        if (KIND == 1 || KIND == 2) {
#pragma unroll
            for (int ai = 0; ai < 2; ++ai)
#pragma unroll
                for (int m = 0; m < 4; ++m) { const float* rp = rope + ((size_t)((row0 + ai * HALF + m * 16) & 4095) * 64 + wc * 16 + 4 * fq) * 2; csa[ai][m] = *(const f32x4*)rp; csb[ai][m] = *(const f32x4*)(rp + 4); }
            const f32x4 ident = (f32x4){1.f, 0.f, 1.f, 0.f};
#pragma unroll
            for (int ai = 0; ai < 2; ++ai)
#pragma unroll
                for (int m = 0; m < 4; ++m) { csa[ai][m] = lat ? csa[ai][m] : ident; csb[ai][m] = lat ? csb[ai][m] : ident; }
        }
#pragma unroll
        for (int ai = 0; ai < 2; ++ai)
#pragma unroll
            for (int m = 0; m < 4; ++m) {
                const unsigned ro = ((unsigned)(row0 + ai * HALF + m * 16) * (unsigned)ldc + (unsigned)col0) * 2u;
#pragma unroll
                for (int bj = 0; bj < 2; ++bj) {
                    f32x4 v0 = acc[ai][bj][m][0], v1 = acc[ai][bj][m][1];
                    if (KIND == 1 || KIND == 2) {
                        const f32x4 cs0 = csa[ai][m], cs1 = csb[ai][m];
                        f32x4 r0, r1;
                        r0[0] = (v0[0] * cs0[0] - v0[1] * cs0[1]) * ks; r0[1] = (v0[0] * cs0[1] + v0[1] * cs0[0]) * ks;
                        r0[2] = (v0[2] * cs0[2] - v0[3] * cs0[3]) * ks; r0[3] = (v0[2] * cs0[3] + v0[3] * cs0[2]) * ks;
                        r1[0] = (v1[0] * cs1[0] - v1[1] * cs1[1]) * ks; r1[1] = (v1[0] * cs1[1] + v1[1] * cs1[0]) * ks;
                        r1[2] = (v1[2] * cs1[2] - v1[3] * cs1[3]) * ks; r1[3] = (v1[2] * cs1[3] + v1[3] * cs1[2]) * ks;
                        v0 = r0; v1 = r1;
                    } else if (KIND == 3) {
                        f32x4 g0 = v0, g1 = v1; sigmoid8(g0, g1, -1.4426950408889634f); v0 *= g0; v1 *= g1;
                    } else if (KIND == 4) {
                        sigmoid8(v0, v1, -1.4426950408889634f);
                    }
                    u32x4 w; w.x = pk2(v0[0], v0[1]); w.y = pk2(v0[2], v0[3]); w.z = pk2(v1[0], v1[1]); w.w = pk2(v1[2], v1[3]);
                    *(u32x4*)((char*)dst + ro + (unsigned)(bj * HALF * 2)) = w;
                }
                asm volatile("" ::: "memory");
            }
    }
    DEVINL void operator()(AccRef acc, const Unit& u, int wr, int wc, int fr, int fq) const {
        const int pn = u.pn; bf16_t* dst; int ldc, colt, kind;
        if (pn < 2)       { dst = (bf16_t*)((char*)big + B_U);  ldc = 512;  colt = pn * 256;        kind = 0; }
        else if (pn < 4)  { dst = (bf16_t*)((char*)big + B_Q);  ldc = 512;  colt = (pn - 2) * 256;  kind = 1; }
        else if (pn < 6)  { dst = (bf16_t*)((char*)big + B_K);  ldc = 512;  colt = (pn - 4) * 256;  kind = 2; }
        else if (pn < 10) { dst = (bf16_t*)((char*)big + B_V);  ldc = 1024; colt = (pn - 6) * 256;  kind = 0; }
        else if (pn < 14) { dst = (bf16_t*)((char*)big + B_SG); ldc = 1024; colt = (pn - 10) * 256; kind = 3; }
        else if (pn < 18) { dst = (bf16_t*)((char*)big + B_GP); ldc = 1024; colt = (pn - 14) * 256; kind = 4; }
        else              { dst = (bf16_t*)((char*)big + B_GR); ldc = 1024; colt = (pn - 18) * 256; kind = 4; }
        const int row0 = u.pm * BM + wr * 64 + fr, col0 = colt + wc * 32 + 8 * fq;
        const bool lat = u.pm < 256;
        if (kind == 0) body<0>(acc, dst, ldc, row0, col0, lat, wc, fq);
        else if (kind == 1) body<1>(acc, dst, ldc, row0, col0, lat, wc, fq);
        else if (kind == 2) body<2>(acc, dst, ldc, row0, col0, lat, wc, fq);
        else if (kind == 3) body<3>(acc, dst, ldc, row0, col0, lat, wc, fq);
        else body<4>(acc, dst, ldc, row0, col0, lat, wc, fq);
    }
};

template <int MODE  > struct EpiGate {
    static constexpr bool PERM = true, FP8 = false; static constexpr int NST = 16;
    bf16_t* out; const bf16_t* gate; const bf16_t* y1;
    DEVINL void operator()(AccRef acc, const Unit& u, int wr, int wc, int fr, int fq) const {
        const int row0 = u.pm * BM + wr * 64 + fr, col0 = u.pn * BM + wc * 32 + 8 * fq;
#pragma unroll
        for (int ai = 0; ai < 2; ++ai) {
            u32x4 g[4][2], y[4][2];
#pragma unroll
            for (int m = 0; m < 4; ++m)
#pragma unroll
                for (int bj = 0; bj < 2; ++bj) {
                    const size_t off = (size_t)(row0 + ai * HALF + m * 16) * 1024 + col0 + bj * HALF;
                    if (MODE != 2) g[m][bj] = *(const u32x4*)(gate + off);
                    if (MODE == 1) y[m][bj] = *(const u32x4*)(y1 + off);
                }
#pragma unroll
            for (int m = 0; m < 4; ++m)
#pragma unroll
                for (int bj = 0; bj < 2; ++bj) {
                    const size_t off = (size_t)(row0 + ai * HALF + m * 16) * 1024 + col0 + bj * HALF;
                    f32x4 v0 = acc[ai][bj][m][0], v1 = acc[ai][bj][m][1];
                    if (MODE != 2) {
                        const u32x4 gg = g[m][bj];
                        v0[0] *= bflo(gg.x); v0[1] *= bfhi(gg.x); v0[2] *= bflo(gg.y); v0[3] *= bfhi(gg.y);
                        v1[0] *= bflo(gg.z); v1[1] *= bfhi(gg.z); v1[2] *= bflo(gg.w); v1[3] *= bfhi(gg.w);
                    }
                    if (MODE == 1) {
                        const u32x4 yy = y[m][bj];
                        v0[0] += bflo(yy.x); v0[1] += bfhi(yy.x); v0[2] += bflo(yy.y); v0[3] += bfhi(yy.y);
                        v1[0] += bflo(yy.z); v1[1] += bfhi(yy.z); v1[2] += bflo(yy.w); v1[3] += bfhi(yy.w);
                    }
                    u32x4 w; w.x = pk2(v0[0], v0[1]); w.y = pk2(v0[2], v0[3]); w.z = pk2(v1[0], v1[1]); w.w = pk2(v1[2], v1[3]);
                    *(u32x4*)(out + off) = w;
                }
            asm volatile("" ::: "memory");
        }
    }
};

template <bool X0, bool ST, bool F8 = false>
struct EpiRes {
    static constexpr bool PERM = true, FP8 = F8;
     static constexpr int NST = 16;
    const float* x0_lat; const float* x0_ctx; bf16_t* strm; const float* modl; int which;
    const float* st; const float* gam; const float* bet;
    DEVINL void operator()(AccRef acc, const Unit& u, int wr, int wc, int fr, int fq) const {
        const bool lat = u.pm < 256;
        const float* mv = modl + ((size_t)(lat ? (u.pm >> 4) : 16) * 6 + which) * 1024;
        const int row0 = u.pm * BM + wr * 64 + fr, col0 = u.pn * BM + wc * 32 + 8 * fq;
        const char* x0 = nullptr; if (X0) x0 = (const char*)(lat ? x0_lat : x0_ctx - (size_t)NLAT * 1024);
        const unsigned so0 = ((unsigned)row0 * 1024u + (unsigned)col0) * 2u;
#pragma unroll
        for (int bj = 0; bj < 2; ++bj) {
            const int col = col0 + bj * HALF;
            float bv[8], gv[8], ev[8];
            ld8f(mv + col, bv); if (ST) { ld8f(gam + col, gv); ld8f(bet + col, ev); }
            f32v2_t bv2[4], G2[4], E2[4];
#pragma unroll
            for (int k = 0; k < 4; ++k) { bv2[k] = (f32v2_t){bv[2 * k], bv[2 * k + 1]}; if (F8) bv2[k] *= (1.0f / W2_SCALE);
                if (ST) { G2[k] = (f32v2_t){gv[2 * k], gv[2 * k + 1]} * ALPHA; E2[k] = (f32v2_t){ev[2 * k], ev[2 * k + 1]} * ALPHA; } }
            constexpr int NA = (X0 || F8) ? 1 : 2;
#pragma unroll
            for (int ab = 0; ab < 2; ab += NA) {
                u32x4 xr[NA][4]; f32x4 xa[NA][4], xb[NA][4]; float mean[NA][4], rstd[NA][4];
#pragma unroll
                for (int a = 0; a < NA; ++a)
#pragma unroll
                    for (int m = 0; m < 4; ++m) {
                        const unsigned rr = (unsigned)((ab + a) * HALF + m * 16);
                        const unsigned so = so0 + rr * 2048u + (unsigned)(bj * HALF * 2);
                        if (ST) { const float2 s2 = *(const float2*)((const char*)st + ((unsigned)row0 + rr) * 8u); mean[a][m] = s2.x; rstd[a][m] = s2.y; }
                        if (X0) { const char* xp = x0 + so * 2u; xa[a][m] = *(const f32x4*)xp; xb[a][m] = *(const f32x4*)(xp + 16); }
                        else xr[a][m] = *(const u32x4*)((const char*)strm + so);
                    }
#pragma unroll
                for (int a = 0; a < NA; ++a)
#pragma unroll
                    for (int m = 0; m < 4; ++m) {
                        const int ai = ab + a;
                        const unsigned so = so0 + (unsigned)(ai * HALF + m * 16) * 2048u + (unsigned)(bj * HALF * 2);
                        float xv[8];
                        if (X0) { const f32x4 p0 = xa[a][m], p1 = xb[a][m]; xv[0] = p0[0]; xv[1] = p0[1]; xv[2] = p0[2]; xv[3] = p0[3]; xv[4] = p1[0]; xv[5] = p1[1]; xv[6] = p1[2]; xv[7] = p1[3]; }
                        else unpk8h(xr[a][m], xv);
                        const f32x4 a0 = acc[ai][bj][m][0], a1 = acc[ai][bj][m][1];
                        float zv[8]; float ra = 1.0f, rb = 0.0f; if (ST) { ra = rstd[a][m]; rb = -mean[a][m] * ra; }
#pragma unroll
                        for (int k = 0; k < 4; ++k) {
                            const f32v2_t x2 = (f32v2_t){xv[2 * k], xv[2 * k + 1]};
                            const f32v2_t c2 = (k < 2) ? (f32v2_t){a0[(2 * k) & 3], a0[(2 * k + 1) & 3]} : (f32v2_t){a1[(2 * k) & 3], a1[(2 * k + 1) & 3]};
                            f32v2_t z;
                            if (ST) { const f32v2_t xn = x2 * ra + rb; z = xn * G2[k] + (bv2[k] * c2 + E2[k]); }
                            else z = x2 * ALPHA + bv2[k] * c2;
                            zv[2 * k] = z.x; zv[2 * k + 1] = z.y;
                        }
                        *(u32x4*)((char*)strm + so) = pk8h(zv);
                    }
                asm volatile("" ::: "memory");
            }
        }
    }
};

struct EpiSig8 {
    static constexpr bool PERM = true, FP8 = true; static constexpr int NST = 16;
    bf16_t* big;
    DEVINL void operator()(AccRef acc, const Unit& u, int wr, int wc, int fr, int fq) const {
        bf16_t* dst = (bf16_t*)((char*)big + (u.pn < 4 ? B_GP : B_GR));
        const int row0 = u.pm * BM + wr * 64 + fr, col0 = (u.pn & 3) * 256 + wc * 32 + 8 * fq;
        constexpr float s = 1.0f / W13_SCALE;
#pragma unroll
        for (int ai = 0; ai < 2; ++ai)
#pragma unroll
            for (int m = 0; m < 4; ++m) {
                bf16_t* rowp = dst + (size_t)(row0 + ai * HALF + m * 16) * 1024 + col0;
#pragma unroll
                for (int bj = 0; bj < 2; ++bj) { f32x4 v0 = acc[ai][bj][m][0], v1 = acc[ai][bj][m][1];
                    sigmoid8(v0, v1, -1.4426950408889634f * s);
                    u32x4 w; w.x = pk2(v0[0], v0[1]); w.y = pk2(v0[2], v0[3]); w.z = pk2(v1[0], v1[1]); w.w = pk2(v1[2], v1[3]);
                    *(u32x4*)(rowp + bj * HALF) = w; }
            }
    }
};
struct EpiSwiglu8 {
    static constexpr bool PERM = true, FP8 = true; static constexpr int NST = 8;
    unsigned char* act; int ldc; int rb0;
    DEVINL void operator()(AccRef acc, const Unit& u, int wr, int wc, int fr, int fq) const {
        const int row0 = (u.pm - rb0) * BM + wr * 64 + fr, col0 = u.pn * HALF + wc * 32 + 8 * fq;
        constexpr float s = 1.0f / W13_SCALE;
#pragma unroll
        for (int ai = 0; ai < 2; ++ai)
#pragma unroll
            for (int m = 0; m < 4; ++m) {
                f32x4 v0, v1; swiglu8(v0, v1, acc[ai][0][m][0], acc[ai][0][m][1], acc[ai][1][m][0], acc[ai][1][m][1], -1.4426950408889634f * s, s * s);
                u32x2 w; w.x = pk4_fp8(v0[0], v0[1], v0[2], v0[3]); w.y = pk4_fp8(v1[0], v1[1], v1[2], v1[3]);
                *(u32x2*)(act + (size_t)(row0 + ai * HALF + m * 16) * ldc + col0) = w;
            }
    }
};
struct EpiPlain8 {
    static constexpr bool PERM = true, FP8 = true; static constexpr int NST = 16;
    bf16_t* out; float scale;
    DEVINL void operator()(AccRef acc, const Unit& u, int wr, int wc, int fr, int fq) const {
        const int row0 = u.pm * BM + wr * 64 + fr, col0 = u.pn * BM + wc * 32 + 8 * fq;
#pragma unroll
        for (int ai = 0; ai < 2; ++ai)
#pragma unroll
            for (int m = 0; m < 4; ++m) {
                const size_t off = (size_t)(row0 + ai * HALF + m * 16) * 1024 + col0;
#pragma unroll
                for (int bj = 0; bj < 2; ++bj) { const f32x4 v0 = acc[ai][bj][m][0] * scale, v1 = acc[ai][bj][m][1] * scale;
                    u32x4 w; w.x = pk2(v0[0], v0[1]); w.y = pk2(v0[2], v0[3]); w.z = pk2(v1[0], v1[1]); w.w = pk2(v1[2], v1[3]);
                    *(u32x4*)(out + off + bj * HALF) = w; }
            }
    }
};
struct EpiSwiglu8b {
    static constexpr bool PERM = true, FP8 = true; static constexpr int NST = 8;
    bf16_t* act; int ldc;
    DEVINL void operator()(AccRef acc, const Unit& u, int wr, int wc, int fr, int fq) const {
        const int row0 = u.pm * BM + wr * 64 + fr, col0 = u.pn * HALF + wc * 32 + 8 * fq;
        constexpr float s = 1.0f / W13_SCALE;
#pragma unroll
        for (int ai = 0; ai < 2; ++ai)
#pragma unroll
            for (int m = 0; m < 4; ++m) {
                f32x4 v0, v1; swiglu8(v0, v1, acc[ai][0][m][0], acc[ai][0][m][1], acc[ai][1][m][0], acc[ai][1][m][1], -1.4426950408889634f * s, s * s);
                u32x4 w; w.x = pk2(v0[0], v0[1]); w.y = pk2(v0[2], v0[3]); w.z = pk2(v1[0], v1[1]); w.w = pk2(v1[2], v1[3]);
                *(u32x4*)(act + (size_t)(row0 + ai * HALF + m * 16) * ldc + col0) = w;
            }
    }
};

struct Params { const float* in[24]; float* out; unsigned char* ws; int ph_lo, ph_hi; };
enum { I_X = 0, I_C, I_CTX, I_CCTX, I_ADAW, I_ADAB, I_WIN, I_POOLW, I_POOLS, I_WPOOLOUT, I_WRETOUT, I_DECAY, I_WOUT, I_LNMG, I_LNMB, I_LNFG, I_LNFB, I_FW1, I_FW3, I_FW2, I_ROUTER, I_MW1, I_MW3, I_MW2 };

constexpr int PH_PRO_A = 0, PH_PRO_B = 1, PH_L0 = 2, PH_PER_L = 20, NPH = PH_L0 + DEPTH * PH_PER_L;
enum { Q_IN = 0, Q_POOLV, Q_RET, Q_COMB, Q_MIX, Q_OUT, Q_LN1, Q_F0, Q_F1  , Q_LN2 = 18 };

template <class RowMap>
DEVINL void cvt_T(LAS float* tl, const float* __restrict__ src, int K, int N, bf16_t* __restrict__ dst, RowMap rm, int rot) {
    const int tid = tid_hidden(), G = gridDim.x;
    const int tn = N / 128, ntile = (K / 128) * tn;
    const int r = tid >> 5, c4 = (tid & 31) * 4;
    const int nl = tid & 127, kq = tid >> 7;
    f32x4 v[8];
    int tile = (blockIdx.x + rot) % G;
    if (tile < ntile) { const int k0 = (tile / tn) * 128, n0 = (tile % tn) * 128;
#pragma unroll
        for (int q = 0; q < 8; ++q) v[q] = *(const f32x4*)(src + (size_t)(k0 + r + 16 * q) * N + n0 + c4); }
    for (; tile < ntile; tile += G) {
        const int k0 = (tile / tn) * 128, n0 = (tile % tn) * 128;
#pragma unroll
        for (int q = 0; q < 8; ++q) *(LAS f32x4*)(tl + (r + 16 * q) * 132 + c4) = v[q];
        __syncthreads();
        const int nt2 = tile + G;
        if (nt2 < ntile) { const int k2 = (nt2 / tn) * 128, n2 = (nt2 % tn) * 128;
#pragma unroll
            for (int q = 0; q < 8; ++q) v[q] = *(const f32x4*)(src + (size_t)(k2 + r + 16 * q) * N + n2 + c4); }
        bf16_t* drow = dst + (size_t)rm(n0 + nl) * K + k0 + kq * 32;
#pragma unroll
        for (int h = 0; h < 4; ++h) { float e[8];
#pragma unroll
            for (int j = 0; j < 8; ++j) e[j] = tl[(kq * 32 + h * 8 + j) * 132 + nl];
            u32x4 w; w.x = pk2(e[0], e[1]); w.y = pk2(e[2], e[3]); w.z = pk2(e[4], e[5]); w.w = pk2(e[6], e[7]);
            *(u32x4*)(drow + h * 8) = w; }
        __syncthreads();
    }
}
template <class RowMap>
DEVINL void cvt_T8(LAS float* tl, const float* __restrict__ src, int K, int N, unsigned char* __restrict__ dst, RowMap rm, int rot, float scale, int ld = 0) {
    if (ld == 0) ld = N;
    const int tid = tid_hidden(), G = gridDim.x;
    const int tn = N / 128, ntile = (K / 128) * tn;
    const int r = tid >> 5, c4 = (tid & 31) * 4;
    const int nl = tid & 127, kq = tid >> 7;
    f32x4 v[8];
    int tile = (blockIdx.x + rot) % G;
    if (tile < ntile) { const int k0 = (tile / tn) * 128, n0 = (tile % tn) * 128;
#pragma unroll
        for (int q = 0; q < 8; ++q) v[q] = *(const f32x4*)(src + (size_t)(k0 + r + 16 * q) * ld + n0 + c4); }
    for (; tile < ntile; tile += G) {
        const int k0 = (tile / tn) * 128, n0 = (tile % tn) * 128;
#pragma unroll
        for (int q = 0; q < 8; ++q) *(LAS f32x4*)(tl + (r + 16 * q) * 132 + c4) = v[q] * scale;
        __syncthreads();
        const int nt2 = tile + G;
        if (nt2 < ntile) { const int k2 = (nt2 / tn) * 128, n2 = (nt2 % tn) * 128;
#pragma unroll
            for (int q = 0; q < 8; ++q) v[q] = *(const f32x4*)(src + (size_t)(k2 + r + 16 * q) * ld + n2 + c4); }
        unsigned char* drow = dst + (size_t)rm(n0 + nl) * K + k0 + kq * 32;
#pragma unroll
        for (int h = 0; h < 2; ++h) { float e[16];
#pragma unroll
            for (int j = 0; j < 16; ++j) e[j] = tl[(kq * 32 + h * 16 + j) * 132 + nl];
            u32x4 w; w.x = pk4_fp8(e[0], e[1], e[2], e[3]); w.y = pk4_fp8(e[4], e[5], e[6], e[7]); w.z = pk4_fp8(e[8], e[9], e[10], e[11]); w.w = pk4_fp8(e[12], e[13], e[14], e[15]);
            *(u32x4*)(drow + h * 16) = w; }
        __syncthreads();
    }
}
struct MapId { DEVINL int operator()(int n) const { return n; } };
struct MapIn { DEVINL int operator()(int n) const { if (n < 512 || n >= 1536) return n; const int j = (n - 512) & 127, base = n - j; return base + (j < 64 ? 2 * j : 2 * (j - 64) + 1); } };
struct MapGU { int off; DEVINL int operator()(int n) const { return (n >> 7) * 256 + (n & 127) + off; } };

DEVINL void convert_mixer_weights(const Params& p, LAS unsigned char* lds, int l) {
    LAS float* tl = (LAS float*)lds;
    unsigned char* wm = p.ws + WS_WMIX;
    cvt_T(tl, p.in[I_WIN] + (size_t)l * 1024 * INW, 1024, INW, (bf16_t*)(wm + WMIX_IN), MapIn(), 0);
    cvt_T(tl, p.in[I_WRETOUT] + (size_t)l * 1024 * 1024, 1024, 1024, (bf16_t*)(wm + WMIX_RET), MapId(), 128);
    cvt_T(tl, p.in[I_WOUT] + (size_t)l * 1024 * 1024, 1024, 1024, (bf16_t*)(wm + WMIX_OUT), MapId(), 0);
    cvt_T8(tl, p.in[I_WIN] + (size_t)l * 1024 * INW + 3584, 1024, 2048, wm + WMIX_IN8, MapId(), 96, W13_SCALE, INW);
    const int tid = tid_hidden(), G = gridDim.x;
    LAS float* sW = (LAS float*)lds;
    LAS float* sP = (LAS float*)(lds + 32768);
    const float* pw = p.in[I_POOLW] + (size_t)l * 4 * 128 * 128; const float* ps = p.in[I_POOLS] + (size_t)l * 512; const float* wo = p.in[I_WPOOLOUT] + (size_t)l * 512 * 1024;
    bf16_t* dst = (bf16_t*)(wm + WMIX_POOL);
    for (int item = (blockIdx.x + 64) % G; item < 64; item += G) {
        const int g = item >> 4, n0 = (item & 15) * 64;
        __syncthreads();
        for (int i = tid; i < 128 * 64; i += 512) { const int d = i >> 6, n = i & 63; sW[i] = ps[g * 128 + d] * wo[(size_t)(g * 128 + d) * 1024 + n0 + n]; }
        for (int i = tid; i < 128 * 128; i += 512) { const int c = i >> 7, d = i & 127; sP[c * 129 + d] = pw[(size_t)g * 16384 + i]; }
        __syncthreads();
        const int n = tid & 63, cq = tid >> 6;
        float a[16];
#pragma unroll
        for (int j = 0; j < 16; ++j) a[j] = 0.f;
        for (int d = 0; d < 128; ++d) { const float w = sW[d * 64 + n];
#pragma unroll
            for (int j = 0; j < 16; ++j) a[j] += sP[(cq * 16 + j) * 129 + d] * w; }
        u32x4 w0, w1; w0.x = pk2(a[0], a[1]); w0.y = pk2(a[2], a[3]); w0.z = pk2(a[4], a[5]); w0.w = pk2(a[6], a[7]);
        w1.x = pk2(a[8], a[9]); w1.y = pk2(a[10], a[11]); w1.z = pk2(a[12], a[13]); w1.w = pk2(a[14], a[15]);
        bf16_t* o = dst + (size_t)(n0 + n) * 512 + g * 128 + cq * 16;
        *(u32x4*)o = w0; *(u32x4*)(o + 8) = w1;
    }
    __syncthreads();
}
DEVINL void convert_ffn_weights(const Params& p, LAS unsigned char* lds, int l) {
    LAS float* tl = (LAS float*)lds;
    unsigned char* fw = p.ws + WS_BIG + F_W;
    const int li = l >> 1;
    if ((l & 1) == 0) {
        cvt_T8(tl, p.in[I_FW1] + (size_t)li * 1024 * DFF, 1024, DFF, fw, MapGU{0}, 0, W13_SCALE);
        cvt_T8(tl, p.in[I_FW3] + (size_t)li * 1024 * DFF, 1024, DFF, fw, MapGU{128}, 64, W13_SCALE);
        cvt_T8(tl, p.in[I_FW2] + (size_t)li * DFF * 1024, DFF, 1024, fw + F_DW2, MapId(), 128, W2_SCALE);
    } else {
        for (int e = 0; e < NEXP; ++e) {
            const size_t so = ((size_t)li * NEXP + e) * 1024 * EFF;
            cvt_T8(tl, p.in[I_MW1] + so, 1024, EFF, fw + (size_t)e * F_EW13, MapGU{0}, e * 32, W13_SCALE);
            cvt_T8(tl, p.in[I_MW3] + so, 1024, EFF, fw + (size_t)e * F_EW13, MapGU{128}, e * 32 + 16, W13_SCALE);
            cvt_T8(tl, p.in[I_MW2] + so, EFF, 1024, fw + (size_t)NEXP * F_EW13 + (size_t)e * F_EW2, MapId(), e * 32 + 8, W2_SCALE);
        }
    }
}

DEVINL void adaln_phase(const Params& p, LAS unsigned char* lds) {
    const int tid = tid_hidden(), G = gridDim.x;
    LAS float* s = (LAS float*)lds;
    LAS float* red = (LAS float*)(lds + 17 * 1024 * 4);
    for (int i = tid; i < 17 * 1024; i += 512) { const float v = i < 16 * 1024 ? p.in[I_C][i] : p.in[I_CCTX][i - 16 * 1024]; s[i] = v / (1.0f + __expf(-v)); }
    __syncthreads();
    float* mod = (float*)(p.ws + WS_MOD);
    for (int item = blockIdx.x; item < 4 * 96; item += G) {
        const int l = item / 96, n = (item % 96) * 64 + (tid & 63), kq = tid >> 6;
        const float* w = p.in[I_ADAW] + (size_t)l * 1024 * 6144 + n;
        float a[17];
#pragma unroll
        for (int r = 0; r < 17; ++r) a[r] = 0.f;
#pragma unroll 4
        for (int k = kq * 128; k < kq * 128 + 128; k += 4) { const float w0 = w[(size_t)k * 6144], w1 = w[(size_t)(k + 1) * 6144], w2 = w[(size_t)(k + 2) * 6144], w3 = w[(size_t)(k + 3) * 6144];
#pragma unroll
            for (int r = 0; r < 17; ++r) { const f32x4 sv = *(const LAS f32x4*)(s + r * 1024 + k); a[r] += sv[0] * w0 + sv[1] * w1 + sv[2] * w2 + sv[3] * w3; } }
#pragma unroll
        for (int r = 0; r < 17; ++r) red[(kq * 17 + r) * 64 + (tid & 63)] = a[r];
        __syncthreads();
        for (int i = tid; i < 17 * 64; i += 512) { const int r = i >> 6, c = i & 63; float v = 0.f;
#pragma unroll
            for (int q = 0; q < 8; ++q) v += red[(q * 17 + r) * 64 + c];
            const int nn = (item % 96) * 64 + c; mod[((size_t)l * 17 + r) * 6144 + nn] = v + p.in[I_ADAB][(size_t)l * 6144 + nn]; }
        __syncthreads();
    }
}
DEVINL void rope_phase(const Params& p) {
    float* tab = (float*)(p.ws + WS_ROPE);
    for (int i = blockIdx.x * 512 + tid_hidden(); i < 4096 * 64; i += gridDim.x * 512) {
        const int pos = i >> 6, f = i & 63;
        const float inv = expf(-logf(10000.0f) * (float)(f & 31) / 32.0f);
        const float ang = (float)(f < 32 ? (pos >> 6) : (pos & 63)) * inv;
        float sn, cs; sincosf(ang, &sn, &cs);
        tab[2 * i] = cs; tab[2 * i + 1] = sn;
    }
}

DEVINL bf16_t* strm_row(const Params& p, int t) { return (bf16_t*)(p.ws + WS_A) + (size_t)t * 1024; }
DEVINL bf16_t* regA(const Params& p) { return (bf16_t*)p.out; }
DEVINL unsigned char* regA8(const Params& p) { return (unsigned char*)p.out + U; }
DEVINL const float* in_row0(const Params& p, int t) { return t < NLAT ? p.in[I_X] + (size_t)t * 1024 : p.in[I_CTX] + (size_t)(t - NLAT) * 1024; }
DEVINL const float* mod_row(const Params& p, int l, int t, int which) { const int r = t < NLAT ? (t >> 12) : 16; return (const float*)(p.ws + WS_MOD) + (((size_t)l * 17 + r) * 6 + which) * 1024; }

DEVINL void modulate0_phase(const Params& p) {
    const int tid = tid_hidden(), lane = tid & 63, gw = blockIdx.x * 8 + (tid >> 6), nw = gridDim.x * 8;
    bf16_t* h = regA(p);
    for (int t = gw; t < T; t += 2 * nw) {
        const int t2 = t + nw; const bool has2 = t2 < T; const int tb = has2 ? t2 : t;
        const float* xa = in_row0(p, t); const float* xb = in_row0(p, tb);
        f32x4 va[4], vb[4];
#pragma unroll
        for (int j = 0; j < 4; ++j) { va[j] = *(const f32x4*)(xa + j * 256 + lane * 4); vb[j] = *(const f32x4*)(xb + j * 256 + lane * 4); }
        const float* sha = mod_row(p, 0, t, 0); const float* sca = mod_row(p, 0, t, 1); const float* shb = mod_row(p, 0, tb, 0); const float* scb = mod_row(p, 0, tb, 1);
#pragma unroll
        for (int j = 0; j < 4; ++j) { const int c = j * 256 + lane * 4;
            const f32x4 ya = va[j] * (*(const f32x4*)(sca + c) + 1.0f) + *(const f32x4*)(sha + c); u32x2 w; w.x = pk2(ya[0], ya[1]); w.y = pk2(ya[2], ya[3]); *(u32x2*)(h + (size_t)t * 1024 + c) = w; *(unsigned*)(regA8(p) + (size_t)t * 1024 + c) = pk4_fp8(ya[0], ya[1], ya[2], ya[3]);
            if (has2) { const f32x4 yb = vb[j] * (*(const f32x4*)(scb + c) + 1.0f) + *(const f32x4*)(shb + c); u32x2 w2; w2.x = pk2(yb[0], yb[1]); w2.y = pk2(yb[2], yb[3]); *(u32x2*)(h + (size_t)tb * 1024 + c) = w2; *(unsigned*)(regA8(p) + (size_t)tb * 1024 + c) = pk4_fp8(yb[0], yb[1], yb[2], yb[3]); } }
    }
}

DEVINL void acc8(float (&a)[8], const u32x4 v) { a[0] += bflo(v.x); a[1] += bfhi(v.x); a[2] += bflo(v.y); a[3] += bfhi(v.y); a[4] += bflo(v.z); a[5] += bfhi(v.z); a[6] += bflo(v.w); a[7] += bfhi(v.w); }
template <int GI, bool HORIZ>
DEVINL void pool_item(const bf16_t* __restrict__ src, const bf16_t* __restrict__ usrc, bf16_t* __restrict__ dst, int t, int ch) {
    constexpr int W = 2 << GI, LEFT = W / 2, RIGHT = W - 1 - LEFT;
    const bool lat = t < NLAT;
    int pos, last, stride;
    if (HORIZ) { pos = lat ? (t & 63) : ((t - NLAT) & 255); last = lat ? 63 : 255; stride = 1; }
    else { pos = (t >> 6) & 63; last = 63; stride = 64; }
    float a[8];
#pragma unroll
    for (int j = 0; j < 8; ++j) a[j] = 0.f;
    if (!HORIZ && !lat) { *(u32x4*)(dst + (size_t)t * 512 + ch) = *(const u32x4*)(src + (size_t)t * 512 + ch); return; }
    const int lo = max(pos - LEFT, 0), hi = min(pos + RIGHT, last);
    u32x4 wv[W];
#pragma unroll
    for (int k = 0; k < W; ++k) { const int qc = min(max(pos - LEFT + k, lo), hi); wv[k] = *(const u32x4*)(src + (size_t)(t + (qc - pos) * stride) * 512 + ch); }
#pragma unroll
    for (int k = 0; k < W; ++k) { const int q = pos - LEFT + k; if (q >= lo && q <= hi) acc8(a, wv[k]); }
    const float inv = 1.0f / (float)(hi - lo + 1);
    u32x4 w;
    if (HORIZ) { const u32x4 uv = *(const u32x4*)(usrc + (size_t)t * 512 + ch);
        w.x = pk2(a[0] * inv - bflo(uv.x), a[1] * inv - bfhi(uv.x)); w.y = pk2(a[2] * inv - bflo(uv.y), a[3] * inv - bfhi(uv.y));
        w.z = pk2(a[4] * inv - bflo(uv.z), a[5] * inv - bfhi(uv.z)); w.w = pk2(a[6] * inv - bflo(uv.w), a[7] * inv - bfhi(uv.w)); }
    else { w.x = pk2(a[0] * inv, a[1] * inv); w.y = pk2(a[2] * inv, a[3] * inv); w.z = pk2(a[4] * inv, a[5] * inv); w.w = pk2(a[6] * inv, a[7] * inv); }
    *(u32x4*)(dst + (size_t)t * 512 + ch) = w;
}
template <bool HORIZ>
DEVINL void pool_phase(const Params& p, int Tact) {
    const int tid = tid_hidden(), lane = tid & 63, gw = blockIdx.x * 8 + (tid >> 6), nw = gridDim.x * 8;
    bf16_t* u = (bf16_t*)(p.ws + WS_BIG + B_U); bf16_t* vm = regA(p);
    const bf16_t* src = HORIZ ? vm : u; bf16_t* dst = HORIZ ? u : vm;
    for (int q = gw; q < Tact / 4; q += nw) {
        const int t = q * 4 + (lane >> 4), cl = (lane & 15) * 8;
        pool_item<3, HORIZ>(src, u, dst, t, 384 + cl); pool_item<2, HORIZ>(src, u, dst, t, 256 + cl); pool_item<1, HORIZ>(src, u, dst, t, 128 + cl); pool_item<0, HORIZ>(src, u, dst, t, cl);
    }
}
struct CombSet { u32x2 a[4], b[4], g[4]; };
DEVINL void comb_load(const Params& p, int t, int lane, CombSet& S) {
    const bf16_t* of = (const bf16_t*)(p.ws + WS_BIG + B_OF); const bf16_t* ob = (const bf16_t*)(p.ws + WS_BIG + B_OB); const bf16_t* sg = (const bf16_t*)(p.ws + WS_BIG + B_SG);
#pragma unroll
    for (int j = 0; j < 4; ++j) { const size_t off = (size_t)t * 1024 + j * 256 + lane * 4; S.a[j] = *(const u32x2*)(of + off); S.b[j] = *(const u32x2*)(ob + off); S.g[j] = *(const u32x2*)(sg + off); }
}
DEVINL void comb_row(const Params& p, int t, int lane, const CombSet& S) {
    bf16_t* ur = (bf16_t*)(p.ws + WS_BIG + B_URET);
#pragma unroll
    for (int j = 0; j < 4; ++j) {
        float o[4] = {bflo(S.a[j].x) + bflo(S.b[j].x), bfhi(S.a[j].x) + bfhi(S.b[j].x), bflo(S.a[j].y) + bflo(S.b[j].y), bfhi(S.a[j].y) + bfhi(S.b[j].y)};
        const float mean = wave_sum(o[0] + o[1] + o[2] + o[3]) * (1.0f / 256.0f);
        float q = 0.f;
#pragma unroll
        for (int e = 0; e < 4; ++e) { o[e] -= mean; q += o[e] * o[e]; }
        const float rstd = rsqrtf(wave_sum(q) * (1.0f / 256.0f) + LN_EPS);
        u32x2 w; w.x = pk2(bflo(S.g[j].x) * o[0] * rstd, bfhi(S.g[j].x) * o[1] * rstd); w.y = pk2(bflo(S.g[j].y) * o[2] * rstd, bfhi(S.g[j].y) * o[3] * rstd);
        *(u32x2*)(ur + (size_t)t * 1024 + j * 256 + lane * 4) = w;
    }
}
DEVINL void combine_phase(const Params& p, int Tact) {
    const int tid = tid_hidden(), lane = tid & 63, gw = blockIdx.x * 8 + (tid >> 6), nw = gridDim.x * 8;
    CombSet A0, A1, B0, B1;
    int ta = gw;
    if (ta < Tact) { comb_load(p, ta, lane, A0); comb_load(p, min(ta + nw, Tact - 1), lane, A1); }
    while (ta < Tact) {
        const int tn = ta + 2 * nw;
        if (tn < Tact) { comb_load(p, tn, lane, B0); comb_load(p, min(tn + nw, Tact - 1), lane, B1); }
        comb_row(p, ta, lane, A0); if (ta + nw < Tact) comb_row(p, ta + nw, lane, A1);
        if (tn >= Tact) break;
        const int tn2 = tn + 2 * nw;
        if (tn2 < Tact) { comb_load(p, tn2, lane, A0); comb_load(p, min(tn2 + nw, Tact - 1), lane, A1); }
        comb_row(p, tn, lane, B0); if (tn + nw < Tact) comb_row(p, tn + nw, lane, B1);
        ta = tn2;
    }
}

struct LnRaw { u32x4 r[2]; };
DEVINL void ln_load_row(const bf16_t* xr, int lane, LnRaw& R) { R.r[0] = *(const u32x4*)(xr + lane * 8); R.r[1] = *(const u32x4*)(xr + 512 + lane * 8); }
DEVINL void ln_norm16(float (&v)[2][8], float& mean_o, float& rstd_o) {
    float s = 0.f;
#pragma unroll
    for (int j = 0; j < 2; ++j)
#pragma unroll
        for (int e = 0; e < 8; ++e) s += v[j][e];
    const float mean = wave_sum(s) * (1.0f / 1024.0f);
    float q = 0.f;
#pragma unroll
    for (int j = 0; j < 2; ++j)
#pragma unroll
        for (int e = 0; e < 8; ++e) { v[j][e] -= mean; q += v[j][e] * v[j][e]; }
    const float rstd = rsqrtf(wave_sum(q) * (1.0f / 1024.0f) + LN_EPS);
#pragma unroll
    for (int j = 0; j < 2; ++j)
#pragma unroll
        for (int e = 0; e < 8; ++e) v[j][e] *= rstd;
    mean_o = mean; rstd_o = rstd;
}
DEVINL void lds8f(const LAS float* p, float (&v)[8]) { const f32x4 a = *(const LAS f32x4*)p, b = *(const LAS f32x4*)(p + 4); v[0] = a[0]; v[1] = a[1]; v[2] = a[2]; v[3] = a[3]; v[4] = b[0]; v[5] = b[1]; v[6] = b[2]; v[7] = b[3]; }
DEVINL int mod_ridx(int t) { return t < NLAT ? (t >> 12) : 16; }
DEVINL void lds_fill(LAS float* dst, const float* src, int tid) { for (int i = tid; i < 256; i += 512) *(LAS f32x4*)(dst + 4 * i) = *(const f32x4*)(src + 4 * i); }
DEVINL void ln1_row(const Params& p, int l, int t, int lane, bool moe, const LnRaw& R, const LAS float* sG, const LAS float* sB, const LAS float* sSC, const LAS float* sSH, LAS float* sR, LAS int* sCnt) {
    bf16_t* h2 = regA(p);
    float v[2][8]; unpk8h(R.r[0], v[0]); unpk8h(R.r[1], v[1]);
    float mean, rstd; ln_norm16(v, mean, rstd);
    if (lane == 0) { float* st1 = (float*)(p.ws + WS_ST1); st1[2 * t] = mean; st1[2 * t + 1] = rstd; }
    float lg[8];
#pragma unroll
    for (int e = 0; e < 8; ++e) lg[e] = 0.f;
#pragma unroll
    for (int j = 0; j < 2; ++j) { const int c = j * 512 + lane * 8;
        float g8[8], b8[8], s8[8], h8[8], hv[8]; lds8f(sG + c, g8); lds8f(sB + c, b8); lds8f(sSC + c, s8); lds8f(sSH + c, h8);
#pragma unroll
        for (int e = 0; e < 8; ++e) hv[e] = (v[j][e] * g8[e] + b8[e]) * (s8[e] + 1.0f) + h8[e];
        { u32x2 w8; w8.x = pk4_fp8(hv[0], hv[1], hv[2], hv[3]); w8.y = pk4_fp8(hv[4], hv[5], hv[6], hv[7]); *(u32x2*)((unsigned char*)h2 + (size_t)t * 1024 + c) = w8; }
        if (moe) {
#pragma unroll
            for (int e = 0; e < 8; ++e) { float w8[8]; lds8f(sR + e * 1024 + c, w8);
#pragma unroll
                for (int i = 0; i < 8; ++i) lg[e] += hv[i] * w8[i]; }
        }
    }
    if (moe) {
        int* toke = (int*)(p.ws + WS_TOKE); float* tokw = (float*)(p.ws + WS_TOKW);
#pragma unroll
        for (int e = 0; e < 8; ++e) lg[e] = wave_sum(lg[e]);
        int e0 = 0; float m0 = lg[0];
#pragma unroll
        for (int e = 1; e < 8; ++e) if (lg[e] > m0) { m0 = lg[e]; e0 = e; }
        int e1 = -1; float m1 = -3.0e38f;
#pragma unroll
        for (int e = 0; e < 8; ++e) if (e != e0 && lg[e] > m1) { m1 = lg[e]; e1 = e; }
        if (e1 < 0) { e1 = (e0 + 1) & 7; m1 = m0; }
        const float ex = __expf(m1 - m0), w0 = 1.0f / (1.0f + ex), w1 = ex / (1.0f + ex);
        if (lane == 0) { toke[2 * t] = e0; toke[2 * t + 1] = e1; tokw[2 * t] = w0; tokw[2 * t + 1] = w1; __hip_atomic_fetch_add(&sCnt[e0], 1, __ATOMIC_RELAXED, __HIP_MEMORY_SCOPE_WORKGROUP); __hip_atomic_fetch_add(&sCnt[e1], 1, __ATOMIC_RELAXED, __HIP_MEMORY_SCOPE_WORKGROUP); }
    }
}
DEVINL void ln1_phase(const Params& p, LAS unsigned char* lds, int l, int Tact) {
    const int tid = tid_hidden(), lane = tid & 63, wv = tid >> 6, G = gridDim.x;
    const bool moe = (l & 1) != 0;
    LAS float* sR = (LAS float*)lds;
    LAS int* sCnt = (LAS int*)(lds + 32768);
    LAS float* sG = (LAS float*)(lds + 36864); LAS float* sB = sG + 1024; LAS float* sSC = sB + 1024; LAS float* sSH = sSC + 2048;
    const int per = (Tact + G - 1) / G, t0 = blockIdx.x * per, t1 = min(t0 + per, Tact);
    const int r_lo = mod_ridx(min(t0, Tact - 1)), r_hi = mod_ridx(max(t1 - 1, 0));
    if (moe) { const float* wr = p.in[I_ROUTER] + (size_t)(l >> 1) * 1024 * 8; for (int i = tid; i < 8192; i += 512) sR[(i & 7) * 1024 + (i >> 3)] = wr[i]; if (tid < 8) sCnt[tid] = 0; }
    { const float* modl = (const float*)(p.ws + WS_MOD) + (size_t)l * 17 * 6144;
      lds_fill(sG, p.in[I_LNMG] + (size_t)l * 1024, tid); lds_fill(sB, p.in[I_LNMB] + (size_t)l * 1024, tid);
      lds_fill(sSC, modl + ((size_t)r_lo * 6 + 4) * 1024, tid); lds_fill(sSC + 1024, modl + ((size_t)r_hi * 6 + 4) * 1024, tid);
      lds_fill(sSH, modl + ((size_t)r_lo * 6 + 3) * 1024, tid); lds_fill(sSH + 1024, modl + ((size_t)r_hi * 6 + 3) * 1024, tid); }
    __syncthreads();
#define LN1_ROW(tt, RR) do { const int _o = (mod_ridx(tt) == r_lo) ? 0 : 1024; ln1_row(p, l, (tt), lane, moe, RR, sG, sB, sSC + _o, sSH + _o, sR, sCnt); } while (0)
    LnRaw A0, A1, B0, B1;
    int ta = t0 + wv;
    if (ta < t1) { ln_load_row(strm_row(p, ta), lane, A0); ln_load_row(strm_row(p, min(ta + 8, t1 - 1)), lane, A1); }
    while (ta < t1) {
        const int tn = ta + 16;
        if (tn < t1) { ln_load_row(strm_row(p, tn), lane, B0); ln_load_row(strm_row(p, min(tn + 8, t1 - 1)), lane, B1); }
        LN1_ROW(ta, A0); if (ta + 8 < t1) LN1_ROW(ta + 8, A1);
        if (tn >= t1) break;
        const int tn2 = tn + 16;
        if (tn2 < t1) { ln_load_row(strm_row(p, tn2), lane, A0); ln_load_row(strm_row(p, min(tn2 + 8, t1 - 1)), lane, A1); }
        LN1_ROW(tn, B0); if (tn + 8 < t1) LN1_ROW(tn + 8, B1);
        ta = tn2;
    }
#undef LN1_ROW
    __syncthreads();
    if (moe && tid < 8) ((int*)(p.ws + WS_WGCNT))[blockIdx.x * 8 + tid] = sCnt[tid];
    __syncthreads();
}

DEVINL void moe_scatter_phase(const Params& p, LAS unsigned char* lds, int Tact) {
    const int tid = tid_hidden(), lane = tid & 63, wv = tid >> 6, G = gridDim.x;
    LAS int* sC = (LAS int*)lds;
    LAS int* sBase = (LAS int*)(lds + 16384);
    LAS int* sE = (LAS int*)(lds + 16384 + 256);
    LAS int* sD = (LAS int*)(lds + 16384 + 256 + 4096);
    const int* wgc = (const int*)(p.ws + WS_WGCNT);
    for (int i = tid; i < G * 8; i += 512) sC[i] = wgc[i];
    __syncthreads();
    if (tid < 8) { int tot = 0, before = 0; for (int g = 0; g < G; ++g) { const int c = sC[g * 8 + tid]; if (g < (int)blockIdx.x) before += c; tot += c; } sBase[tid] = before; sBase[8 + tid] = (tot + 255) / 256 * 256; }
    __syncthreads();
    if (tid == 0) { int acc = 0; for (int e = 0; e < 8; ++e) { const int pd = sBase[8 + e]; sBase[e] += acc; acc += pd; sBase[8 + e] = acc; } }
    __syncthreads();
    const int per = (Tact + G - 1) / G, t0 = blockIdx.x * per, t1 = min(t0 + per, Tact), na = max(t1 - t0, 0) * 2;
    const int* toke = (const int*)(p.ws + WS_TOKE); int* tokd = (int*)(p.ws + WS_TOKD);
    for (int a = tid; a < na; a += 512) sE[a] = toke[2 * t0 + a] & 7;
    __syncthreads();
    for (int a = tid; a < na; a += 512) { const int e = sE[a]; int r = 0; for (int b = 0; b < a; ++b) r += (sE[b] == e) ? 1 : 0; int d = sBase[e] + r; d = min(max(d, 0), MAXRB * 256 - 1); sD[a] = d; tokd[2 * t0 + a] = d; }
    if (blockIdx.x == 0) {
        int* blke = (int*)(p.ws + WS_BLKE);
        if (tid == 0) blke[0] = sBase[15] / 256;
        if (tid < 7) blke[1 + tid] = sBase[8 + tid] / 256;
        for (int rb = tid; rb < MAXRB; rb += 512) { int e = 0; while (e < 7 && rb * 256 >= sBase[8 + e]) ++e; blke[8 + rb] = e; }
    }
    __syncthreads();
    const unsigned char* h2 = (const unsigned char*)regA(p); unsigned char* xs = p.ws + WS_BIG + F_XS;
    for (int a0 = wv; a0 < na; a0 += 64) {
        u32x4 v0[8];
#pragma unroll
        for (int r = 0; r < 8; ++r) { const int a = min(a0 + 8 * r, na - 1), t = t0 + (a >> 1); v0[r] = *(const u32x4*)(h2 + (size_t)t * 1024 + lane * 16); }
#pragma unroll
        for (int r = 0; r < 8; ++r) { const int a = a0 + 8 * r; if (a < na) { const int d = sD[a]; *(u32x4*)(xs + (size_t)d * 1024 + lane * 16) = v0[r]; } }
    }
    __syncthreads();
}

struct Ln2Set { LnRaw z; LnRaw ya, yb; float w0, w1, m1, r1; };
struct Ln2Par { const LAS float* G; const LAS float* B; const LAS float* SC; const LAS float* SH; const LAS float* M5; const LAS float* GM; const LAS float* BM; };
DEVINL void ln2_load(const Params& p, int t, int lane, bool moe, Ln2Set& S) {
    if (moe) { const int* tokd = (const int*)(p.ws + WS_TOKD); const float* tokw = (const float*)(p.ws + WS_TOKW); const bf16_t* yk = (const bf16_t*)(p.ws + WS_BIG + F_YK);
        const int d0 = tokd[2 * t], d1 = tokd[2 * t + 1]; S.w0 = tokw[2 * t]; S.w1 = tokw[2 * t + 1]; const float* st1 = (const float*)(p.ws + WS_ST1); S.m1 = st1[2 * t]; S.r1 = st1[2 * t + 1];
        ln_load_row(yk + (size_t)d0 * 1024, lane, S.ya); ln_load_row(yk + (size_t)d1 * 1024, lane, S.yb); }
    ln_load_row(strm_row(p, t), lane, S.z);
}
DEVINL void ln2_row(const Params& p, int l, int t, int lane, bool moe, const Ln2Set& S, const Ln2Par& P) {
    float v[2][8]; unpk8h(S.z.r[0], v[0]); unpk8h(S.z.r[1], v[1]);
    if (moe) {
#pragma unroll
        for (int j = 0; j < 2; ++j) { const int c = j * 512 + lane * 8; float a8[8], b8[8], g8[8], e8[8], m8[8]; unpk8(S.ya.r[j], a8); unpk8(S.yb.r[j], b8); lds8f(P.GM + c, g8); lds8f(P.BM + c, e8); lds8f(P.M5 + c, m8);
#pragma unroll
            for (int e = 0; e < 8; ++e) { const float x1 = (v[j][e] - S.m1) * S.r1 * g8[e] + e8[e];
                v[j][e] = x1 * ALPHA + m8[e] * (S.w0 * a8[e] + S.w1 * b8[e]); } } }
    float mean2, rstd2; ln_norm16(v, mean2, rstd2);
    const bool last = l + 1 >= DEPTH, store_x = moe || last;
    if (!store_x && lane == 0) { float* st2 = (float*)(p.ws + WS_ST2); st2[2 * t] = mean2; st2[2 * t + 1] = rstd2; }
#pragma unroll
    for (int j = 0; j < 2; ++j) { const int c = j * 512 + lane * 8; float g8[8], b8[8], xv[8]; lds8f(P.G + c, g8); lds8f(P.B + c, b8);
#pragma unroll
        for (int e = 0; e < 8; ++e) xv[e] = v[j][e] * g8[e] + b8[e];
        if (last) { float* o = p.out + (size_t)t * 1024 + c; *(f32x4*)o = (f32x4){xv[0], xv[1], xv[2], xv[3]}; *(f32x4*)(o + 4) = (f32x4){xv[4], xv[5], xv[6], xv[7]}; }
        else if (store_x) *(u32x4*)(strm_row(p, t) + c) = pk8h(xv);
        if (!last) { float s8[8], h8[8], hv[8]; lds8f(P.SC + c, s8); lds8f(P.SH + c, h8);
#pragma unroll
            for (int e = 0; e < 8; ++e) hv[e] = xv[e] * (s8[e] + 1.0f) + h8[e];
            *(u32x4*)(regA(p) + (size_t)t * 1024 + c) = pk8(hv);
            u32x2 w8; w8.x = pk4_fp8(hv[0], hv[1], hv[2], hv[3]); w8.y = pk4_fp8(hv[4], hv[5], hv[6], hv[7]); *(u32x2*)(regA8(p) + (size_t)t * 1024 + c) = w8; }
    }
}
DEVINL void ln2_phase(const Params& p, LAS unsigned char* lds, int l, int Tact) {
    const int tid = tid_hidden(), lane = tid & 63, wv = tid >> 6, G = gridDim.x;
    const bool moe = (l & 1) != 0, last = l + 1 >= DEPTH;
    LAS float* sG = (LAS float*)lds; LAS float* sB = sG + 1024; LAS float* sSC = sB + 1024; LAS float* sSH = sSC + 2048; LAS float* sM5 = sSH + 2048; LAS float* sGM = sM5 + 2048; LAS float* sBM = sGM + 1024;
    const int per = (Tact + G - 1) / G, t0 = blockIdx.x * per, t1 = min(t0 + per, Tact);
    const int r_lo = mod_ridx(min(t0, Tact - 1)), r_hi = mod_ridx(max(t1 - 1, 0));
    __syncthreads();
    { const float* mod = (const float*)(p.ws + WS_MOD); const float* modl = mod + (size_t)l * 17 * 6144; const float* modn = mod + (size_t)(last ? l : l + 1) * 17 * 6144;
      lds_fill(sG, p.in[I_LNFG] + (size_t)l * 1024, tid); lds_fill(sB, p.in[I_LNFB] + (size_t)l * 1024, tid);
      lds_fill(sSC, modn + ((size_t)r_lo * 6 + 1) * 1024, tid); lds_fill(sSC + 1024, modn + ((size_t)r_hi * 6 + 1) * 1024, tid);
      lds_fill(sSH, modn + ((size_t)r_lo * 6 + 0) * 1024, tid); lds_fill(sSH + 1024, modn + ((size_t)r_hi * 6 + 0) * 1024, tid);
      lds_fill(sM5, modl + ((size_t)r_lo * 6 + 5) * 1024, tid); lds_fill(sM5 + 1024, modl + ((size_t)r_hi * 6 + 5) * 1024, tid);
      lds_fill(sGM, p.in[I_LNMG] + (size_t)l * 1024, tid); lds_fill(sBM, p.in[I_LNMB] + (size_t)l * 1024, tid); }
    __syncthreads();
#define LN2_ROW(tt, SS) do { const int _o = (mod_ridx(tt) == r_lo) ? 0 : 1024; const Ln2Par _P{sG, sB, sSC + _o, sSH + _o, sM5 + _o, sGM, sBM}; ln2_row(p, l, (tt), lane, moe, SS, _P); } while (0)
    Ln2Set A0, A1, B0, B1;
    int ta = t0 + wv;
    if (ta < t1) { ln2_load(p, ta, lane, moe, A0); ln2_load(p, min(ta + 8, t1 - 1), lane, moe, A1); }
    while (ta < t1) {
        const int tn = ta + 16;
        if (tn < t1) { ln2_load(p, tn, lane, moe, B0); ln2_load(p, min(tn + 8, t1 - 1), lane, moe, B1); }
        LN2_ROW(ta, A0); if (ta + 8 < t1) LN2_ROW(ta + 8, A1);
        if (tn >= t1) break;
        const int tn2 = tn + 16;
        if (tn2 < t1) { ln2_load(p, tn2, lane, moe, A0); ln2_load(p, min(tn2 + 8, t1 - 1), lane, moe, A1); }
        LN2_ROW(tn, B0); if (tn + 8 < t1) LN2_ROW(tn + 8, B1);
        ta = tn2;
    }
#undef LN2_ROW
    __syncthreads();
}

DEVINL bf16x8 cat8(v4i16_t a, v4i16_t b) { bf16x8 r; r[0] = a[0]; r[1] = a[1]; r[2] = a[2]; r[3] = a[3]; r[4] = b[0]; r[5] = b[1]; r[6] = b[2]; r[7] = b[3]; return r; }
DEVINL void retention_phase(const Params& p, LAS unsigned char* lds, int l, bool need_ctx) {
    constexpr int RS = 272;
    int tid = threadIdx.x; asm volatile("" : "+v"(tid));
    const int w = __builtin_amdgcn_readfirstlane(tid >> 6), lane = tid & 63, fr = lane & 15, fq = lane >> 4;
    LAS unsigned char* Qs = lds; LAS unsigned char* Ks = lds + 34816; LAS unsigned char* Vs = lds + 69632; LAS unsigned char* Ps = lds + 104448;
    LAS float* tqd = (LAS float*)(lds + LDS_TAB); LAS float* tkd = tqd + 128;
    const bf16_t* qg = (const bf16_t*)(p.ws + WS_BIG + B_Q); const bf16_t* kg = (const bf16_t*)(p.ws + WS_BIG + B_K); const bf16_t* vg = (const bf16_t*)(p.ws + WS_BIG + B_V);
    const int lr = tid >> 4, lc = tid & 15;
    const int trq = fr >> 2, trp = fr & 3;
    for (int item = blockIdx.x; item < 256; item += gridDim.x) {
        const int dvs = item & 1, dir = (item >> 1) & 1, hd = (item >> 2) & 3, b = item >> 4;
        bf16_t* og = (bf16_t*)(p.ws + WS_BIG + (dir ? B_OB : B_OF));
        const float zl = p.in[I_DECAY][l * 8 + dir * 4 + hd];
        const float lg2 = -log1pf(expf(-zl)) * 1.4426950408889634f;
        __syncthreads();
        if (tid < 128) { tqd[tid] = exp2f(lg2 * (float)(dir ? 128 - tid : tid + 1)); tkd[tid] = exp2f(lg2 * (float)(dir ? tid : 127 - tid)); }
        const float cdec = exp2f(lg2 * 128.0f);
        float afac[4];
#pragma unroll
        for (int jj = 0; jj < 4; ++jj) afac[jj] = exp2f(lg2 * (float)(dir ? (4 * fq + jj - fr) : (fr - 4 * fq - jj)));
        f32x4 S[8];
#pragma unroll
        for (int t = 0; t < 8; ++t) S[t] = (f32x4){0.f, 0.f, 0.f, 0.f};
        u32x4 rq[4], rk[4], rv[4];
#define RET_TOK0(c) ((c) < 2 ? NLAT + b * 256 + (dir ? 1 - (c) : (c)) * 128 : b * 4096 + (dir ? 33 - (c) : (c) - 2) * 128)
#define RET_LOAD(c) do { const int _t0 = RET_TOK0(c); _Pragma("unroll") for (int ps = 0; ps < 4; ++ps) { const size_t _t = (size_t)(_t0 + lr + 32 * ps); \
            rq[ps] = *(const u32x4*)(qg + _t * 512 + hd * 128 + lc * 8); rk[ps] = *(const u32x4*)(kg + _t * 512 + hd * 128 + lc * 8); rv[ps] = *(const u32x4*)(vg + _t * 1024 + hd * 256 + dvs * 128 + lc * 8); } } while (0)
        RET_LOAD(0);
        for (int c = 0; c < 34; ++c) {
            const int tok0 = RET_TOK0(c);
            __syncthreads();
#pragma unroll
            for (int ps = 0; ps < 4; ++ps) { const int o = (lr + 32 * ps) * RS + lc * 16; *(LAS u32x4*)(Qs + o) = rq[ps]; *(LAS u32x4*)(Ks + o) = rk[ps]; *(LAS u32x4*)(Vs + o) = rv[ps]; }
            __syncthreads();
            if (c + 1 < 34) RET_LOAD(c + 1);
            const bool do_out = (c >= 2) || need_ctx;
            if (do_out) {
                const int rt = w < 4 ? w : 11 - w;
                bf16x8 qf[4];
#pragma unroll
                for (int s = 0; s < 4; ++s) qf[s] = *(const LAS bf16x8*)(Qs + (16 * rt + fr) * RS + (32 * s + 8 * fq) * 2);
                const int i = 16 * rt + fr;
#pragma unroll
                for (int t = 0; t < 8; ++t) {
                    const bool live = dir ? (t >= rt) : (t <= rt);
                    f32x4 a = (f32x4){0.f, 0.f, 0.f, 0.f};
                    if (live) {
#pragma unroll
                        for (int s = 0; s < 4; ++s) { const bf16x8 kf = *(const LAS bf16x8*)(Ks + (16 * t + fr) * RS + (32 * s + 8 * fq) * 2); a = __builtin_amdgcn_mfma_f32_16x16x32_bf16(kf, qf[s], a, 0, 0, 0); }
                        const float bt = __builtin_amdgcn_exp2f(lg2 * 16.0f * (float)(dir ? t - rt : rt - t));
#pragma unroll
                        for (int jj = 0; jj < 4; ++jj) { const int dd = dir ? (4 * fq + jj - fr) : (fr - 4 * fq - jj); a[jj] = (t != rt || dd >= 0) ? a[jj] * (afac[jj] * bt) : 0.f; }
                    }
                    u32x2 pw; pw.x = pk2(a[0], a[1]); pw.y = pk2(a[2], a[3]);
                    *(LAS u32x2*)(Ps + i * RS + (16 * t + 4 * fq) * 2) = pw;
                }
            }
            __syncthreads();
            bf16x8 vf[4];
#pragma unroll
            for (int s = 0; s < 4; ++s) { LAS unsigned char* a0 = Vs + (32 * s + 8 * fq + trq) * RS + (16 * w + 4 * trp) * 2;
                vf[s] = cat8(__builtin_amdgcn_ds_read_tr16_b64_v4i16((LAS v4i16_t*)a0), __builtin_amdgcn_ds_read_tr16_b64_v4i16((LAS v4i16_t*)(a0 + 4 * RS))); }
            if (do_out) {
                bf16x8 Sb[4];
#pragma unroll
                for (int s = 0; s < 4; ++s) { u32x4 t4; t4.x = pk2(S[2 * s][0], S[2 * s][1]); t4.y = pk2(S[2 * s][2], S[2 * s][3]); t4.z = pk2(S[2 * s + 1][0], S[2 * s + 1][1]); t4.w = pk2(S[2 * s + 1][2], S[2 * s + 1][3]); Sb[s] = __builtin_bit_cast(bf16x8, t4); }
#pragma unroll
                for (int ip = 0; ip < 4; ++ip) {
                    const int i0 = 16 * (2 * ip) + fr, i1 = i0 + 16;
                    bf16x8 q0[4], q1[4];
#pragma unroll
                    for (int s = 0; s < 4; ++s) { q0[s] = *(const LAS bf16x8*)(Qs + i0 * RS + (32 * s + 8 * fq) * 2); q1[s] = *(const LAS bf16x8*)(Qs + i1 * RS + (32 * s + 8 * fq) * 2); }
                    f32x4 a0 = (f32x4){0.f, 0.f, 0.f, 0.f}, a1 = a0;
#pragma unroll
                    for (int s = 0; s < 4; ++s) { a0 = __builtin_amdgcn_mfma_f32_16x16x32_bf16(Sb[s], q0[s], a0, 0, 0, 0); a1 = __builtin_amdgcn_mfma_f32_16x16x32_bf16(Sb[s], q1[s], a1, 0, 0, 0); }
                    a0 *= tqd[i0]; a1 *= tqd[i1];
#pragma unroll
                    for (int s = 0; s < 4; ++s) {
                        if (dir ? (2 * s + 1 >= 2 * ip) : (2 * s <= 2 * ip)) { const bf16x8 pb = *(const LAS bf16x8*)(Ps + i0 * RS + (32 * s + 8 * fq) * 2); a0 = __builtin_amdgcn_mfma_f32_16x16x32_bf16(vf[s], pb, a0, 0, 0, 0); }
                        if (dir ? (2 * s + 1 >= 2 * ip + 1) : (2 * s <= 2 * ip + 1)) { const bf16x8 pb = *(const LAS bf16x8*)(Ps + i1 * RS + (32 * s + 8 * fq) * 2); a1 = __builtin_amdgcn_mfma_f32_16x16x32_bf16(vf[s], pb, a1, 0, 0, 0); }
                    }
                    u32x2 ow0, ow1; ow0.x = pk2(a0[0], a0[1]); ow0.y = pk2(a0[2], a0[3]); ow1.x = pk2(a1[0], a1[1]); ow1.y = pk2(a1[2], a1[3]);
                    *(u32x2*)(og + (size_t)(tok0 + i0) * 1024 + hd * 256 + dvs * 128 + 16 * w + 4 * fq) = ow0;
                    *(u32x2*)(og + (size_t)(tok0 + i1) * 1024 + hd * 256 + dvs * 128 + 16 * w + 4 * fq) = ow1;
                }
            }
#pragma unroll
            for (int t = 0; t < 8; ++t) S[t] *= cdec;
#pragma unroll
            for (int s = 0; s < 4; ++s) {
                const f32x4 k0 = *(const LAS f32x4*)(tkd + 32 * s + 8 * fq), k1 = *(const LAS f32x4*)(tkd + 32 * s + 8 * fq + 4);
                const u32x4 vv = __builtin_bit_cast(u32x4, vf[s]); u32x4 t4;
                t4.x = pk2(bflo(vv.x) * k0[0], bfhi(vv.x) * k0[1]); t4.y = pk2(bflo(vv.y) * k0[2], bfhi(vv.y) * k0[3]);
                t4.z = pk2(bflo(vv.z) * k1[0], bfhi(vv.z) * k1[1]); t4.w = pk2(bflo(vv.w) * k1[2], bfhi(vv.w) * k1[3]);
                const bf16x8 vsc = __builtin_bit_cast(bf16x8, t4);
#pragma unroll
                for (int t = 0; t < 8; ++t) {
                    LAS unsigned char* a0 = Ks + (32 * s + 8 * fq + trq) * RS + (32 * (t >> 1) + 8 * trp + 4 * (t & 1)) * 2;
                    const bf16x8 kt = cat8(__builtin_amdgcn_ds_read_tr16_b64_v4i16((LAS v4i16_t*)a0), __builtin_amdgcn_ds_read_tr16_b64_v4i16((LAS v4i16_t*)(a0 + 4 * RS)));
                    S[t] = __builtin_amdgcn_mfma_f32_16x16x32_bf16(kt, vsc, S[t], 0, 0, 0);
                }
            }
        }
#undef RET_TOK0
#undef RET_LOAD
    }
    __syncthreads();
}

__global__ void __launch_bounds__(512, 2) fwd_kernel(Params p) {
    extern __shared__ __attribute__((aligned(16))) unsigned char lds_raw[];
    LAS unsigned char* lds = (LAS unsigned char*)lds_raw;
    const int tid = threadIdx.x, G = gridDim.x, lo = p.ph_lo, hi = p.ph_hi;
    volatile LAS unsigned* xst = (volatile LAS unsigned*)(lds + LDS_CTL);
    if (tid < 4) xst[tid] = 0u;
    __syncthreads();
    XcdBarrier bar; bar.bar = (unsigned*)(p.ws + WS_CTL) + CW_BAR; bar.x = 0; bar.st = xst;
    const bool multi = (hi - lo) > 1;
    if (multi) bar = xcd_barrier_post((unsigned*)(p.ws + WS_CTL) + CW_BAR, xst);
#ifndef PHM
#define PHM 0xFFFFFFFFu
#endif
#define PM(q) ((PHM >> (q)) & 1u)
#define IN(k) (lo <= (k) && (k) < hi)
#ifndef TSEL
#define TSEL 0u
#endif
#ifndef TMULT
#define TMULT 10
#endif
    volatile LAS unsigned long long* tacc = (volatile LAS unsigned long long*)(lds + LDS_CTL + 32);
    if (TSEL && tid == 0) { tacc[0] = 0ull; tacc[1] = wall_clock64(); }
#define SEAMK(k, kind) do { if ((k) + 1 < hi) xcd_barrier(bar); if (TSEL && blockIdx.x == 0 && tid == 0) { const unsigned long long _n = wall_clock64(); if ((TSEL >> (kind)) & 1u) tacc[0] += _n - tacc[1]; tacc[1] = _n; } } while (0)
    unsigned char* big = p.ws + WS_BIG;
    const char* wmix = (const char*)(p.ws + WS_WMIX);

    if (PM(13) && IN(PH_PRO_A)) { adaln_phase(p, lds); rope_phase(p); __syncthreads(); convert_mixer_weights(p, lds, 0); SEAMK(PH_PRO_A, 13); }
    if (PM(14) && IN(PH_PRO_B)) { modulate0_phase(p); SEAMK(PH_PRO_B, 14); }

    for (int l = 0; l < DEPTH; ++l) {
        const int pb = PH_L0 + l * PH_PER_L;
        if (hi <= pb || lo >= pb + PH_PER_L) continue;
        const bool need_ctx = l < DEPTH - 1;
        const int Tact = need_ctx ? T : NLAT, nMact = Tact / 256;
        const float* modl = (const float*)(p.ws + WS_MOD) + (size_t)l * 17 * 6144;

        if (PM(0) && IN(pb + Q_IN)) {
            EpiIn E{(bf16_t*)big, (const float*)(p.ws + WS_ROPE)};
            if (need_ctx) { SchedRect S{(const char*)regA(p), wmix + WMIX_IN, T / 256, 14, G, (int)blockIdx.x, (size_t)256 * 1024 * 2}; gemm_phase(lds, 1024, S, E); }
            else { SchedIn3 S{(const char*)regA(p), wmix + WMIX_IN, G, (int)blockIdx.x, (size_t)256 * 1024 * 2}; gemm_phase(lds, 1024, S, E); }
            __syncthreads();
            {
              SchedRect S8{(const char*)regA8(p), wmix + WMIX_IN8, nMact, 8, G, (int)blockIdx.x, (size_t)256 * 1024};
              EpiSig8 E8{(bf16_t*)big}; gemm_phase(lds, 1024 / 2, S8, E8); }
            SEAMK(pb + Q_IN, 0);
        }
        if (PM(2) && IN(pb + Q_RET)) { pool_phase<false>(p, Tact); retention_phase(p, lds, l, need_ctx); SEAMK(pb + Q_RET, 2); }
        if (PM(3) && IN(pb + Q_COMB)) { combine_phase(p, Tact); pool_phase<true>(p, Tact); SEAMK(pb + Q_COMB, 3); }
        if (PM(4) && IN(pb + Q_MIX)) {
            { SchedRect S{(const char*)(big + B_U), wmix + WMIX_POOL, nMact, 4, G, (int)blockIdx.x, (size_t)256 * 512 * 2};
              EpiGate<0> E{(bf16_t*)(big + B_Y1), (const bf16_t*)(big + B_GP), nullptr}; gemm_phase(lds, 512, S, E); }
            __syncthreads();
            { SchedRect S{(const char*)(big + B_URET), wmix + WMIX_RET, nMact, 4, G, (int)blockIdx.x, (size_t)256 * 1024 * 2};
              EpiGate<1> E{(bf16_t*)(big + B_MIX), (const bf16_t*)(big + B_GR), (const bf16_t*)(big + B_Y1)}; gemm_phase(lds, 1024, S, E); }
            SEAMK(pb + Q_MIX, 4);
        }
        if (PM(5) && IN(pb + Q_OUT)) {
            SchedRect S{(const char*)(big + B_MIX), wmix + WMIX_OUT, nMact, 4, G, (int)blockIdx.x, (size_t)256 * 1024 * 2};
            const bool renorm = (l & 1) != 0;
            const float* lg = p.in[I_LNFG] + (size_t)(l > 0 ? l - 1 : 0) * 1024; const float* lb = p.in[I_LNFB] + (size_t)(l > 0 ? l - 1 : 0) * 1024;
            if (l == 0) { EpiRes<true, false> E{p.in[I_X], p.in[I_CTX], (bf16_t*)(p.ws + WS_A), modl, 2, nullptr, lg, lb}; gemm_phase(lds, 1024, S, E); }
            else if (renorm) { EpiRes<false, true> E{nullptr, nullptr, (bf16_t*)(p.ws + WS_A), modl, 2, (const float*)(p.ws + WS_ST2), lg, lb}; gemm_phase(lds, 1024, S, E); }
            else { EpiRes<false, false> E{nullptr, nullptr, (bf16_t*)(p.ws + WS_A), modl, 2, nullptr, lg, lb}; gemm_phase(lds, 1024, S, E); }
            SEAMK(pb + Q_OUT, 5);
        }
        if (PM(6) && IN(pb + Q_LN1)) {
            ln1_phase(p, lds, l, Tact);
            convert_ffn_weights(p, lds, l);
            if (l + 1 < DEPTH) convert_mixer_weights(p, lds, l + 1);
            SEAMK(pb + Q_LN1, 6);
        }
        if ((l & 1) == 0) {
            if (PM(7) && IN(pb + Q_F0)) {
                SchedRect S{(const char*)regA(p), (const char*)(big + F_W), nMact, 2 * DFF / 256, G, (int)blockIdx.x, (size_t)256 * 1024};
                EpiSwiglu8 E{big + F_ACT, DFF, 0}; gemm_phase(lds, 1024 / 2, S, E);
                SEAMK(pb + Q_F0, 7);
            }
            if (PM(8) && IN(pb + Q_F1)) {
                SchedRect S{(const char*)(big + F_ACT), (const char*)(big + F_DW2), nMact, 4, G, (int)blockIdx.x, (size_t)256 * DFF};
                EpiRes<false, true, true> E{nullptr, nullptr, (bf16_t*)(p.ws + WS_A), modl, 5, (const float*)(p.ws + WS_ST1), p.in[I_LNMG] + (size_t)l * 1024, p.in[I_LNMB] + (size_t)l * 1024};
                gemm_phase(lds, DFF / 2, S, E);
                SEAMK(pb + Q_F1, 8);
            }
        } else {
            if (PM(9) && IN(pb + Q_F0)) { moe_scatter_phase(p, lds, Tact); SEAMK(pb + Q_F0, 9); }
            const int* blke = (const int*)(p.ws + WS_BLKE);
            for (int g = 0; g < NGRP; ++g) {
                if (PM(10) && IN(pb + Q_F1 + 2 * g)) {
                    const int nb = min(blke[0], MAXRB), rb0 = g * RBG, nrb = min(RBG, nb - rb0);
                    if (nrb > 0) {
                        int w0, w1, w2; moe_bounds(blke, w0, w1, w2);
                        SchedMoe S{(const char*)(big + F_XS), (const char*)(big + F_W), w0, w1, w2, rb0, 0, nrb, 2 * EFF / 256, G, (int)blockIdx.x, (size_t)256 * 1024, F_EW13};
                        EpiSwiglu8 E{big + F_ACTM, EFF, rb0}; gemm_phase(lds, 1024 / 2, S, E);
                    }
                    SEAMK(pb + Q_F1 + 2 * g, 10);
                }
                if (PM(11) && IN(pb + Q_F1 + 2 * g + 1)) {
                    const int nb = min(blke[0], MAXRB), rb0 = g * RBG, nrb = min(RBG, nb - rb0);
                    if (nrb > 0) {
                        int w0, w1, w2; moe_bounds(blke, w0, w1, w2);
                        SchedMoe S{(const char*)(big + F_ACTM), (const char*)(big + F_W + (size_t)NEXP * F_EW13), w0, w1, w2, rb0, rb0, nrb, 4, G, (int)blockIdx.x, (size_t)256 * EFF, F_EW2};
                        EpiPlain8 E{(bf16_t*)(big + F_YK), 1.0f / W2_SCALE}; gemm_phase(lds, EFF / 2, S, E);
                    }
                    SEAMK(pb + Q_F1 + 2 * g + 1, 11);
                }
            }
        }
        if (PM(12) && IN(pb + Q_LN2)) { ln2_phase(p, lds, l, Tact); SEAMK(pb + Q_LN2, 12); }
    }
#undef IN
#undef SEAMK
    if (TSEL && blockIdx.x == 0 && tid == 0) { const unsigned long long t0 = wall_clock64(), w = tacc[0] * (unsigned long long)TMULT; while (wall_clock64() - t0 < w) __builtin_amdgcn_s_sleep(32); }
}

static bool phase_active(int ph) {
    if (ph < PH_L0) return true;
    const int l = (ph - PH_L0) / PH_PER_L, q = (ph - PH_L0) % PH_PER_L;
    if (q == Q_POOLV) return false;
    if (q <= Q_F0 || q == Q_LN2) return true;
    if (q >= Q_F1 && q < Q_LN2) { if ((l & 1) == 0) return q == Q_F1; return q < Q_F1 + 2 * NGRP; }
    return false;
}

extern "C" void kernel_launch(void* const* d_in, const int* in_sizes, int n_in, void* d_out, int out_size, void* d_ws, size_t ws_size, hipStream_t stream) {
    static int grid = 0;
    if (grid == 0) {
        if (n_in != 24 || out_size != NLAT * 1024 || ws_size < WS_END) { fprintf(stderr, "kernel_launch: unexpected shapes (n_in %d out %d ws %zu need %zu)\n", n_in, out_size, ws_size, (size_t)WS_END); grid = -1; return; }
        int dev = 0, cus = 0, per_cu = 0;
        if (hipGetDevice(&dev) != hipSuccess || hipDeviceGetAttribute(&cus, hipDeviceAttributeMultiprocessorCount, dev) != hipSuccess) { grid = -1; return; }
        if (hipFuncSetAttribute((const void*)fwd_kernel, hipFuncAttributeMaxDynamicSharedMemorySize, LDS_BYTES) != hipSuccess) { fprintf(stderr, "kernel_launch: hipFuncSetAttribute failed\n"); grid = -1; return; }
        if (hipOccupancyMaxActiveBlocksPerMultiprocessor(&per_cu, (const void*)fwd_kernel, 512, LDS_BYTES) != hipSuccess || per_cu < 1) { fprintf(stderr, "kernel_launch: occupancy query says %d\n", per_cu); (void)hipGetLastError(); per_cu = 1; }
        grid = cus < 256 ? cus : 256;
    }
    if (grid < 0) return;
    (void)hipMemsetAsync((char*)d_ws + WS_CTL, 0, CTL_BYTES, stream);
    Params p{};
    for (int i = 0; i < 24; ++i) p.in[i] = (const float*)d_in[i];
    p.out = (float*)d_out; p.ws = (unsigned char*)d_ws;
#if MK_MULTI
#ifndef MAXPH
#define MAXPH NPH
#endif
    for (int ph = 0; ph < MAXPH; ++ph) {
        if (!phase_active(ph)) continue;
        p.ph_lo = ph; p.ph_hi = ph + 1;
        hipLaunchKernelGGL(fwd_kernel, dim3(grid), dim3(512), LDS_BYTES, stream, p);
    }
#else
    p.ph_lo = 0; p.ph_hi = NPH;
    hipLaunchKernelGGL(fwd_kernel, dim3(grid), dim3(512), LDS_BYTES, stream, p);
#endif
}
```

```cpp
#include <hip/hip_runtime.h>
#include <stdint.h>
#include <cstdio>

#define MAXPH NPH
#ifndef MK_MULTI
#define MK_MULTI 0
#endif

#define DEVINL __device__ __forceinline__
#define LAS __attribute__((address_space(3)))
typedef unsigned short bf16_t;
typedef short bf16x8 __attribute__((ext_vector_type(8)));
typedef short v4i16_t __attribute__((ext_vector_type(4)));
typedef float f32x4 __attribute__((ext_vector_type(4)));
typedef unsigned u32x4 __attribute__((ext_vector_type(4)));
typedef unsigned u32x2 __attribute__((ext_vector_type(2)));

constexpr int D = 1024, BATCH = 16, SEQ = 4096, DEPTH = 4, CTXL = 256, GRIDW = 64;
constexpr int NLAT = BATCH * SEQ, NCTX = BATCH * CTXL, T = NLAT + NCTX;
constexpr int INW = 5632, DFF = 2816, NEXP = 8, EFF = 3584;
constexpr int MAXRB = 552;
constexpr int RBG = 552;
constexpr int NGRP = 1;
constexpr float ALPHA = 1.6817928305074290f;
constexpr float LN_EPS = 1e-5f;
constexpr float KSCALE = 0.08838834764831845f;

constexpr size_t AL(size_t x) { return (x + 255) & ~(size_t)255; }
constexpr size_t U = (size_t)T * 1024 * 2;
constexpr size_t WS_CTL = 0;
constexpr size_t CTL_BYTES = 65536;
constexpr size_t WS_MOD = WS_CTL + CTL_BYTES;
constexpr size_t WS_ROPE = AL(WS_MOD + (size_t)4 * 17 * 6144 * 4);
constexpr size_t WS_CTXS = AL(WS_ROPE + (size_t)4096 * 64 * 8);
constexpr size_t WS_TOKE = AL(WS_CTXS + (size_t)NCTX * 1024 * 4);
constexpr size_t WS_TOKW = AL(WS_TOKE + (size_t)T * 8);
constexpr size_t WS_TOKD = AL(WS_TOKW + (size_t)T * 8);
constexpr size_t WS_WGCNT = AL(WS_TOKD + (size_t)T * 8);
constexpr size_t WS_BLKE = AL(WS_WGCNT + 256 * 8 * 4);
constexpr size_t WS_ST1 = AL(WS_BLKE + (MAXRB + 8) * 4);
constexpr size_t WS_ST2 = AL(WS_ST1 + (size_t)T * 8);
constexpr size_t WS_WMIX = AL(WS_ST2 + (size_t)T * 8);
constexpr size_t WMIX_IN = 0, WMIX_POOL = (size_t)INW * 1024 * 2, WMIX_RET = WMIX_POOL + (size_t)1024 * 512 * 2, WMIX_OUT = WMIX_RET + (size_t)1024 * 1024 * 2, WMIX_IN8 = WMIX_OUT + (size_t)1024 * 1024 * 2, WMIX_BYTES = WMIX_IN8 + (size_t)2048 * 1024;
constexpr size_t WS_A = AL(WS_WMIX + WMIX_BYTES);
constexpr size_t WS_BIG = AL(WS_A + U);
constexpr size_t B_U = 0, B_Q = U / 2, B_K = U, B_V = U + U / 2, B_SG = 2 * U + U / 2, B_GP = 3 * U + U / 2, B_GR = 4 * U + U / 2, B_OF = 5 * U + U / 2, B_OB = 6 * U + U / 2, B_END = 7 * U + U / 2;
constexpr size_t B_URET = B_V, B_Y1 = B_Q, B_MIX = B_OF;
constexpr size_t F_W = 0;
constexpr size_t F_DW2 = (size_t)2 * DFF * 1024 * 2;
constexpr float W13_SCALE = 64.0f, W2_SCALE = 256.0f;
constexpr size_t F_EW13 = (size_t)2 * EFF * 1024, F_EW2 = (size_t)1024 * EFF, F_EALL = (size_t)NEXP * (F_EW13 + F_EW2);
constexpr size_t F_XS = AL(F_EALL);
constexpr size_t F_YK = AL(F_XS + (size_t)MAXRB * 256 * 1024);
constexpr size_t F_ACTM = AL(F_YK + (size_t)MAXRB * 256 * 1024 * 2);
constexpr size_t F_ACT = AL(F_DW2 + (size_t)1024 * DFF * 2);
constexpr size_t F_END_D = F_ACT + (size_t)T * DFF * 2, F_END_M = F_ACTM + (size_t)RBG * 256 * EFF;
constexpr size_t WS_END = WS_BIG + B_END;
static_assert(F_END_D <= B_END && F_END_M <= B_END, "FFN stage must fit in BIG");
static_assert(WS_END <= (size_t)1295298688, "workspace budget");

constexpr int CW_BAR = 0;
constexpr int CW_DBG = 4096;

constexpr int LDS_MAIN = 139264;
constexpr int LDS_TAB = LDS_MAIN;
constexpr int LDS_CTL = LDS_MAIN + 1024;
constexpr int LDS_BYTES = LDS_CTL + 256;

DEVINL float bf2f(unsigned b) { return __uint_as_float(b << 16); }
DEVINL float bflo(unsigned w) { return __uint_as_float(w << 16); }
DEVINL float bfhi(unsigned w) { return __uint_as_float(w & 0xffff0000u); }
typedef __bf16 bf16v2_t __attribute__((ext_vector_type(2)));
typedef float f32v2_t __attribute__((ext_vector_type(2)));
DEVINL unsigned pk2(float lo, float hi) { const f32v2_t v = {lo, hi}; return __builtin_bit_cast(unsigned, __builtin_convertvector(v, bf16v2_t)); }
DEVINL void unpk8(const u32x4 w, float (&v)[8]) { v[0] = bflo(w.x); v[1] = bfhi(w.x); v[2] = bflo(w.y); v[3] = bfhi(w.y); v[4] = bflo(w.z); v[5] = bfhi(w.z); v[6] = bflo(w.w); v[7] = bfhi(w.w); }
DEVINL u32x4 pk8(const float (&v)[8]) { u32x4 w; w.x = pk2(v[0], v[1]); w.y = pk2(v[2], v[3]); w.z = pk2(v[4], v[5]); w.w = pk2(v[6], v[7]); return w; }
typedef _Float16 f16v2_t __attribute__((ext_vector_type(2)));
DEVINL unsigned pk2h(float lo, float hi) { return __builtin_bit_cast(unsigned, __builtin_amdgcn_cvt_pkrtz(lo, hi)); }
DEVINL float h2f_bits(unsigned h) { const unsigned m = h & 0x7fffu; const unsigned f = ((h & 0x8000u) << 16) | ((m << 13) + 0x38000000u); return (m < 0x400u) ? 0.f : __uint_as_float(f); }
DEVINL float h2f_cvt(unsigned h) { float f; asm("v_cvt_f32_f16_e32 %0, %1" : "=v"(f) : "v"(h)); return f; }
DEVINL void unpk8h(const u32x4 w, float (&v)[8]) {
    v[0] = h2f_cvt(w.x); v[1] = h2f_cvt(w.x >> 16); v[2] = h2f_cvt(w.y); v[3] = h2f_cvt(w.y >> 16);
    v[4] = h2f_cvt(w.z); v[5] = h2f_cvt(w.z >> 16); v[6] = h2f_cvt(w.w); v[7] = h2f_cvt(w.w >> 16); }
DEVINL u32x4 pk8h(const float (&v)[8]) { u32x4 w; w.x = pk2h(v[0], v[1]); w.y = pk2h(v[2], v[3]); w.z = pk2h(v[4], v[5]); w.w = pk2h(v[6], v[7]); return w; }
DEVINL void ld8f(const float* p, float (&v)[8]) { const f32x4 a = *(const f32x4*)p, b = *(const f32x4*)(p + 4); v[0] = a[0]; v[1] = a[1]; v[2] = a[2]; v[3] = a[3]; v[4] = b[0]; v[5] = b[1]; v[6] = b[2]; v[7] = b[3]; }
DEVINL unsigned pk4_fp8(float a, float b, float c, float d) { int w = 0; w = __builtin_amdgcn_cvt_pk_fp8_f32(a, b, w, false); w = __builtin_amdgcn_cvt_pk_fp8_f32(c, d, w, true); return (unsigned)w; }
DEVINL bf16_t f2bf(float f) { return (bf16_t)(pk2(f, 0.f) & 0xffffu); }
DEVINL float sigmoidf_(float x) { return __builtin_amdgcn_rcpf(1.0f + __builtin_amdgcn_exp2f(-1.4426950408889634f * x)); }
DEVINL float siluf_(float x) { return x * __builtin_amdgcn_rcpf(1.0f + __builtin_amdgcn_exp2f(-1.4426950408889634f * x)); }
DEVINL f32x4 exp2_4(const f32x4 x) { f32x4 r; r[0] = __builtin_amdgcn_exp2f(x[0]); r[1] = __builtin_amdgcn_exp2f(x[1]); r[2] = __builtin_amdgcn_exp2f(x[2]); r[3] = __builtin_amdgcn_exp2f(x[3]); return r; }
DEVINL f32x4 rcp_4(const f32x4 x) { f32x4 r; r[0] = __builtin_amdgcn_rcpf(x[0]); r[1] = __builtin_amdgcn_rcpf(x[1]); r[2] = __builtin_amdgcn_rcpf(x[2]); r[3] = __builtin_amdgcn_rcpf(x[3]); return r; }
DEVINL void sigmoid8(f32x4& a0, f32x4& a1, const float nl2) {
    const f32x4 e0 = exp2_4(a0 * nl2), e1 = exp2_4(a1 * nl2);
    a0 = rcp_4(e0 + 1.0f); a1 = rcp_4(e1 + 1.0f);
}
DEVINL void swiglu8(f32x4& v0, f32x4& v1, const f32x4 a0, const f32x4 a1, const f32x4 b0, const f32x4 b1, const float nl2, const float s2) {
    const f32x4 e0 = exp2_4(a0 * nl2), e1 = exp2_4(a1 * nl2);
    const f32x4 p0 = a0 * b0, p1 = a1 * b1;
    const f32x4 r0 = rcp_4(e0 + 1.0f), r1 = rcp_4(e1 + 1.0f);
    v0 = p0 * (r0 * s2); v1 = p1 * (r1 * s2);
}
DEVINL int tid_hidden() { int t = threadIdx.x; asm volatile("" : "+v"(t)); return t; }
#define DPP_ADD(v, ctrl, rmask) v += __builtin_bit_cast(float, __builtin_amdgcn_update_dpp(0, __builtin_bit_cast(int, v), ctrl, rmask, 0xf, false))
DEVINL float wave_sum(float v) {
    DPP_ADD(v, 0xB1, 0xf);
    DPP_ADD(v, 0x4E, 0xf);
    DPP_ADD(v, 0x141, 0xf);
    DPP_ADD(v, 0x140, 0xf);
    DPP_ADD(v, 0x142, 0xa);
    DPP_ADD(v, 0x143, 0xc);
    return __builtin_bit_cast(float, __builtin_amdgcn_readlane(__builtin_bit_cast(int, v), 63));
}
DEVINL void wave_sum8(float (&v)[8], int lane) {
    float s1[4], s2[2];
#pragma unroll
    for (int e = 0; e < 4; ++e) { const auto r = __builtin_amdgcn_permlane32_swap(__float_as_uint(v[e]), __float_as_uint(v[e + 4]), false, false); s1[e] = __uint_as_float(r[0]) + __uint_as_float(r[1]); }
#pragma unroll
    for (int e = 0; e < 2; ++e) { const auto r = __builtin_amdgcn_permlane16_swap(__float_as_uint(s1[e]), __float_as_uint(s1[e + 2]), false, false); s2[e] = __uint_as_float(r[0]) + __uint_as_float(r[1]); }
    const bool hi8 = (lane & 8) != 0;
    const float tk = hi8 ? s2[1] : s2[0], ot = hi8 ? s2[0] : s2[1];
    float s3 = tk + __builtin_bit_cast(float, __builtin_amdgcn_update_dpp(0, __builtin_bit_cast(int, ot), 0x128, 0xf, 0xf, false));
    DPP_ADD(s3, 0x141, 0xf);
    DPP_ADD(s3, 0x4E, 0xf);
    DPP_ADD(s3, 0xB1, 0xf);
#pragma unroll
    for (int e = 0; e < 8; ++e) v[e] = __builtin_bit_cast(float, __builtin_amdgcn_readlane(__builtin_bit_cast(int, s3), 8 * e));
}

#define XB_TMO      128
#define XB_XCNT(j)  (256  + 64 * (j))
#define XB_XSUB(j)  (1280 + 64 * (j))
#define XB_XGEN(j)  (2304 + 64 * (j))
#define XB_TOP      3328
#define XB_TOPGEN   3392
#define XCD_BAR_WORDS 3456
#define XB_SPIN_CAP (1u << 20)
DEVINL unsigned xb_ld(unsigned* p)              { return __hip_atomic_load(p, __ATOMIC_RELAXED, __HIP_MEMORY_SCOPE_AGENT); }
DEVINL unsigned xb_add(unsigned* p, unsigned v) { return __hip_atomic_fetch_add(p, v, __ATOMIC_RELAXED, __HIP_MEMORY_SCOPE_AGENT); }
DEVINL unsigned xb_xcc_id() { return (unsigned)__builtin_amdgcn_s_getreg((3 << 11) | 20) & 0xFu; }
#define XB_SPIN(cond, bar) do { unsigned _sp = 0; while (cond) { __builtin_amdgcn_s_sleep(1); \
    if ((++_sp & 255u) == 0u) { if (xb_ld(&(bar)[XB_TMO])) break; if (_sp > XB_SPIN_CAP) { atomicAdd(&(bar)[XB_TMO], 1u); break; } } } } while (0)
struct XcdBarrier { unsigned* bar; unsigned x; volatile LAS unsigned* st; };
DEVINL XcdBarrier xcd_barrier_post(unsigned* bar, volatile LAS unsigned* st) {
    XcdBarrier b; b.bar = bar; b.x = xb_xcc_id(); b.st = st;
    if (threadIdx.x == 0) (void)xb_add(&bar[XB_XCNT(b.x)], 1u);
    return b;
}
DEVINL void xcd_barrier_complete(unsigned* bar, unsigned x, unsigned& nloc, unsigned& nx) {
    const unsigned G = gridDim.x * gridDim.y * gridDim.z;
    unsigned sum, cnt, mine, sp = 0u;
    for (;;) {
        sum = 0u; cnt = 0u; mine = 0u;
#pragma unroll
        for (unsigned j = 0; j < 16; ++j) { const unsigned c = xb_ld(&bar[XB_XCNT(j)]); sum += c; cnt += (c > 0u) ? 1u : 0u; mine = (j == x) ? c : mine; }
        if (sum == G) break;
        __builtin_amdgcn_s_sleep(1);
        if ((++sp & 255u) == 0u) { if (xb_ld(&bar[XB_TMO])) break; if (sp > XB_SPIN_CAP) { atomicAdd(&bar[XB_TMO], 1u); break; } }
    }
    nloc = mine > 0u ? mine : 1u; nx = cnt > 0u ? cnt : 1u;
}
DEVINL void xcd_barrier(const XcdBarrier& b) {
    asm volatile("s_waitcnt vmcnt(0)" ::: "memory");
    __syncthreads();
    if (threadIdx.x == 0) {
        unsigned* bar = b.bar;
        __builtin_amdgcn_s_waitcnt(0);
        unsigned nloc = b.st[0], nx = b.st[1];
        if (nloc == 0u) { xcd_barrier_complete(bar, b.x, nloc, nx); b.st[0] = nloc; b.st[1] = nx; }
        const unsigned old = xb_add(&bar[XB_XSUB(b.x)], 1u);
        const unsigned gen = old / nloc;
        if (old + 1u == (gen + 1u) * nloc) {
            __builtin_amdgcn_fence(__ATOMIC_RELEASE, "agent");
            asm volatile("s_waitcnt vmcnt(0)" ::: "memory");
            const unsigned og = xb_add(&bar[XB_TOP], 1u);
            const unsigned tg = og / nx;
            if (og + 1u == (tg + 1u) * nx) xb_add(&bar[XB_TOPGEN], 1u);
            else XB_SPIN(xb_ld(&bar[XB_TOPGEN]) == tg, bar);
            __builtin_amdgcn_fence(__ATOMIC_ACQUIRE, "agent");
            xb_add(&bar[XB_XGEN(b.x)], 1u);
            asm volatile("s_waitcnt vmcnt(0)" ::: "memory");
        } else {
            XB_SPIN(xb_ld(&bar[XB_XGEN(b.x)]) == gen, bar);
            __builtin_amdgcn_fence(__ATOMIC_ACQUIRE, "agent");
            asm volatile("s_waitcnt vmcnt(0)" ::: "memory");
        }
    }
    __syncthreads();
}

constexpr int BM = 256, BK = 64, HALF = 128, HTB = HALF * BK * 2, NXCD = 8, WGM = 8;
DEVINL int lds_byte(int r, int c) { const int st = (r >> 4) * 2 + (c >> 5), rr = r & 15, cc = c & 31, ob = rr * 64 + cc * 2; return st * 1024 + (ob ^ (((ob >> 9) & 1) << 5)); }
DEVINL void stage_rc(int b, int& R, int& C) { const int st = b / 1024, sb = b % 1024, swz = sb ^ (((sb >> 9) & 1) << 5); R = (st >> 1) * 16 + swz / 64; C = (st & 1) * 32 + (swz % 64) / 2; }
DEVINL int perm32(int rho) { const int n = rho >> 4, i = rho & 15; return 8 * (i >> 2) + 4 * n + (i & 3); }

struct Unit { int pm, pn; const char* a; const char* b; };

DEVINL bool rect_next(long L, int nM, int nN, int& pm, int& pn) {
    const int nwg = nM * nN; if (L >= nwg) return false;
    int wgid = (int)L; { const int q = nwg / NXCD, r = nwg % NXCD, xcd = wgid % NXCD, off = wgid / NXCD; wgid = (xcd < r ? xcd * (q + 1) : r * (q + 1) + (xcd - r) * q) + off; }
    const int nig = WGM * nN, gid = wgid / nig, fm = gid * WGM, gsz = (nM - fm) < WGM ? (nM - fm) : WGM;
    pm = fm + ((wgid % nig) % gsz); pn = (wgid % nig) / gsz; return true;
}
struct SchedRect {
    const char* A; const char* B; int nM, nN, G, c; size_t tstep;
    DEVINL bool next(int i, Unit& u) const { if (!rect_next((long)i * G + c, nM, nN, u.pm, u.pn)) return false; u.a = A + (size_t)u.pm * tstep; u.b = B + (size_t)u.pn * tstep; return true; }
};
struct SchedIn3 {
    const char* A; const char* B; int G, c; size_t tstep;
    DEVINL bool next(int i, Unit& u) const {
        const long L = (long)i * G + c;
        if (L < 256 * 14) { rect_next(L, 256, 14, u.pm, u.pn); }
        else { const long L2 = L - 256 * 14; if (L2 >= 16 * 6) return false; u.pm = 256 + (int)(L2 / 6); u.pn = 4 + (int)(L2 % 6); }
        u.a = A + (size_t)u.pm * tstep; u.b = B + (size_t)u.pn * tstep; return true; }
};
struct SchedMoe {
    const char* abase; const char* wbase; int eb0, eb1, eb2; int rb0, arb0, nrb, nN, G, c; size_t tstep, estride;
    DEVINL bool next(int i, Unit& u) const {
        int pm, pn; if (!rect_next((long)i * G + c, nrb, nN, pm, pn)) return false;
        u.pm = rb0 + pm; u.pn = pn;
        const int r = u.pm;
        const int e = (r >= (eb0 & 1023)) + (r >= ((eb0 >> 10) & 1023)) + (r >= ((eb0 >> 20) & 1023)) + (r >= (eb1 & 1023)) + (r >= ((eb1 >> 10) & 1023)) + (r >= ((eb1 >> 20) & 1023)) + (r >= (eb2 & 1023));
        u.a = abase + (size_t)(u.pm - arb0) * tstep; u.b = wbase + (size_t)e * estride + (size_t)pn * tstep; return true; }
};

DEVINL void moe_bounds(const int* blke, int& w0, int& w1, int& w2) {
    int b[7];
#pragma unroll
    for (int e = 0; e < 7; ++e) { int v = __builtin_amdgcn_readfirstlane(blke[1 + e]); v = v < 0 ? 0 : (v > 1023 ? 1023 : v); b[e] = v; }
    w0 = b[0] | (b[1] << 10) | (b[2] << 20); w1 = b[3] | (b[4] << 10) | (b[5] << 20); w2 = b[6];
}
typedef int v4i_t __attribute__((ext_vector_type(4)));
typedef int v8i_t __attribute__((ext_vector_type(8)));
DEVINL v8i_t cat_v8(bf16x8 lo, bf16x8 hi) { return __builtin_shufflevector(__builtin_bit_cast(v4i_t, lo), __builtin_bit_cast(v4i_t, hi), 0, 1, 2, 3, 4, 5, 6, 7); }
template <class Epi, class Sched>
DEVINL void gemm_phase(LAS unsigned char* lds, const int K, const Sched& S, const Epi& E) {
    int tid = threadIdx.x; asm volatile("" : "+v"(tid));
    const int wid = __builtin_amdgcn_readfirstlane(tid >> 6), lane = tid & 63, wr = wid >> 2, wc = wid & 3, fr = lane & 15, fq = lane >> 4;
    const int nt = K / BK;
    unsigned voffA, voffB;
    { int R, C; stage_rc(tid * 16, R, C); const int Rb = Epi::PERM ? ((R & ~31) + perm32(R & 31)) : R;
      voffA = (unsigned)(R * K + C) * 2u; voffB = (unsigned)(Rb * K + C) * 2u; }
    const size_t kstep = (size_t)(BK * 2);
    const size_t hstep = (size_t)HALF * K * 2;
    const size_t qstep = (size_t)64 * K * 2;
    const unsigned ldsw = (unsigned)wid * 1024u;
    const int aoff = lds_byte(wr * 64 + fr, fq * 8), boff = lds_byte(wc * 32 + fr, fq * 8);
#define PG8_SA(b, h) (((b) * 2 + (h)) * HTB)
#define PG8_SB(b, h) ((4 + (b) * 2 + (h)) * HTB)
#define PG8_STAGE(bufoff, gbase, voff) do { _Pragma("unroll") for (int _i = 0; _i < 2; ++_i) \
        __builtin_amdgcn_global_load_lds((const unsigned*)((const char*)(gbase) + _i * qstep + (voff)), (LAS unsigned*)(lds + (bufoff) + ldsw + _i * 8192), 16, 0, 0); } while (0)
#define PG8_LDA(dst, b, h) do { if constexpr (Epi::FP8) { _Pragma("unroll") for (int m = 0; m < 4; ++m) dst##8[m] = cat_v8(*(const LAS bf16x8*)(lds + PG8_SA(b, h) + aoff + m * 2048), *(const LAS bf16x8*)(lds + PG8_SA(b, h) + aoff + m * 2048 + 1024)); } \
        else { _Pragma("unroll") for (int m = 0; m < 4; ++m) _Pragma("unroll") for (int k = 0; k < 2; ++k) dst[m][k] = *(const LAS bf16x8*)(lds + PG8_SA(b, h) + aoff + m * 2048 + k * 1024); } } while (0)
#define PG8_LDB(dst, b, h) do { if constexpr (Epi::FP8) { _Pragma("unroll") for (int n = 0; n < 2; ++n) dst##8[n] = cat_v8(*(const LAS bf16x8*)(lds + PG8_SB(b, h) + boff + n * 2048), *(const LAS bf16x8*)(lds + PG8_SB(b, h) + boff + n * 2048 + 1024)); } \
        else { _Pragma("unroll") for (int n = 0; n < 2; ++n) _Pragma("unroll") for (int k = 0; k < 2; ++k) dst[n][k] = *(const LAS bf16x8*)(lds + PG8_SB(b, h) + boff + n * 2048 + k * 1024); } } while (0)
#define PG8_MMA(ai, bj, At, Bt) do { __builtin_amdgcn_s_setprio(1); \
        if constexpr (Epi::FP8) { _Pragma("unroll") for (int m = 0; m < 4; ++m) _Pragma("unroll") for (int n = 0; n < 2; ++n) \
            asm volatile("v_mfma_scale_f32_16x16x128_f8f6f4 %0, %1, %2, %0, %3, %3 op_sel_hi:[0,0,0]" : "+v"(acc[ai][bj][m][n]) : "v"(Bt##8[n]), "v"(At##8[m]), "v"(sc1)); } \
        else { _Pragma("unroll") for (int m = 0; m < 4; ++m) _Pragma("unroll") for (int n = 0; n < 2; ++n) _Pragma("unroll") for (int k = 0; k < 2; ++k) \
            acc[ai][bj][m][n] = __builtin_amdgcn_mfma_f32_16x16x32_bf16(Bt[n][k], At[m][k], acc[ai][bj][m][n], 0, 0, 0); } \
        __builtin_amdgcn_s_setprio(0); } while (0)
#define PG8_MFMA_DRAIN() do { if constexpr (Epi::FP8) { asm volatile("s_nop 15\n\ts_nop 15" : "+v"(acc[0][0][0][0]), "+v"(acc[0][0][0][1]), "+v"(acc[0][0][1][0]), "+v"(acc[0][0][1][1]), "+v"(acc[0][0][2][0]), "+v"(acc[0][0][2][1]), "+v"(acc[0][0][3][0]), "+v"(acc[0][0][3][1]), "+v"(acc[0][1][0][0]), "+v"(acc[0][1][0][1]), "+v"(acc[0][1][1][0]), "+v"(acc[0][1][1][1]), "+v"(acc[0][1][2][0]), "+v"(acc[0][1][2][1]), "+v"(acc[0][1][3][0]), "+v"(acc[0][1][3][1])); asm volatile("" : "+v"(acc[1][0][0][0]), "+v"(acc[1][0][0][1]), "+v"(acc[1][0][1][0]), "+v"(acc[1][0][1][1]), "+v"(acc[1][0][2][0]), "+v"(acc[1][0][2][1]), "+v"(acc[1][0][3][0]), "+v"(acc[1][0][3][1]), "+v"(acc[1][1][0][0]), "+v"(acc[1][1][0][1]), "+v"(acc[1][1][1][0]), "+v"(acc[1][1][1][1]), "+v"(acc[1][1][2][0]), "+v"(acc[1][1][2][1]), "+v"(acc[1][1][3][0]), "+v"(acc[1][1][3][1])); } } while (0)
#define PG8_WAIT_V(n) asm volatile("s_waitcnt vmcnt(" #n ")" ::: "memory")
#define PG8_WAIT_L(n) asm volatile("s_waitcnt lgkmcnt(" #n ")" ::: "memory")
#define PG8_WAIT_VN(n) asm volatile("s_waitcnt vmcnt(%0)" :: "n"(n) : "memory")
#define PG8_BAR __builtin_amdgcn_s_barrier()
#define PG8_SCHED __builtin_amdgcn_sched_barrier(0)
    Unit cur, nxt; int ui = 0;
    if (!S.next(0, cur)) return;
    f32x4 acc[2][2][4][2];
#pragma unroll
    for (int a = 0; a < 2; ++a)
#pragma unroll
        for (int b = 0; b < 2; ++b)
#pragma unroll
            for (int m = 0; m < 4; ++m)
#pragma unroll
                for (int n = 0; n < 2; ++n) acc[a][b][m][n] = (f32x4){0.f, 0.f, 0.f, 0.f};
    int sc1 = 0x7F7F7F7F; asm volatile("" : "+v"(sc1));
    bf16x8 At[4][2], B0[2][2], B1[2][2]; v8i_t At8[4], B08[2], B18[2];
    const char* cA = cur.a; const char* cB = cur.b;
    PG8_STAGE(PG8_SB(0, 0), cB, voffB); PG8_STAGE(PG8_SA(0, 0), cA, voffA); PG8_STAGE(PG8_SB(0, 1), cB + hstep, voffB); PG8_STAGE(PG8_SA(0, 1), cA + hstep, voffA);
    PG8_STAGE(PG8_SB(1, 0), cB + kstep, voffB); PG8_STAGE(PG8_SA(1, 0), cA + kstep, voffA); PG8_STAGE(PG8_SB(1, 1), cB + hstep + kstep, voffB);
    PG8_WAIT_V(6); PG8_BAR;
    if (wr == 1) PG8_BAR;
    for (;;) {
        const bool has_next = S.next(ui + 1, nxt);
        const char* nA = has_next ? nxt.a : cA; const char* nB = has_next ? nxt.b : cB;
        int epi_flag = (ui > 0) ? 1 : 0;
        for (int t = 0; t < nt; t += 2) {
            const bool last = (t == nt - 2);
            const char* a1 = cA + (size_t)(t + 1) * kstep;
            const char* a2 = last ? nA : cA + (size_t)(t + 2) * kstep; const char* b2 = last ? nB : cB + (size_t)(t + 2) * kstep;
            const char* a3 = a2 + kstep; const char* b3 = b2 + kstep;
            int after_epi = 0;
            if constexpr (Epi::FP8) { after_epi = __builtin_amdgcn_readfirstlane(epi_flag); asm volatile("" : "+s"(after_epi)); epi_flag = 0; }
            PG8_LDB(B0, 0, 0); PG8_LDB(B1, 0, 1); PG8_LDA(At, 0, 0); PG8_STAGE(PG8_SA(1, 1), a1 + hstep, voffA);
            if (Epi::FP8 && after_epi) PG8_WAIT_VN(8 + Epi::NST); else PG8_WAIT_V(8);
            PG8_WAIT_L(0); PG8_BAR; PG8_MMA(0, 0, At, B0); PG8_MMA(0, 1, At, B1); PG8_BAR; PG8_SCHED;
            PG8_LDA(At, 0, 1); PG8_STAGE(PG8_SB(0, 0), b2, voffB); PG8_STAGE(PG8_SB(0, 1), b2 + hstep, voffB); PG8_STAGE(PG8_SA(0, 0), a2, voffA);
            if (Epi::FP8 && after_epi) PG8_WAIT_VN(8 + Epi::NST); else PG8_WAIT_V(8);
            PG8_WAIT_L(0); PG8_BAR; PG8_MMA(1, 0, At, B0); PG8_MMA(1, 1, At, B1); PG8_BAR; PG8_SCHED;
            PG8_LDB(B0, 1, 0); PG8_LDB(B1, 1, 1); PG8_LDA(At, 1, 0); PG8_STAGE(PG8_SA(0, 1), a2 + hstep, voffA);
            PG8_WAIT_V(8); PG8_WAIT_L(0); PG8_BAR; PG8_MMA(0, 0, At, B0); PG8_MMA(0, 1, At, B1); PG8_BAR; PG8_SCHED;
            PG8_LDA(At, 1, 1); PG8_STAGE(PG8_SB(1, 0), b3, voffB); PG8_STAGE(PG8_SB(1, 1), b3 + hstep, voffB); PG8_STAGE(PG8_SA(1, 0), a3, voffA);
            PG8_WAIT_V(8); PG8_WAIT_L(0); PG8_BAR; PG8_MMA(1, 0, At, B0); PG8_MMA(1, 1, At, B1); PG8_BAR; PG8_SCHED;
        }
        PG8_MFMA_DRAIN();
        {
            int tz = threadIdx.x; asm volatile("" : "+v"(tz)); const int wz = __builtin_amdgcn_readfirstlane(tz >> 6), lz = tz & 63;
            E(acc, cur, wz >> 2, wz & 3, lz & 15, lz >> 4);
        }
        if (!has_next) break;
#pragma unroll
        for (int a = 0; a < 2; ++a)
#pragma unroll
            for (int b = 0; b < 2; ++b)
#pragma unroll
                for (int m = 0; m < 4; ++m)
#pragma unroll
                    for (int n = 0; n < 2; ++n) acc[a][b][m][n] = (f32x4){0.f, 0.f, 0.f, 0.f};
        cur = nxt; cA = nA; cB = nB; ++ui;
    }
    PG8_WAIT_V(0);
    if (wr == 0) PG8_BAR;
    PG8_BAR;
#undef PG8_SA
#undef PG8_SB
#undef PG8_STAGE
#undef PG8_LDA
#undef PG8_LDB
#undef PG8_MMA
#undef PG8_MFMA_DRAIN
#undef PG8_WAIT_V
#undef PG8_WAIT_L
#undef PG8_WAIT_VN
#undef PG8_BAR
#undef PG8_SCHED
}

typedef const f32x4 (&AccRef)[2][2][4][2];

struct EpiIn {
    static constexpr bool PERM = true, FP8 = false; static constexpr int NST = 16;
    bf16_t* big; const float* rope;
    template <int KIND> DEVINL void body(AccRef acc, bf16_t* dst, int ldc, int row0, int col0, bool lat, int wc, int fq) const {
        constexpr float ks = (KIND == 2) ? KSCALE : 1.0f;
        f32x4 csa[2][4], csb[2][4];
        if (KIND == 1 || KIND == 2) {
#pragma unroll
            for (int ai = 0; ai < 2; ++ai)
#pragma unroll
                for (int m = 0; m < 4; ++m) { const float* rp = rope + ((size_t)((row0 + ai * HALF + m * 16) & 4095) * 64 + wc * 16 + 4 * fq) * 2; csa[ai][m] = *(const f32x4*)rp; csb[ai][m] = *(const f32x4*)(rp + 4); }
            const f32x4 ident = (f32x4){1.f, 0.f, 1.f, 0.f};
#pragma unroll
            for (int ai = 0; ai < 2; ++ai)
#pragma unroll
                for (int m = 0; m < 4; ++m) { csa[ai][m] = lat ? csa[ai][m] : ident; csb[ai][m] = lat ? csb[ai][m] : ident; }
        }
#pragma unroll
        for (int ai = 0; ai < 2; ++ai)
#pragma unroll
            for (int m = 0; m < 4; ++m) {
                const unsigned ro = ((unsigned)(row0 + ai * HALF + m * 16) * (unsigned)ldc + (unsigned)col0) * 2u;
#pragma unroll
                for (int bj = 0; bj < 2; ++bj) {
                    f32x4 v0 = acc[ai][bj][m][0], v1 = acc[ai][bj][m][1];
                    if (KIND == 1 || KIND == 2) {
                        const f32x4 cs0 = csa[ai][m], cs1 = csb[ai][m];
                        f32x4 r0, r1;
                        r0[0] = (v0[0] * cs0[0] - v0[1] * cs0[1]) * ks; r0[1] = (v0[0] * cs0[1] + v0[1] * cs0[0]) * ks;
                        r0[2] = (v0[2] * cs0[2] - v0[3] * cs0[3]) * ks; r0[3] = (v0[2] * cs0[3] + v0[3] * cs0[2]) * ks;
                        r1[0] = (v1[0] * cs1[0] - v1[1] * cs1[1]) * ks; r1[1] = (v1[0] * cs1[1] + v1[1] * cs1[0]) * ks;
                        r1[2] = (v1[2] * cs1[2] - v1[3] * cs1[3]) * ks; r1[3] = (v1[2] * cs1[3] + v1[3] * cs1[2]) * ks;
                        v0 = r0; v1 = r1;
                    } else if (KIND == 3) {
                        f32x4 g0 = v0, g1 = v1; sigmoid8(g0, g1, -1.4426950408889634f); v0 *= g0; v1 *= g1;
                    } else if (KIND == 4) {
                        sigmoid8(v0, v1, -1.4426950408889634f);
                    }
                    u32x4 w; w.x = pk2(v0[0], v0[1]); w.y = pk2(v0[2], v0[3]); w.z = pk2(v1[0], v1[1]); w.w = pk2(v1[2], v1[3]);
                    *(u32x4*)((char*)dst + ro + (unsigned)(bj * HALF * 2)) = w;
                }
                asm volatile("" ::: "memory");
            }
    }
    DEVINL void operator()(AccRef acc, const Unit& u, int wr, int wc, int fr, int fq) const {
        const int pn = u.pn; bf16_t* dst; int ldc, colt, kind;
        if (pn < 2)       { dst = (bf16_t*)((char*)big + B_U);  ldc = 512;  colt = pn * 256;        kind = 0; }
        else if (pn < 4)  { dst = (bf16_t*)((char*)big + B_Q);  ldc = 512;  colt = (pn - 2) * 256;  kind = 1; }
        else if (pn < 6)  { dst = (bf16_t*)((char*)big + B_K);  ldc = 512;  colt = (pn - 4) * 256;  kind = 2; }
        else if (pn < 10) { dst = (bf16_t*)((char*)big + B_V);  ldc = 1024; colt = (pn - 6) * 256;  kind = 0; }
        else if (pn < 14) { dst = (bf16_t*)((char*)big + B_SG); ldc = 1024; colt = (pn - 10) * 256; kind = 3; }
        else if (pn < 18) { dst = (bf16_t*)((char*)big + B_GP); ldc = 1024; colt = (pn - 14) * 256; kind = 4; }
        else              { dst = (bf16_t*)((char*)big + B_GR); ldc = 1024; colt = (pn - 18) * 256; kind = 4; }
        const int row0 = u.pm * BM + wr * 64 + fr, col0 = colt + wc * 32 + 8 * fq;
        const bool lat = u.pm < 256;
        if (kind == 0) body<0>(acc, dst, ldc, row0, col0, lat, wc, fq);
        else if (kind == 1) body<1>(acc, dst, ldc, row0, col0, lat, wc, fq);
        else if (kind == 2) body<2>(acc, dst, ldc, row0, col0, lat, wc, fq);
        else if (kind == 3) body<3>(acc, dst, ldc, row0, col0, lat, wc, fq);
        else body<4>(acc, dst, ldc, row0, col0, lat, wc, fq);
    }
};

template <int MODE  > struct EpiGate {
    static constexpr bool PERM = true, FP8 = false; static constexpr int NST = 16;
    bf16_t* out; const bf16_t* gate; const bf16_t* y1;
    DEVINL void operator()(AccRef acc, const Unit& u, int wr, int wc, int fr, int fq) const {
        const int row0 = u.pm * BM + wr * 64 + fr, col0 = u.pn * BM + wc * 32 + 8 * fq;
#pragma unroll
        for (int ai = 0; ai < 2; ++ai) {
            u32x4 g[4][2], y[4][2];
#pragma unroll
            for (int m = 0; m < 4; ++m)
#pragma unroll
                for (int bj = 0; bj < 2; ++bj) {
                    const size_t off = (size_t)(row0 + ai * HALF + m * 16) * 1024 + col0 + bj * HALF;
                    if (MODE != 2) g[m][bj] = *(const u32x4*)(gate + off);
                    if (MODE == 1) y[m][bj] = *(const u32x4*)(y1 + off);
                }
#pragma unroll
            for (int m = 0; m < 4; ++m)
#pragma unroll
                for (int bj = 0; bj < 2; ++bj) {
                    const size_t off = (size_t)(row0 + ai * HALF + m * 16) * 1024 + col0 + bj * HALF;
                    f32x4 v0 = acc[ai][bj][m][0], v1 = acc[ai][bj][m][1];
                    if (MODE != 2) {
                        const u32x4 gg = g[m][bj];
                        v0[0] *= bflo(gg.x); v0[1] *= bfhi(gg.x); v0[2] *= bflo(gg.y); v0[3] *= bfhi(gg.y);
                        v1[0] *= bflo(gg.z); v1[1] *= bfhi(gg.z); v1[2] *= bflo(gg.w); v1[3] *= bfhi(gg.w);
                    }
                    if (MODE == 1) {
                        const u32x4 yy = y[m][bj];
                        v0[0] += bflo(yy.x); v0[1] += bfhi(yy.x); v0[2] += bflo(yy.y); v0[3] += bfhi(yy.y);
                        v1[0] += bflo(yy.z); v1[1] += bfhi(yy.z); v1[2] += bflo(yy.w); v1[3] += bfhi(yy.w);
                    }
                    u32x4 w; w.x = pk2(v0[0], v0[1]); w.y = pk2(v0[2], v0[3]); w.z = pk2(v1[0], v1[1]); w.w = pk2(v1[2], v1[3]);
                    *(u32x4*)(out + off) = w;
                }
            asm volatile("" ::: "memory");
        }
    }
};

template <bool X0, bool ST, bool F8 = false>
struct EpiRes {
    static constexpr bool PERM = true, FP8 = F8;
     static constexpr int NST = 16;
    const float* x0_lat; const float* x0_ctx; bf16_t* strm; const float* modl; int which;
    const float* st; const float* gam; const float* bet;
    DEVINL void operator()(AccRef acc, const Unit& u, int wr, int wc, int fr, int fq) const {
        const bool lat = u.pm < 256;
        const float* mv = modl + ((size_t)(lat ? (u.pm >> 4) : 16) * 6 + which) * 1024;
        const int row0 = u.pm * BM + wr * 64 + fr, col0 = u.pn * BM + wc * 32 + 8 * fq;
        const char* x0 = nullptr; if (X0) x0 = (const char*)(lat ? x0_lat : x0_ctx - (size_t)NLAT * 1024);
        const unsigned so0 = ((unsigned)row0 * 1024u + (unsigned)col0) * 2u;
#pragma unroll
        for (int bj = 0; bj < 2; ++bj) {
            const int col = col0 + bj * HALF;
            float bv[8], gv[8], ev[8];
            ld8f(mv + col, bv); if (ST) { ld8f(gam + col, gv); ld8f(bet + col, ev); }
            f32v2_t bv2[4], G2[4], E2[4];
#pragma unroll
            for (int k = 0; k < 4; ++k) { bv2[k] = (f32v2_t){bv[2 * k], bv[2 * k + 1]}; if (F8) bv2[k] *= (1.0f / W2_SCALE);
                if (ST) { G2[k] = (f32v2_t){gv[2 * k], gv[2 * k + 1]} * ALPHA; E2[k] = (f32v2_t){ev[2 * k], ev[2 * k + 1]} * ALPHA; } }
            constexpr int NA = (X0 || F8) ? 1 : 2;
#pragma unroll
            for (int ab = 0; ab < 2; ab += NA) {
                u32x4 xr[NA][4]; f32x4 xa[NA][4], xb[NA][4]; float mean[NA][4], rstd[NA][4];
#pragma unroll
                for (int a = 0; a < NA; ++a)
#pragma unroll
                    for (int m = 0; m < 4; ++m) {
                        const unsigned rr = (unsigned)((ab + a) * HALF + m * 16);
                        const unsigned so = so0 + rr * 2048u + (unsigned)(bj * HALF * 2);
                        if (ST) { const float2 s2 = *(const float2*)((const char*)st + ((unsigned)row0 + rr) * 8u); mean[a][m] = s2.x; rstd[a][m] = s2.y; }
                        if (X0) { const char* xp = x0 + so * 2u; xa[a][m] = *(const f32x4*)xp; xb[a][m] = *(const f32x4*)(xp + 16); }
                        else xr[a][m] = *(const u32x4*)((const char*)strm + so);
                    }
#pragma unroll
                for (int a = 0; a < NA; ++a)
#pragma unroll
                    for (int m = 0; m < 4; ++m) {
                        const int ai = ab + a;
                        const unsigned so = so0 + (unsigned)(ai * HALF + m * 16) * 2048u + (unsigned)(bj * HALF * 2);
                        float xv[8];
                        if (X0) { const f32x4 p0 = xa[a][m], p1 = xb[a][m]; xv[0] = p0[0]; xv[1] = p0[1]; xv[2] = p0[2]; xv[3] = p0[3]; xv[4] = p1[0]; xv[5] = p1[1]; xv[6] = p1[2]; xv[7] = p1[3]; }
                        else unpk8h(xr[a][m], xv);
                        const f32x4 a0 = acc[ai][bj][m][0], a1 = acc[ai][bj][m][1];
                        float zv[8]; float ra = 1.0f, rb = 0.0f; if (ST) { ra = rstd[a][m]; rb = -mean[a][m] * ra; }
#pragma unroll
                        for (int k = 0; k < 4; ++k) {
                            const f32v2_t x2 = (f32v2_t){xv[2 * k], xv[2 * k + 1]};
                            const f32v2_t c2 = (k < 2) ? (f32v2_t){a0[(2 * k) & 3], a0[(2 * k + 1) & 3]} : (f32v2_t){a1[(2 * k) & 3], a1[(2 * k + 1) & 3]};
                            f32v2_t z;
                            if (ST) { const f32v2_t xn = x2 * ra + rb; z = xn * G2[k] + (bv2[k] * c2 + E2[k]); }
                            else z = x2 * ALPHA + bv2[k] * c2;
                            zv[2 * k] = z.x; zv[2 * k + 1] = z.y;
                        }
                        *(u32x4*)((char*)strm + so) = pk8h(zv);
                    }
                asm volatile("" ::: "memory");
            }
        }
    }
};

struct EpiSig8 {
    static constexpr bool PERM = true, FP8 = true; static constexpr int NST = 16;
    bf16_t* big;
    DEVINL void operator()(AccRef acc, const Unit& u, int wr, int wc, int fr, int fq) const {
        bf16_t* dst = (bf16_t*)((char*)big + (u.pn < 4 ? B_GP : B_GR));
        const int row0 = u.pm * BM + wr * 64 + fr, col0 = (u.pn & 3) * 256 + wc * 32 + 8 * fq;
        constexpr float s = 1.0f / W13_SCALE;
#pragma unroll
        for (int ai = 0; ai < 2; ++ai)
#pragma unroll
            for (int m = 0; m < 4; ++m) {
                bf16_t* rowp = dst + (size_t)(row0 + ai * HALF + m * 16) * 1024 + col0;
#pragma unroll
                for (int bj = 0; bj < 2; ++bj) { f32x4 v0 = acc[ai][bj][m][0], v1 = acc[ai][bj][m][1];
                    sigmoid8(v0, v1, -1.4426950408889634f * s);
                    u32x4 w; w.x = pk2(v0[0], v0[1]); w.y = pk2(v0[2], v0[3]); w.z = pk2(v1[0], v1[1]); w.w = pk2(v1[2], v1[3]);
                    *(u32x4*)(rowp + bj * HALF) = w; }
            }
    }
};
struct EpiSwiglu8 {
    static constexpr bool PERM = true, FP8 = true; static constexpr int NST = 8;
    unsigned char* act; int ldc; int rb0;
    DEVINL void operator()(AccRef acc, const Unit& u, int wr, int wc, int fr, int fq) const {
        const int row0 = (u.pm - rb0) * BM + wr * 64 + fr, col0 = u.pn * HALF + wc * 32 + 8 * fq;
        constexpr float s = 1.0f / W13_SCALE;
#pragma unroll
        for (int ai = 0; ai < 2; ++ai)
#pragma unroll
            for (int m = 0; m < 4; ++m) {
                f32x4 v0, v1; swiglu8(v0, v1, acc[ai][0][m][0], acc[ai][0][m][1], acc[ai][1][m][0], acc[ai][1][m][1], -1.4426950408889634f * s, s * s);
                u32x2 w; w.x = pk4_fp8(v0[0], v0[1], v0[2], v0[3]); w.y = pk4_fp8(v1[0], v1[1], v1[2], v1[3]);
                *(u32x2*)(act + (size_t)(row0 + ai * HALF + m * 16) * ldc + col0) = w;
            }
    }
};
struct EpiPlain8 {
    static constexpr bool PERM = true, FP8 = true; static constexpr int NST = 16;
    bf16_t* out; float scale;
    DEVINL void operator()(AccRef acc, const Unit& u, int wr, int wc, int fr, int fq) const {
        const int row0 = u.pm * BM + wr * 64 + fr, col0 = u.pn * BM + wc * 32 + 8 * fq;
#pragma unroll
        for (int ai = 0; ai < 2; ++ai)
#pragma unroll
            for (int m = 0; m < 4; ++m) {
                const size_t off = (size_t)(row0 + ai * HALF + m * 16) * 1024 + col0;
#pragma unroll
                for (int bj = 0; bj < 2; ++bj) { const f32x4 v0 = acc[ai][bj][m][0] * scale, v1 = acc[ai][bj][m][1] * scale;
                    u32x4 w; w.x = pk2(v0[0], v0[1]); w.y = pk2(v0[2], v0[3]); w.z = pk2(v1[0], v1[1]); w.w = pk2(v1[2], v1[3]);
                    *(u32x4*)(out + off + bj * HALF) = w; }
            }
    }
};
struct EpiSwiglu8b {
    static constexpr bool PERM = true, FP8 = true; static constexpr int NST = 8;
    bf16_t* act; int ldc;
    DEVINL void operator()(AccRef acc, const Unit& u, int wr, int wc, int fr, int fq) const {
        const int row0 = u.pm * BM + wr * 64 + fr, col0 = u.pn * HALF + wc * 32 + 8 * fq;
        constexpr float s = 1.0f / W13_SCALE;
#pragma unroll
        for (int ai = 0; ai < 2; ++ai)
#pragma unroll
            for (int m = 0; m < 4; ++m) {
                f32x4 v0, v1; swiglu8(v0, v1, acc[ai][0][m][0], acc[ai][0][m][1], acc[ai][1][m][0], acc[ai][1][m][1], -1.4426950408889634f * s, s * s);
                u32x4 w; w.x = pk2(v0[0], v0[1]); w.y = pk2(v0[2], v0[3]); w.z = pk2(v1[0], v1[1]); w.w = pk2(v1[2], v1[3]);
                *(u32x4*)(act + (size_t)(row0 + ai * HALF + m * 16) * ldc + col0) = w;
            }
    }
};

struct Params { const float* in[24]; float* out; unsigned char* ws; int ph_lo, ph_hi; };
enum { I_X = 0, I_C, I_CTX, I_CCTX, I_ADAW, I_ADAB, I_WIN, I_POOLW, I_POOLS, I_WPOOLOUT, I_WRETOUT, I_DECAY, I_WOUT, I_LNMG, I_LNMB, I_LNFG, I_LNFB, I_FW1, I_FW3, I_FW2, I_ROUTER, I_MW1, I_MW3, I_MW2 };

constexpr int PH_PRO_A = 0, PH_PRO_B = 1, PH_L0 = 2, PH_PER_L = 20, NPH = PH_L0 + DEPTH * PH_PER_L;
enum { Q_IN = 0, Q_POOLV, Q_RET, Q_COMB, Q_MIX, Q_OUT, Q_LN1, Q_F0, Q_F1  , Q_LN2 = 18 };

template <class RowMap>
DEVINL void cvt_T(LAS float* tl, const float* __restrict__ src, int K, int N, bf16_t* __restrict__ dst, RowMap rm, int rot) {
    const int tid = tid_hidden(), G = gridDim.x;
    const int tn = N / 128, ntile = (K / 128) * tn;
    const int r = tid >> 5, c4 = (tid & 31) * 4;
    const int nl = tid & 127, kq = tid >> 7;
    f32x4 v[8];
    int tile = (blockIdx.x + rot) % G;
    if (tile < ntile) { const int k0 = (tile / tn) * 128, n0 = (tile % tn) * 128;
#pragma unroll
        for (int q = 0; q < 8; ++q) v[q] = *(const f32x4*)(src + (size_t)(k0 + r + 16 * q) * N + n0 + c4); }
    for (; tile < ntile; tile += G) {
        const int k0 = (tile / tn) * 128, n0 = (tile % tn) * 128;
#pragma unroll
        for (int q = 0; q < 8; ++q) *(LAS f32x4*)(tl + (r + 16 * q) * 132 + c4) = v[q];
        __syncthreads();
        const int nt2 = tile + G;
        if (nt2 < ntile) { const int k2 = (nt2 / tn) * 128, n2 = (nt2 % tn) * 128;
#pragma unroll
            for (int q = 0; q < 8; ++q) v[q] = *(const f32x4*)(src + (size_t)(k2 + r + 16 * q) * N + n2 + c4); }
        bf16_t* drow = dst + (size_t)rm(n0 + nl) * K + k0 + kq * 32;
#pragma unroll
        for (int h = 0; h < 4; ++h) { float e[8];
#pragma unroll
            for (int j = 0; j < 8; ++j) e[j] = tl[(kq * 32 + h * 8 + j) * 132 + nl];
            u32x4 w; w.x = pk2(e[0], e[1]); w.y = pk2(e[2], e[3]); w.z = pk2(e[4], e[5]); w.w = pk2(e[6], e[7]);
            *(u32x4*)(drow + h * 8) = w; }
        __syncthreads();
    }
}
template <class RowMap>
DEVINL void cvt_T8(LAS float* tl, const float* __restrict__ src, int K, int N, unsigned char* __restrict__ dst, RowMap rm, int rot, float scale, int ld = 0) {
    if (ld == 0) ld = N;
    const int tid = tid_hidden(), G = gridDim.x;
    const int tn = N / 128, ntile = (K / 128) * tn;
    const int r = tid >> 5, c4 = (tid & 31) * 4;
    const int nl = tid & 127, kq = tid >> 7;
    f32x4 v[8];
    int tile = (blockIdx.x + rot) % G;
    if (tile < ntile) { const int k0 = (tile / tn) * 128, n0 = (tile % tn) * 128;
#pragma unroll
        for (int q = 0; q < 8; ++q) v[q] = *(const f32x4*)(src + (size_t)(k0 + r + 16 * q) * ld + n0 + c4); }
    for (; tile < ntile; tile += G) {
        const int k0 = (tile / tn) * 128, n0 = (tile % tn) * 128;
#pragma unroll
        for (int q = 0; q < 8; ++q) *(LAS f32x4*)(tl + (r + 16 * q) * 132 + c4) = v[q] * scale;
        __syncthreads();
        const int nt2 = tile + G;
        if (nt2 < ntile) { const int k2 = (nt2 / tn) * 128, n2 = (nt2 % tn) * 128;
#pragma unroll
            for (int q = 0; q < 8; ++q) v[q] = *(const f32x4*)(src + (size_t)(k2 + r + 16 * q) * ld + n2 + c4); }
        unsigned char* drow = dst + (size_t)rm(n0 + nl) * K + k0 + kq * 32;
#pragma unroll
        for (int h = 0; h < 2; ++h) { float e[16];
#pragma unroll
            for (int j = 0; j < 16; ++j) e[j] = tl[(kq * 32 + h * 16 + j) * 132 + nl];
            u32x4 w; w.x = pk4_fp8(e[0], e[1], e[2], e[3]); w.y = pk4_fp8(e[4], e[5], e[6], e[7]); w.z = pk4_fp8(e[8], e[9], e[10], e[11]); w.w = pk4_fp8(e[12], e[13], e[14], e[15]);
            *(u32x4*)(drow + h * 16) = w; }
        __syncthreads();
    }
}
struct MapId { DEVINL int operator()(int n) const { return n; } };
struct MapIn { DEVINL int operator()(int n) const { if (n < 512 || n >= 1536) return n; const int j = (n - 512) & 127, base = n - j; return base + (j < 64 ? 2 * j : 2 * (j - 64) + 1); } };
struct MapGU { int off; DEVINL int operator()(int n) const { return (n >> 7) * 256 + (n & 127) + off; } };

DEVINL void convert_mixer_weights(const Params& p, LAS unsigned char* lds, int l) {
    LAS float* tl = (LAS float*)lds;
    unsigned char* wm = p.ws + WS_WMIX;
    cvt_T(tl, p.in[I_WIN] + (size_t)l * 1024 * INW, 1024, INW, (bf16_t*)(wm + WMIX_IN), MapIn(), 0);
    cvt_T(tl, p.in[I_WRETOUT] + (size_t)l * 1024 * 1024, 1024, 1024, (bf16_t*)(wm + WMIX_RET), MapId(), 128);
    cvt_T(tl, p.in[I_WOUT] + (size_t)l * 1024 * 1024, 1024, 1024, (bf16_t*)(wm + WMIX_OUT), MapId(), 0);
    cvt_T8(tl, p.in[I_WIN] + (size_t)l * 1024 * INW + 3584, 1024, 2048, wm + WMIX_IN8, MapId(), 96, W13_SCALE, INW);
    const int tid = tid_hidden(), G = gridDim.x;
    LAS float* sW = (LAS float*)lds;
    LAS float* sP = (LAS float*)(lds + 32768);
    const float* pw = p.in[I_POOLW] + (size_t)l * 4 * 128 * 128; const float* ps = p.in[I_POOLS] + (size_t)l * 512; const float* wo = p.in[I_WPOOLOUT] + (size_t)l * 512 * 1024;
    bf16_t* dst = (bf16_t*)(wm + WMIX_POOL);
    for (int item = (blockIdx.x + 64) % G; item < 64; item += G) {
        const int g = item >> 4, n0 = (item & 15) * 64;
        __syncthreads();
        for (int i = tid; i < 128 * 64; i += 512) { const int d = i >> 6, n = i & 63; sW[i] = ps[g * 128 + d] * wo[(size_t)(g * 128 + d) * 1024 + n0 + n]; }
        for (int i = tid; i < 128 * 128; i += 512) { const int c = i >> 7, d = i & 127; sP[c * 129 + d] = pw[(size_t)g * 16384 + i]; }
        __syncthreads();
        const int n = tid & 63, cq = tid >> 6;
        float a[16];
#pragma unroll
        for (int j = 0; j < 16; ++j) a[j] = 0.f;
        for (int d = 0; d < 128; ++d) { const float w = sW[d * 64 + n];
#pragma unroll
            for (int j = 0; j < 16; ++j) a[j] += sP[(cq * 16 + j) * 129 + d] * w; }
        u32x4 w0, w1; w0.x = pk2(a[0], a[1]); w0.y = pk2(a[2], a[3]); w0.z = pk2(a[4], a[5]); w0.w = pk2(a[6], a[7]);
        w1.x = pk2(a[8], a[9]); w1.y = pk2(a[10], a[11]); w1.z = pk2(a[12], a[13]); w1.w = pk2(a[14], a[15]);
        bf16_t* o = dst + (size_t)(n0 + n) * 512 + g * 128 + cq * 16;
        *(u32x4*)o = w0; *(u32x4*)(o + 8) = w1;
    }
    __syncthreads();
}
DEVINL void convert_ffn_weights(const Params& p, LAS unsigned char* lds, int l) {
    LAS float* tl = (LAS float*)lds;
    unsigned char* fw = p.ws + WS_BIG + F_W;
    const int li = l >> 1;
    if ((l & 1) == 0) {
        cvt_T8(tl, p.in[I_FW1] + (size_t)li * 1024 * DFF, 1024, DFF, fw, MapGU{0}, 0, W13_SCALE);
        cvt_T8(tl, p.in[I_FW3] + (size_t)li * 1024 * DFF, 1024, DFF, fw, MapGU{128}, 64, W13_SCALE);
        cvt_T8(tl, p.in[I_FW2] + (size_t)li * DFF * 1024, DFF, 1024, fw + F_DW2, MapId(), 128, W2_SCALE);
    } else {
        for (int e = 0; e < NEXP; ++e) {
            const size_t so = ((size_t)li * NEXP + e) * 1024 * EFF;
            cvt_T8(tl, p.in[I_MW1] + so, 1024, EFF, fw + (size_t)e * F_EW13, MapGU{0}, e * 32, W13_SCALE);
            cvt_T8(tl, p.in[I_MW3] + so, 1024, EFF, fw + (size_t)e * F_EW13, MapGU{128}, e * 32 + 16, W13_SCALE);
            cvt_T8(tl, p.in[I_MW2] + so, EFF, 1024, fw + (size_t)NEXP * F_EW13 + (size_t)e * F_EW2, MapId(), e * 32 + 8, W2_SCALE);
        }
    }
}

DEVINL void adaln_phase(const Params& p, LAS unsigned char* lds) {
    const int tid = tid_hidden(), G = gridDim.x;
    LAS float* s = (LAS float*)lds;
    LAS float* red = (LAS float*)(lds + 17 * 1024 * 4);
    for (int i = tid; i < 17 * 1024; i += 512) { const float v = i < 16 * 1024 ? p.in[I_C][i] : p.in[I_CCTX][i - 16 * 1024]; s[i] = v / (1.0f + __expf(-v)); }
    __syncthreads();
    float* mod = (float*)(p.ws + WS_MOD);
    for (int item = blockIdx.x; item < 4 * 96; item += G) {
        const int l = item / 96, n = (item % 96) * 64 + (tid & 63), kq = tid >> 6;
        const float* w = p.in[I_ADAW] + (size_t)l * 1024 * 6144 + n;
        float a[17];
#pragma unroll
        for (int r = 0; r < 17; ++r) a[r] = 0.f;
#pragma unroll 4
        for (int k = kq * 128; k < kq * 128 + 128; k += 4) { const float w0 = w[(size_t)k * 6144], w1 = w[(size_t)(k + 1) * 6144], w2 = w[(size_t)(k + 2) * 6144], w3 = w[(size_t)(k + 3) * 6144];
#pragma unroll
            for (int r = 0; r < 17; ++r) { const f32x4 sv = *(const LAS f32x4*)(s + r * 1024 + k); a[r] += sv[0] * w0 + sv[1] * w1 + sv[2] * w2 + sv[3] * w3; } }
#pragma unroll
        for (int r = 0; r < 17; ++r) red[(kq * 17 + r) * 64 + (tid & 63)] = a[r];
        __syncthreads();
        for (int i = tid; i < 17 * 64; i += 512) { const int r = i >> 6, c = i & 63; float v = 0.f;
#pragma unroll
            for (int q = 0; q < 8; ++q) v += red[(q * 17 + r) * 64 + c];
            const int nn = (item % 96) * 64 + c; mod[((size_t)l * 17 + r) * 6144 + nn] = v + p.in[I_ADAB][(size_t)l * 6144 + nn]; }
        __syncthreads();
    }
}
DEVINL void rope_phase(const Params& p) {
    float* tab = (float*)(p.ws + WS_ROPE);
    for (int i = blockIdx.x * 512 + tid_hidden(); i < 4096 * 64; i += gridDim.x * 512) {
        const int pos = i >> 6, f = i & 63;
        const float inv = expf(-logf(10000.0f) * (float)(f & 31) / 32.0f);
        const float ang = (float)(f < 32 ? (pos >> 6) : (pos & 63)) * inv;
        float sn, cs; sincosf(ang, &sn, &cs);
        tab[2 * i] = cs; tab[2 * i + 1] = sn;
    }
}

DEVINL bf16_t* strm_row(const Params& p, int t) { return (bf16_t*)(p.ws + WS_A) + (size_t)t * 1024; }
DEVINL bf16_t* regA(const Params& p) { return (bf16_t*)p.out; }
DEVINL unsigned char* regA8(const Params& p) { return (unsigned char*)p.out + U; }
DEVINL const float* in_row0(const Params& p, int t) { return t < NLAT ? p.in[I_X] + (size_t)t * 1024 : p.in[I_CTX] + (size_t)(t - NLAT) * 1024; }
DEVINL const float* mod_row(const Params& p, int l, int t, int which) { const int r = t < NLAT ? (t >> 12) : 16; return (const float*)(p.ws + WS_MOD) + (((size_t)l * 17 + r) * 6 + which) * 1024; }

DEVINL void modulate0_phase(const Params& p) {
    const int tid = tid_hidden(), lane = tid & 63, gw = blockIdx.x * 8 + (tid >> 6), nw = gridDim.x * 8;
    bf16_t* h = regA(p);
    for (int t = gw; t < T; t += 2 * nw) {
        const int t2 = t + nw; const bool has2 = t2 < T; const int tb = has2 ? t2 : t;
        const float* xa = in_row0(p, t); const float* xb = in_row0(p, tb);
        f32x4 va[4], vb[4];
#pragma unroll
        for (int j = 0; j < 4; ++j) { va[j] = *(const f32x4*)(xa + j * 256 + lane * 4); vb[j] = *(const f32x4*)(xb + j * 256 + lane * 4); }
        const float* sha = mod_row(p, 0, t, 0); const float* sca = mod_row(p, 0, t, 1); const float* shb = mod_row(p, 0, tb, 0); const float* scb = mod_row(p, 0, tb, 1);
#pragma unroll
        for (int j = 0; j < 4; ++j) { const int c = j * 256 + lane * 4;
            const f32x4 ya = va[j] * (*(const f32x4*)(sca + c) + 1.0f) + *(const f32x4*)(sha + c); u32x2 w; w.x = pk2(ya[0], ya[1]); w.y = pk2(ya[2], ya[3]); *(u32x2*)(h + (size_t)t * 1024 + c) = w; *(unsigned*)(regA8(p) + (size_t)t * 1024 + c) = pk4_fp8(ya[0], ya[1], ya[2], ya[3]);
            if (has2) { const f32x4 yb = vb[j] * (*(const f32x4*)(scb + c) + 1.0f) + *(const f32x4*)(shb + c); u32x2 w2; w2.x = pk2(yb[0], yb[1]); w2.y = pk2(yb[2], yb[3]); *(u32x2*)(h + (size_t)tb * 1024 + c) = w2; *(unsigned*)(regA8(p) + (size_t)tb * 1024 + c) = pk4_fp8(yb[0], yb[1], yb[2], yb[3]); } }
    }
}

DEVINL void acc8(float (&a)[8], const u32x4 v) { a[0] += bflo(v.x); a[1] += bfhi(v.x); a[2] += bflo(v.y); a[3] += bfhi(v.y); a[4] += bflo(v.z); a[5] += bfhi(v.z); a[6] += bflo(v.w); a[7] += bfhi(v.w); }
template <int GI, bool HORIZ>
DEVINL void pool_item(const bf16_t* __restrict__ src, const bf16_t* __restrict__ usrc, bf16_t* __restrict__ dst, int t, int ch) {
    constexpr int W = 2 << GI, LEFT = W / 2, RIGHT = W - 1 - LEFT;
    const bool lat = t < NLAT;
    int pos, last, stride;
    if (HORIZ) { pos = lat ? (t & 63) : ((t - NLAT) & 255); last = lat ? 63 : 255; stride = 1; }
    else { pos = (t >> 6) & 63; last = 63; stride = 64; }
    float a[8];
#pragma unroll
    for (int j = 0; j < 8; ++j) a[j] = 0.f;
    if (!HORIZ && !lat) { *(u32x4*)(dst + (size_t)t * 512 + ch) = *(const u32x4*)(src + (size_t)t * 512 + ch); return; }
    const int lo = max(pos - LEFT, 0), hi = min(pos + RIGHT, last);
    u32x4 wv[W];
#pragma unroll
    for (int k = 0; k < W; ++k) { const int qc = min(max(pos - LEFT + k, lo), hi); wv[k] = *(const u32x4*)(src + (size_t)(t + (qc - pos) * stride) * 512 + ch); }
#pragma unroll
    for (int k = 0; k < W; ++k) { const int q = pos - LEFT + k; if (q >= lo && q <= hi) acc8(a, wv[k]); }
    const float inv = 1.0f / (float)(hi - lo + 1);
    u32x4 w;
    if (HORIZ) { const u32x4 uv = *(const u32x4*)(usrc + (size_t)t * 512 + ch);
        w.x = pk2(a[0] * inv - bflo(uv.x), a[1] * inv - bfhi(uv.x)); w.y = pk2(a[2] * inv - bflo(uv.y), a[3] * inv - bfhi(uv.y));
        w.z = pk2(a[4] * inv - bflo(uv.z), a[5] * inv - bfhi(uv.z)); w.w = pk2(a[6] * inv - bflo(uv.w), a[7] * inv - bfhi(uv.w)); }
    else { w.x = pk2(a[0] * inv, a[1] * inv); w.y = pk2(a[2] * inv, a[3] * inv); w.z = pk2(a[4] * inv, a[5] * inv); w.w = pk2(a[6] * inv, a[7] * inv); }
    *(u32x4*)(dst + (size_t)t * 512 + ch) = w;
}
template <bool HORIZ>
DEVINL void pool_phase(const Params& p, int Tact) {
    const int tid = tid_hidden(), lane = tid & 63, gw = blockIdx.x * 8 + (tid >> 6), nw = gridDim.x * 8;
    bf16_t* u = (bf16_t*)(p.ws + WS_BIG + B_U); bf16_t* vm = regA(p);
    const bf16_t* src = HORIZ ? vm : u; bf16_t* dst = HORIZ ? u : vm;
    for (int q = gw; q < Tact / 4; q += nw) {
        const int t = q * 4 + (lane >> 4), cl = (lane & 15) * 8;
        pool_item<3, HORIZ>(src, u, dst, t, 384 + cl); pool_item<2, HORIZ>(src, u, dst, t, 256 + cl); pool_item<1, HORIZ>(src, u, dst, t, 128 + cl); pool_item<0, HORIZ>(src, u, dst, t, cl);
    }
}
struct CombSet { u32x2 a[4], b[4], g[4]; };
DEVINL void comb_load(const Params& p, int t, int lane, CombSet& S) {
    const bf16_t* of = (const bf16_t*)(p.ws + WS_BIG + B_OF); const bf16_t* ob = (const bf16_t*)(p.ws + WS_BIG + B_OB); const bf16_t* sg = (const bf16_t*)(p.ws + WS_BIG + B_SG);
#pragma unroll
    for (int j = 0; j < 4; ++j) { const size_t off = (size_t)t * 1024 + j * 256 + lane * 4; S.a[j] = *(const u32x2*)(of + off); S.b[j] = *(const u32x2*)(ob + off); S.g[j] = *(const u32x2*)(sg + off); }
}
DEVINL void comb_row(const Params& p, int t, int lane, const CombSet& S) {
    bf16_t* ur = (bf16_t*)(p.ws + WS_BIG + B_URET);
#pragma unroll
    for (int j = 0; j < 4; ++j) {
        float o[4] = {bflo(S.a[j].x) + bflo(S.b[j].x), bfhi(S.a[j].x) + bfhi(S.b[j].x), bflo(S.a[j].y) + bflo(S.b[j].y), bfhi(S.a[j].y) + bfhi(S.b[j].y)};
        const float mean = wave_sum(o[0] + o[1] + o[2] + o[3]) * (1.0f / 256.0f);
        float q = 0.f;
#pragma unroll
        for (int e = 0; e < 4; ++e) { o[e] -= mean; q += o[e] * o[e]; }
        const float rstd = rsqrtf(wave_sum(q) * (1.0f / 256.0f) + LN_EPS);
        u32x2 w; w.x = pk2(bflo(S.g[j].x) * o[0] * rstd, bfhi(S.g[j].x) * o[1] * rstd); w.y = pk2(bflo(S.g[j].y) * o[2] * rstd, bfhi(S.g[j].y) * o[3] * rstd);
        *(u32x2*)(ur + (size_t)t * 1024 + j * 256 + lane * 4) = w;
    }
}
DEVINL void combine_phase(const Params& p, int Tact) {
    const int tid = tid_hidden(), lane = tid & 63, gw = blockIdx.x * 8 + (tid >> 6), nw = gridDim.x * 8;
    CombSet A0, A1, B0, B1;
    int ta = gw;
    if (ta < Tact) { comb_load(p, ta, lane, A0); comb_load(p, min(ta + nw, Tact - 1), lane, A1); }
    while (ta < Tact) {
        const int tn = ta + 2 * nw;
        if (tn < Tact) { comb_load(p, tn, lane, B0); comb_load(p, min(tn + nw, Tact - 1), lane, B1); }
        comb_row(p, ta, lane, A0); if (ta + nw < Tact) comb_row(p, ta + nw, lane, A1);
        if (tn >= Tact) break;
        const int tn2 = tn + 2 * nw;
        if (tn2 < Tact) { comb_load(p, tn2, lane, A0); comb_load(p, min(tn2 + nw, Tact - 1), lane, A1); }
        comb_row(p, tn, lane, B0); if (tn + nw < Tact) comb_row(p, tn + nw, lane, B1);
        ta = tn2;
    }
}

struct LnRaw { u32x4 r[2]; };
DEVINL void ln_load_row(const bf16_t* xr, int lane, LnRaw& R) { R.r[0] = *(const u32x4*)(xr + lane * 8); R.r[1] = *(const u32x4*)(xr + 512 + lane * 8); }
DEVINL void ln_norm16(float (&v)[2][8], float& mean_o, float& rstd_o) {
    float s = 0.f;
#pragma unroll
    for (int j = 0; j < 2; ++j)
#pragma unroll
        for (int e = 0; e < 8; ++e) s += v[j][e];
    const float mean = wave_sum(s) * (1.0f / 1024.0f);
    float q = 0.f;
#pragma unroll
    for (int j = 0; j < 2; ++j)
#pragma unroll
        for (int e = 0; e < 8; ++e) { v[j][e] -= mean; q += v[j][e] * v[j][e]; }
    const float rstd = rsqrtf(wave_sum(q) * (1.0f / 1024.0f) + LN_EPS);
#pragma unroll
    for (int j = 0; j < 2; ++j)
#pragma unroll
        for (int e = 0; e < 8; ++e) v[j][e] *= rstd;
    mean_o = mean; rstd_o = rstd;
}
DEVINL void lds8f(const LAS float* p, float (&v)[8]) { const f32x4 a = *(const LAS f32x4*)p, b = *(const LAS f32x4*)(p + 4); v[0] = a[0]; v[1] = a[1]; v[2] = a[2]; v[3] = a[3]; v[4] = b[0]; v[5] = b[1]; v[6] = b[2]; v[7] = b[3]; }
DEVINL int mod_ridx(int t) { return t < NLAT ? (t >> 12) : 16; }
DEVINL void lds_fill(LAS float* dst, const float* src, int tid) { for (int i = tid; i < 256; i += 512) *(LAS f32x4*)(dst + 4 * i) = *(const f32x4*)(src + 4 * i); }
DEVINL void ln1_row(const Params& p, int t, int lane, bool moe, const LnRaw& R, const LAS float* sG2, const LAS float* sB2, LAS float* sR, LAS int* sCnt) {
    unsigned char* h2 = (unsigned char*)regA(p);
    float v[2][8]; unpk8h(R.r[0], v[0]); unpk8h(R.r[1], v[1]);
    f32v2_t d[2][4];
#pragma unroll
    for (int j = 0; j < 2; ++j)
#pragma unroll
        for (int k = 0; k < 4; ++k) d[j][k] = (f32v2_t){v[j][2 * k], v[j][2 * k + 1]};
    f32v2_t s2 = (d[0][0] + d[0][1]) + (d[0][2] + d[0][3]) + ((d[1][0] + d[1][1]) + (d[1][2] + d[1][3]));
    const float mean = wave_sum(s2.x + s2.y) * (1.0f / 1024.0f);
    f32v2_t q2 = (f32v2_t){0.f, 0.f};
#pragma unroll
    for (int j = 0; j < 2; ++j)
#pragma unroll
        for (int k = 0; k < 4; ++k) { d[j][k] -= mean; q2 += d[j][k] * d[j][k]; }
    const float rstd = rsqrtf(wave_sum(q2.x + q2.y) * (1.0f / 1024.0f) + LN_EPS);
    if (lane == 0) { float* st1 = (float*)(p.ws + WS_ST1); st1[2 * t] = mean; st1[2 * t + 1] = rstd; }
    f32v2_t lg2[8];
#pragma unroll
    for (int e = 0; e < 8; ++e) lg2[e] = (f32v2_t){0.f, 0.f};
#pragma unroll
    for (int j = 0; j < 2; ++j) { const int c = j * 512 + lane * 8;
        float g8[8], b8[8]; lds8f(sG2 + c, g8); lds8f(sB2 + c, b8);
        f32v2_t hp[4];
#pragma unroll
        for (int k = 0; k < 4; ++k) hp[k] = d[j][k] * ((f32v2_t){g8[2 * k], g8[2 * k + 1]} * rstd) + (f32v2_t){b8[2 * k], b8[2 * k + 1]};
        { u32x2 w8; w8.x = pk4_fp8(hp[0].x, hp[0].y, hp[1].x, hp[1].y); w8.y = pk4_fp8(hp[2].x, hp[2].y, hp[3].x, hp[3].y); *(u32x2*)(h2 + (size_t)t * 1024 + c) = w8; }
        if (moe) {
#pragma unroll
            for (int e = 0; e < 8; ++e) { float w8[8]; lds8f(sR + e * 1024 + c, w8);
#pragma unroll
                for (int k = 0; k < 4; ++k) lg2[e] += hp[k] * (f32v2_t){w8[2 * k], w8[2 * k + 1]}; }
        }
    }
    if (moe) {
        int* toke = (int*)(p.ws + WS_TOKE); float* tokw = (float*)(p.ws + WS_TOKW);
        float lg[8];
#pragma unroll
        for (int e = 0; e < 8; ++e) lg[e] = lg2[e].x + lg2[e].y;
        wave_sum8(lg, lane);
        int e0 = 0; float m0 = lg[0];
#pragma unroll
        for (int e = 1; e < 8; ++e) if (lg[e] > m0) { m0 = lg[e]; e0 = e; }
        int e1 = -1; float m1 = -3.0e38f;
#pragma unroll
        for (int e = 0; e < 8; ++e) if (e != e0 && lg[e] > m1) { m1 = lg[e]; e1 = e; }
        if (e1 < 0) { e1 = (e0 + 1) & 7; m1 = m0; }
        const float ex = __expf(m1 - m0), w0 = __builtin_amdgcn_rcpf(1.0f + ex), w1 = ex * w0;
        if (lane == 0) { toke[2 * t] = e0; toke[2 * t + 1] = e1; tokw[2 * t] = w0; tokw[2 * t + 1] = w1; __hip_atomic_fetch_add(&sCnt[e0], 1, __ATOMIC_RELAXED, __HIP_MEMORY_SCOPE_WORKGROUP); __hip_atomic_fetch_add(&sCnt[e1], 1, __ATOMIC_RELAXED, __HIP_MEMORY_SCOPE_WORKGROUP); }
    }
}
DEVINL void ln1_phase(const Params& p, LAS unsigned char* lds, int l, int Tact) {
    const int tid = tid_hidden(), lane = tid & 63, wv = tid >> 6, G = gridDim.x;
    const bool moe = (l & 1) != 0;
    LAS float* sR = (LAS float*)lds;
    LAS int* sCnt = (LAS int*)(lds + 32768);
    LAS float* sG = (LAS float*)(lds + 36864); LAS float* sB = sG + 1024; LAS float* sSC = sB + 1024; LAS float* sSH = sSC + 2048;
    LAS float* sG2 = sSH + 2048; LAS float* sB2 = sG2 + 2048;
    const int per = (Tact + G - 1) / G, t0 = blockIdx.x * per, t1 = min(t0 + per, Tact);
    const int r_lo = mod_ridx(min(t0, Tact - 1)), r_hi = mod_ridx(max(t1 - 1, 0));
    if (moe) { const float* wr = p.in[I_ROUTER] + (size_t)(l >> 1) * 1024 * 8; for (int i = tid; i < 8192; i += 512) sR[(i & 7) * 1024 + (i >> 3)] = wr[i]; if (tid < 8) sCnt[tid] = 0; }
    { const float* modl = (const float*)(p.ws + WS_MOD) + (size_t)l * 17 * 6144;
      lds_fill(sG, p.in[I_LNMG] + (size_t)l * 1024, tid); lds_fill(sB, p.in[I_LNMB] + (size_t)l * 1024, tid);
      lds_fill(sSC, modl + ((size_t)r_lo * 6 + 4) * 1024, tid); lds_fill(sSC + 1024, modl + ((size_t)r_hi * 6 + 4) * 1024, tid);
      lds_fill(sSH, modl + ((size_t)r_lo * 6 + 3) * 1024, tid); lds_fill(sSH + 1024, modl + ((size_t)r_hi * 6 + 3) * 1024, tid); }
    __syncthreads();
    for (int i = tid; i < 2048; i += 512) { const int cc = i & 1023; const float sc1 = sSC[i] + 1.0f; sG2[i] = sG[cc] * sc1; sB2[i] = sB[cc] * sc1 + sSH[i]; }
    __syncthreads();
#define LN1_ROW(tt, RR) do { const int _o = (mod_ridx(tt) == r_lo) ? 0 : 1024; ln1_row(p, (tt), lane, moe, RR, sG2 + _o, sB2 + _o, sR, sCnt); } while (0)
    LnRaw A0, A1, B0, B1;
    int ta = t0 + wv;
    if (ta < t1) { ln_load_row(strm_row(p, ta), lane, A0); ln_load_row(strm_row(p, min(ta + 8, t1 - 1)), lane, A1); }
    while (ta < t1) {
        const int tn = ta + 16;
        if (tn < t1) { ln_load_row(strm_row(p, tn), lane, B0); ln_load_row(strm_row(p, min(tn + 8, t1 - 1)), lane, B1); }
        LN1_ROW(ta, A0); if (ta + 8 < t1) LN1_ROW(ta + 8, A1);
        if (tn >= t1) break;
        const int tn2 = tn + 16;
        if (tn2 < t1) { ln_load_row(strm_row(p, tn2), lane, A0); ln_load_row(strm_row(p, min(tn2 + 8, t1 - 1)), lane, A1); }
        LN1_ROW(tn, B0); if (tn + 8 < t1) LN1_ROW(tn + 8, B1);
        ta = tn2;
    }
#undef LN1_ROW
    __syncthreads();
    if (moe && tid < 8) ((int*)(p.ws + WS_WGCNT))[blockIdx.x * 8 + tid] = sCnt[tid];
    __syncthreads();
}

DEVINL void moe_scatter_phase(const Params& p, LAS unsigned char* lds, int Tact) {
    const int tid = tid_hidden(), lane = tid & 63, wv = tid >> 6, G = gridDim.x;
    LAS int* sC = (LAS int*)lds;
    LAS int* sBase = (LAS int*)(lds + 16384);
    LAS int* sE = (LAS int*)(lds + 16384 + 256);
    LAS int* sD = (LAS int*)(lds + 16384 + 256 + 4096);
    const int* wgc = (const int*)(p.ws + WS_WGCNT);
    for (int i = tid; i < G * 8; i += 512) sC[i] = wgc[i];
    __syncthreads();
    if (tid < 8) { int tot = 0, before = 0; for (int g = 0; g < G; ++g) { const int c = sC[g * 8 + tid]; if (g < (int)blockIdx.x) before += c; tot += c; } sBase[tid] = before; sBase[8 + tid] = (tot + 255) / 256 * 256; }
    __syncthreads();
    if (tid == 0) { int acc = 0; for (int e = 0; e < 8; ++e) { const int pd = sBase[8 + e]; sBase[e] += acc; acc += pd; sBase[8 + e] = acc; } }
    __syncthreads();
    const int per = (Tact + G - 1) / G, t0 = blockIdx.x * per, t1 = min(t0 + per, Tact), na = max(t1 - t0, 0) * 2;
    const int* toke = (const int*)(p.ws + WS_TOKE); int* tokd = (int*)(p.ws + WS_TOKD);
    for (int a = tid; a < na; a += 512) sE[a] = toke[2 * t0 + a] & 7;
    __syncthreads();
    for (int a = tid; a < na; a += 512) { const int e = sE[a]; int r = 0; for (int b = 0; b < a; ++b) r += (sE[b] == e) ? 1 : 0; int d = sBase[e] + r; d = min(max(d, 0), MAXRB * 256 - 1); sD[a] = d; tokd[2 * t0 + a] = d; }
    if (blockIdx.x == 0) {
        int* blke = (int*)(p.ws + WS_BLKE);
        if (tid == 0) blke[0] = sBase[15] / 256;
        if (tid < 7) blke[1 + tid] = sBase[8 + tid] / 256;
        for (int rb = tid; rb < MAXRB; rb += 512) { int e = 0; while (e < 7 && rb * 256 >= sBase[8 + e]) ++e; blke[8 + rb] = e; }
    }
    __syncthreads();
    const unsigned char* h2 = (const unsigned char*)regA(p); unsigned char* xs = p.ws + WS_BIG + F_XS;
    for (int a0 = wv; a0 < na; a0 += 64) {
        u32x4 v0[8];
#pragma unroll
        for (int r = 0; r < 8; ++r) { const int a = min(a0 + 8 * r, na - 1), t = t0 + (a >> 1); v0[r] = *(const u32x4*)(h2 + (size_t)t * 1024 + lane * 16); }
#pragma unroll
        for (int r = 0; r < 8; ++r) { const int a = a0 + 8 * r; if (a < na) { const int d = sD[a]; *(u32x4*)(xs + (size_t)d * 1024 + lane * 16) = v0[r]; } }
    }
    __syncthreads();
}

struct Ln2Set { LnRaw z; LnRaw ya, yb; float w0, w1, m1, r1; };
struct Ln2Par { const LAS float* G; const LAS float* B; const LAS float* SC; const LAS float* SH; const LAS float* M5; const LAS float* GM; const LAS float* BM; };
DEVINL void ln2_load(const Params& p, int t, int lane, bool moe, Ln2Set& S) {
    if (moe) { const int* tokd = (const int*)(p.ws + WS_TOKD); const float* tokw = (const float*)(p.ws + WS_TOKW); const bf16_t* yk = (const bf16_t*)(p.ws + WS_BIG + F_YK);
        const int d0 = tokd[2 * t], d1 = tokd[2 * t + 1]; S.w0 = tokw[2 * t]; S.w1 = tokw[2 * t + 1]; const float* st1 = (const float*)(p.ws + WS_ST1); S.m1 = st1[2 * t]; S.r1 = st1[2 * t + 1];
        ln_load_row(yk + (size_t)d0 * 1024, lane, S.ya); ln_load_row(yk + (size_t)d1 * 1024, lane, S.yb); }
    ln_load_row(strm_row(p, t), lane, S.z);
}
DEVINL void ln2_row(const Params& p, int l, int t, int lane, bool moe, const Ln2Set& S, const Ln2Par& P) {
    float v[2][8]; unpk8h(S.z.r[0], v[0]); unpk8h(S.z.r[1], v[1]);
    if (moe) {
#pragma unroll
        for (int j = 0; j < 2; ++j) { const int c = j * 512 + lane * 8; float a8[8], b8[8], g8[8], e8[8], m8[8]; unpk8(S.ya.r[j], a8); unpk8(S.yb.r[j], b8); lds8f(P.GM + c, g8); lds8f(P.BM + c, e8); lds8f(P.M5 + c, m8);
#pragma unroll
            for (int e = 0; e < 8; ++e) { const float x1 = (v[j][e] - S.m1) * S.r1 * g8[e] + e8[e];
                v[j][e] = x1 * ALPHA + m8[e] * (S.w0 * a8[e] + S.w1 * b8[e]); } } }
    float mean2, rstd2; ln_norm16(v, mean2, rstd2);
    const bool last = l + 1 >= DEPTH, store_x = moe || last;
    if (!store_x && lane == 0) { float* st2 = (float*)(p.ws + WS_ST2); st2[2 * t] = mean2; st2[2 * t + 1] = rstd2; }
#pragma unroll
    for (int j = 0; j < 2; ++j) { const int c = j * 512 + lane * 8; float g8[8], b8[8], xv[8]; lds8f(P.G + c, g8); lds8f(P.B + c, b8);
#pragma unroll
        for (int e = 0; e < 8; ++e) xv[e] = v[j][e] * g8[e] + b8[e];
        if (last) { float* o = p.out + (size_t)t * 1024 + c; *(f32x4*)o = (f32x4){xv[0], xv[1], xv[2], xv[3]}; *(f32x4*)(o + 4) = (f32x4){xv[4], xv[5], xv[6], xv[7]}; }
        else if (store_x) *(u32x4*)(strm_row(p, t) + c) = pk8h(xv);
        if (!last) { float s8[8], h8[8], hv[8]; lds8f(P.SC + c, s8); lds8f(P.SH + c, h8);
#pragma unroll
            for (int e = 0; e < 8; ++e) hv[e] = xv[e] * (s8[e] + 1.0f) + h8[e];
            *(u32x4*)(regA(p) + (size_t)t * 1024 + c) = pk8(hv);
            u32x2 w8; w8.x = pk4_fp8(hv[0], hv[1], hv[2], hv[3]); w8.y = pk4_fp8(hv[4], hv[5], hv[6], hv[7]); *(u32x2*)(regA8(p) + (size_t)t * 1024 + c) = w8; }
    }
}
DEVINL void ln2_phase(const Params& p, LAS unsigned char* lds, int l, int Tact) {
    const int tid = tid_hidden(), lane = tid & 63, wv = tid >> 6, G = gridDim.x;
    const bool moe = (l & 1) != 0, last = l + 1 >= DEPTH;
    LAS float* sG = (LAS float*)lds; LAS float* sB = sG + 1024; LAS float* sSC = sB + 1024; LAS float* sSH = sSC + 2048; LAS float* sM5 = sSH + 2048; LAS float* sGM = sM5 + 2048; LAS float* sBM = sGM + 1024;
    const int per = (Tact + G - 1) / G, t0 = blockIdx.x * per, t1 = min(t0 + per, Tact);
    const int r_lo = mod_ridx(min(t0, Tact - 1)), r_hi = mod_ridx(max(t1 - 1, 0));
    __syncthreads();
    { const float* mod = (const float*)(p.ws + WS_MOD); const float* modl = mod + (size_t)l * 17 * 6144; const float* modn = mod + (size_t)(last ? l : l + 1) * 17 * 6144;
      lds_fill(sG, p.in[I_LNFG] + (size_t)l * 1024, tid); lds_fill(sB, p.in[I_LNFB] + (size_t)l * 1024, tid);
      lds_fill(sSC, modn + ((size_t)r_lo * 6 + 1) * 1024, tid); lds_fill(sSC + 1024, modn + ((size_t)r_hi * 6 + 1) * 1024, tid);
      lds_fill(sSH, modn + ((size_t)r_lo * 6 + 0) * 1024, tid); lds_fill(sSH + 1024, modn + ((size_t)r_hi * 6 + 0) * 1024, tid);
      lds_fill(sM5, modl + ((size_t)r_lo * 6 + 5) * 1024, tid); lds_fill(sM5 + 1024, modl + ((size_t)r_hi * 6 + 5) * 1024, tid);
      lds_fill(sGM, p.in[I_LNMG] + (size_t)l * 1024, tid); lds_fill(sBM, p.in[I_LNMB] + (size_t)l * 1024, tid); }
    __syncthreads();
#define LN2_ROW(tt, SS) do { const int _o = (mod_ridx(tt) == r_lo) ? 0 : 1024; const Ln2Par _P{sG, sB, sSC + _o, sSH + _o, sM5 + _o, sGM, sBM}; ln2_row(p, l, (tt), lane, moe, SS, _P); } while (0)
    Ln2Set A0, A1, B0, B1;
    int ta = t0 + wv;
    if (ta < t1) { ln2_load(p, ta, lane, moe, A0); ln2_load(p, min(ta + 8, t1 - 1), lane, moe, A1); }
    while (ta < t1) {
        const int tn = ta + 16;
        if (tn < t1) { ln2_load(p, tn, lane, moe, B0); ln2_load(p, min(tn + 8, t1 - 1), lane, moe, B1); }
        LN2_ROW(ta, A0); if (ta + 8 < t1) LN2_ROW(ta + 8, A1);
        if (tn >= t1) break;
        const int tn2 = tn + 16;
        if (tn2 < t1) { ln2_load(p, tn2, lane, moe, A0); ln2_load(p, min(tn2 + 8, t1 - 1), lane, moe, A1); }
        LN2_ROW(tn, B0); if (tn + 8 < t1) LN2_ROW(tn + 8, B1);
        ta = tn2;
    }
#undef LN2_ROW
    __syncthreads();
}

DEVINL bf16x8 cat8(v4i16_t a, v4i16_t b) { bf16x8 r; r[0] = a[0]; r[1] = a[1]; r[2] = a[2]; r[3] = a[3]; r[4] = b[0]; r[5] = b[1]; r[6] = b[2]; r[7] = b[3]; return r; }
DEVINL void retention_phase(const Params& p, LAS unsigned char* lds, int l, bool need_ctx) {
    constexpr int RS = 272;
    int tid = threadIdx.x; asm volatile("" : "+v"(tid));
    const int w = __builtin_amdgcn_readfirstlane(tid >> 6), lane = tid & 63, fr = lane & 15, fq = lane >> 4;
    LAS unsigned char* Qs = lds; LAS unsigned char* Ks = lds + 34816; LAS unsigned char* Vs = lds + 69632; LAS unsigned char* Ps = lds + 104448;
    LAS float* tqd = (LAS float*)(lds + LDS_TAB); LAS float* tkd = tqd + 128;
    const bf16_t* qg = (const bf16_t*)(p.ws + WS_BIG + B_Q); const bf16_t* kg = (const bf16_t*)(p.ws + WS_BIG + B_K); const bf16_t* vg = (const bf16_t*)(p.ws + WS_BIG + B_V);
    const int lr = tid >> 4, lc = tid & 15;
    const int trq = fr >> 2, trp = fr & 3;
    for (int item = blockIdx.x; item < 256; item += gridDim.x) {
        const int dvs = item & 1, dir = (item >> 1) & 1, hd = (item >> 2) & 3, b = item >> 4;
        bf16_t* og = (bf16_t*)(p.ws + WS_BIG + (dir ? B_OB : B_OF));
        const float zl = p.in[I_DECAY][l * 8 + dir * 4 + hd];
        const float lg2 = -log1pf(expf(-zl)) * 1.4426950408889634f;
        __syncthreads();
        if (tid < 128) { tqd[tid] = exp2f(lg2 * (float)(dir ? 128 - tid : tid + 1)); tkd[tid] = exp2f(lg2 * (float)(dir ? tid : 127 - tid)); }
        const float cdec = exp2f(lg2 * 128.0f);
        float afac[4];
#pragma unroll
        for (int jj = 0; jj < 4; ++jj) afac[jj] = exp2f(lg2 * (float)(dir ? (4 * fq + jj - fr) : (fr - 4 * fq - jj)));
        f32x4 S[8];
#pragma unroll
        for (int t = 0; t < 8; ++t) S[t] = (f32x4){0.f, 0.f, 0.f, 0.f};
        u32x4 rq[4], rk[4], rv[4];
#define RET_TOK0(c) ((c) < 2 ? NLAT + b * 256 + (dir ? 1 - (c) : (c)) * 128 : b * 4096 + (dir ? 33 - (c) : (c) - 2) * 128)
#define RET_LOAD(c) do { const int _t0 = RET_TOK0(c); _Pragma("unroll") for (int ps = 0; ps < 4; ++ps) { const size_t _t = (size_t)(_t0 + lr + 32 * ps); \
            rq[ps] = *(const u32x4*)(qg + _t * 512 + hd * 128 + lc * 8); rk[ps] = *(const u32x4*)(kg + _t * 512 + hd * 128 + lc * 8); rv[ps] = *(const u32x4*)(vg + _t * 1024 + hd * 256 + dvs * 128 + lc * 8); } } while (0)
        RET_LOAD(0);
        for (int c = 0; c < 34; ++c) {
            const int tok0 = RET_TOK0(c);
            __syncthreads();
#pragma unroll
            for (int ps = 0; ps < 4; ++ps) { const int o = (lr + 32 * ps) * RS + lc * 16; *(LAS u32x4*)(Qs + o) = rq[ps]; *(LAS u32x4*)(Ks + o) = rk[ps]; *(LAS u32x4*)(Vs + o) = rv[ps]; }
            __syncthreads();
            if (c + 1 < 34) RET_LOAD(c + 1);
            const bool do_out = (c >= 2) || need_ctx;
            if (do_out) {
                const int rt = w < 4 ? w : 11 - w;
                bf16x8 qf[4];
#pragma unroll
                for (int s = 0; s < 4; ++s) qf[s] = *(const LAS bf16x8*)(Qs + (16 * rt + fr) * RS + (32 * s + 8 * fq) * 2);
                const int i = 16 * rt + fr;
#pragma unroll
                for (int t = 0; t < 8; ++t) {
                    const bool live = dir ? (t >= rt) : (t <= rt);
                    f32x4 a = (f32x4){0.f, 0.f, 0.f, 0.f};
                    if (live) {
#pragma unroll
                        for (int s = 0; s < 4; ++s) { const bf16x8 kf = *(const LAS bf16x8*)(Ks + (16 * t + fr) * RS + (32 * s + 8 * fq) * 2); a = __builtin_amdgcn_mfma_f32_16x16x32_bf16(kf, qf[s], a, 0, 0, 0); }
                        const float bt = __builtin_amdgcn_exp2f(lg2 * 16.0f * (float)(dir ? t - rt : rt - t));
#pragma unroll
                        for (int jj = 0; jj < 4; ++jj) { const int dd = dir ? (4 * fq + jj - fr) : (fr - 4 * fq - jj); a[jj] = (t != rt || dd >= 0) ? a[jj] * (afac[jj] * bt) : 0.f; }
                    }
                    u32x2 pw; pw.x = pk2(a[0], a[1]); pw.y = pk2(a[2], a[3]);
                    *(LAS u32x2*)(Ps + i * RS + (16 * t + 4 * fq) * 2) = pw;
                }
            }
            __syncthreads();
            bf16x8 vf[4];
#pragma unroll
            for (int s = 0; s < 4; ++s) { LAS unsigned char* a0 = Vs + (32 * s + 8 * fq + trq) * RS + (16 * w + 4 * trp) * 2;
                vf[s] = cat8(__builtin_amdgcn_ds_read_tr16_b64_v4i16((LAS v4i16_t*)a0), __builtin_amdgcn_ds_read_tr16_b64_v4i16((LAS v4i16_t*)(a0 + 4 * RS))); }
            if (do_out) {
                bf16x8 Sb[4];
#pragma unroll
                for (int s = 0; s < 4; ++s) { u32x4 t4; t4.x = pk2(S[2 * s][0], S[2 * s][1]); t4.y = pk2(S[2 * s][2], S[2 * s][3]); t4.z = pk2(S[2 * s + 1][0], S[2 * s + 1][1]); t4.w = pk2(S[2 * s + 1][2], S[2 * s + 1][3]); Sb[s] = __builtin_bit_cast(bf16x8, t4); }
#pragma unroll
                for (int ip = 0; ip < 4; ++ip) {
                    const int i0 = 16 * (2 * ip) + fr, i1 = i0 + 16;
                    bf16x8 q0[4], q1[4];
#pragma unroll
                    for (int s = 0; s < 4; ++s) { q0[s] = *(const LAS bf16x8*)(Qs + i0 * RS + (32 * s + 8 * fq) * 2); q1[s] = *(const LAS bf16x8*)(Qs + i1 * RS + (32 * s + 8 * fq) * 2); }
                    f32x4 a0 = (f32x4){0.f, 0.f, 0.f, 0.f}, a1 = a0;
#pragma unroll
                    for (int s = 0; s < 4; ++s) { a0 = __builtin_amdgcn_mfma_f32_16x16x32_bf16(Sb[s], q0[s], a0, 0, 0, 0); a1 = __builtin_amdgcn_mfma_f32_16x16x32_bf16(Sb[s], q1[s], a1, 0, 0, 0); }
                    a0 *= tqd[i0]; a1 *= tqd[i1];
#pragma unroll
                    for (int s = 0; s < 4; ++s) {
                        if (dir ? (2 * s + 1 >= 2 * ip) : (2 * s <= 2 * ip)) { const bf16x8 pb = *(const LAS bf16x8*)(Ps + i0 * RS + (32 * s + 8 * fq) * 2); a0 = __builtin_amdgcn_mfma_f32_16x16x32_bf16(vf[s], pb, a0, 0, 0, 0); }
                        if (dir ? (2 * s + 1 >= 2 * ip + 1) : (2 * s <= 2 * ip + 1)) { const bf16x8 pb = *(const LAS bf16x8*)(Ps + i1 * RS + (32 * s + 8 * fq) * 2); a1 = __builtin_amdgcn_mfma_f32_16x16x32_bf16(vf[s], pb, a1, 0, 0, 0); }
                    }
                    u32x2 ow0, ow1; ow0.x = pk2(a0[0], a0[1]); ow0.y = pk2(a0[2], a0[3]); ow1.x = pk2(a1[0], a1[1]); ow1.y = pk2(a1[2], a1[3]);
                    *(u32x2*)(og + (size_t)(tok0 + i0) * 1024 + hd * 256 + dvs * 128 + 16 * w + 4 * fq) = ow0;
                    *(u32x2*)(og + (size_t)(tok0 + i1) * 1024 + hd * 256 + dvs * 128 + 16 * w + 4 * fq) = ow1;
                }
            }
#pragma unroll
            for (int t = 0; t < 8; ++t) S[t] *= cdec;
#pragma unroll
            for (int s = 0; s < 4; ++s) {
                const f32x4 k0 = *(const LAS f32x4*)(tkd + 32 * s + 8 * fq), k1 = *(const LAS f32x4*)(tkd + 32 * s + 8 * fq + 4);
                const u32x4 vv = __builtin_bit_cast(u32x4, vf[s]); u32x4 t4;
                t4.x = pk2(bflo(vv.x) * k0[0], bfhi(vv.x) * k0[1]); t4.y = pk2(bflo(vv.y) * k0[2], bfhi(vv.y) * k0[3]);
                t4.z = pk2(bflo(vv.z) * k1[0], bfhi(vv.z) * k1[1]); t4.w = pk2(bflo(vv.w) * k1[2], bfhi(vv.w) * k1[3]);
                const bf16x8 vsc = __builtin_bit_cast(bf16x8, t4);
#pragma unroll
                for (int t = 0; t < 8; ++t) {
                    LAS unsigned char* a0 = Ks + (32 * s + 8 * fq + trq) * RS + (32 * (t >> 1) + 8 * trp + 4 * (t & 1)) * 2;
                    const bf16x8 kt = cat8(__builtin_amdgcn_ds_read_tr16_b64_v4i16((LAS v4i16_t*)a0), __builtin_amdgcn_ds_read_tr16_b64_v4i16((LAS v4i16_t*)(a0 + 4 * RS)));
                    S[t] = __builtin_amdgcn_mfma_f32_16x16x32_bf16(kt, vsc, S[t], 0, 0, 0);
                }
            }
        }
#undef RET_TOK0
#undef RET_LOAD
    }
    __syncthreads();
}

__global__ void __launch_bounds__(512, 2) fwd_kernel(Params p) {
    extern __shared__ __attribute__((aligned(16))) unsigned char lds_raw[];
    LAS unsigned char* lds = (LAS unsigned char*)lds_raw;
    const int tid = threadIdx.x, G = gridDim.x, lo = p.ph_lo, hi = p.ph_hi;
    volatile LAS unsigned* xst = (volatile LAS unsigned*)(lds + LDS_CTL);
    if (tid < 4) xst[tid] = 0u;
    __syncthreads();
    XcdBarrier bar; bar.bar = (unsigned*)(p.ws + WS_CTL) + CW_BAR; bar.x = 0; bar.st = xst;
    const bool multi = (hi - lo) > 1;
    if (multi) bar = xcd_barrier_post((unsigned*)(p.ws + WS_CTL) + CW_BAR, xst);
#ifndef PHM
#define PHM 0xFFFFFFFFu
#endif
#define PM(q) ((PHM >> (q)) & 1u)
#define IN(k) (lo <= (k) && (k) < hi)
#ifndef TSEL
#define TSEL 0u
#endif
#ifndef TMULT
#define TMULT 10
#endif
    volatile LAS unsigned long long* tacc = (volatile LAS unsigned long long*)(lds + LDS_CTL + 32);
    if (TSEL && tid == 0) { tacc[0] = 0ull; tacc[1] = wall_clock64(); }
#define SEAMK(k, kind) do { if ((k) + 1 < hi) xcd_barrier(bar); if (TSEL && blockIdx.x == 0 && tid == 0) { const unsigned long long _n = wall_clock64(); if ((TSEL >> (kind)) & 1u) tacc[0] += _n - tacc[1]; tacc[1] = _n; } } while (0)
    unsigned char* big = p.ws + WS_BIG;
    const char* wmix = (const char*)(p.ws + WS_WMIX);

    if (PM(13) && IN(PH_PRO_A)) { adaln_phase(p, lds); rope_phase(p); __syncthreads(); convert_mixer_weights(p, lds, 0); SEAMK(PH_PRO_A, 13); }
    if (PM(14) && IN(PH_PRO_B)) { modulate0_phase(p); SEAMK(PH_PRO_B, 14); }

    for (int l = 0; l < DEPTH; ++l) {
        const int pb = PH_L0 + l * PH_PER_L;
        if (hi <= pb || lo >= pb + PH_PER_L) continue;
        const bool need_ctx = l < DEPTH - 1;
        const int Tact = need_ctx ? T : NLAT, nMact = Tact / 256;
        const float* modl = (const float*)(p.ws + WS_MOD) + (size_t)l * 17 * 6144;

        if (PM(0) && IN(pb + Q_IN)) {
            EpiIn E{(bf16_t*)big, (const float*)(p.ws + WS_ROPE)};
            if (need_ctx) { SchedRect S{(const char*)regA(p), wmix + WMIX_IN, T / 256, 14, G, (int)blockIdx.x, (size_t)256 * 1024 * 2}; gemm_phase(lds, 1024, S, E); }
            else { SchedIn3 S{(const char*)regA(p), wmix + WMIX_IN, G, (int)blockIdx.x, (size_t)256 * 1024 * 2}; gemm_phase(lds, 1024, S, E); }
            __syncthreads();
            {
              SchedRect S8{(const char*)regA8(p), wmix + WMIX_IN8, nMact, 8, G, (int)blockIdx.x, (size_t)256 * 1024};
              EpiSig8 E8{(bf16_t*)big}; gemm_phase(lds, 1024 / 2, S8, E8); }
            SEAMK(pb + Q_IN, 0);
        }
        if (PM(2) && IN(pb + Q_RET)) { pool_phase<false>(p, Tact); retention_phase(p, lds, l, need_ctx); SEAMK(pb + Q_RET, 2); }
        if (PM(3) && IN(pb + Q_COMB)) { combine_phase(p, Tact); pool_phase<true>(p, Tact); SEAMK(pb + Q_COMB, 3); }
        if (PM(4) && IN(pb + Q_MIX)) {
            { SchedRect S{(const char*)(big + B_U), wmix + WMIX_POOL, nMact, 4, G, (int)blockIdx.x, (size_t)256 * 512 * 2};
              EpiGate<0> E{(bf16_t*)(big + B_Y1), (const bf16_t*)(big + B_GP), nullptr}; gemm_phase(lds, 512, S, E); }
            __syncthreads();
            { SchedRect S{(const char*)(big + B_URET), wmix + WMIX_RET, nMact, 4, G, (int)blockIdx.x, (size_t)256 * 1024 * 2};
              EpiGate<1> E{(bf16_t*)(big + B_MIX), (const bf16_t*)(big + B_GR), (const bf16_t*)(big + B_Y1)}; gemm_phase(lds, 1024, S, E); }
            SEAMK(pb + Q_MIX, 4);
        }
        if (PM(5) && IN(pb + Q_OUT)) {
            SchedRect S{(const char*)(big + B_MIX), wmix + WMIX_OUT, nMact, 4, G, (int)blockIdx.x, (size_t)256 * 1024 * 2};
            const bool renorm = (l & 1) != 0;
            const float* lg = p.in[I_LNFG] + (size_t)(l > 0 ? l - 1 : 0) * 1024; const float* lb = p.in[I_LNFB] + (size_t)(l > 0 ? l - 1 : 0) * 1024;
            if (l == 0) { EpiRes<true, false> E{p.in[I_X], p.in[I_CTX], (bf16_t*)(p.ws + WS_A), modl, 2, nullptr, lg, lb}; gemm_phase(lds, 1024, S, E); }
            else if (renorm) { EpiRes<false, true> E{nullptr, nullptr, (bf16_t*)(p.ws + WS_A), modl, 2, (const float*)(p.ws + WS_ST2), lg, lb}; gemm_phase(lds, 1024, S, E); }
            else { EpiRes<false, false> E{nullptr, nullptr, (bf16_t*)(p.ws + WS_A), modl, 2, nullptr, lg, lb}; gemm_phase(lds, 1024, S, E); }
            SEAMK(pb + Q_OUT, 5);
        }
        if (PM(6) && IN(pb + Q_LN1)) {
            ln1_phase(p, lds, l, Tact);
            convert_ffn_weights(p, lds, l);
            if (l + 1 < DEPTH) convert_mixer_weights(p, lds, l + 1);
            SEAMK(pb + Q_LN1, 6);
        }
        if ((l & 1) == 0) {
            if (PM(7) && IN(pb + Q_F0)) {
                SchedRect S{(const char*)regA(p), (const char*)(big + F_W), nMact, 2 * DFF / 256, G, (int)blockIdx.x, (size_t)256 * 1024};
                EpiSwiglu8 E{big + F_ACT, DFF, 0}; gemm_phase(lds, 1024 / 2, S, E);
                SEAMK(pb + Q_F0, 7);
            }
            if (PM(8) && IN(pb + Q_F1)) {
                SchedRect S{(const char*)(big + F_ACT), (const char*)(big + F_DW2), nMact, 4, G, (int)blockIdx.x, (size_t)256 * DFF};
                EpiRes<false, true, true> E{nullptr, nullptr, (bf16_t*)(p.ws + WS_A), modl, 5, (const float*)(p.ws + WS_ST1), p.in[I_LNMG] + (size_t)l * 1024, p.in[I_LNMB] + (size_t)l * 1024};
                gemm_phase(lds, DFF / 2, S, E);
                SEAMK(pb + Q_F1, 8);
            }
        } else {
            if (PM(9) && IN(pb + Q_F0)) { moe_scatter_phase(p, lds, Tact); SEAMK(pb + Q_F0, 9); }
            const int* blke = (const int*)(p.ws + WS_BLKE);
            for (int g = 0; g < NGRP; ++g) {
                if (PM(10) && IN(pb + Q_F1 + 2 * g)) {
                    const int nb = min(blke[0], MAXRB), rb0 = g * RBG, nrb = min(RBG, nb - rb0);
                    if (nrb > 0) {
                        int w0, w1, w2; moe_bounds(blke, w0, w1, w2);
                        SchedMoe S{(const char*)(big + F_XS), (const char*)(big + F_W), w0, w1, w2, rb0, 0, nrb, 2 * EFF / 256, G, (int)blockIdx.x, (size_t)256 * 1024, F_EW13};
                        EpiSwiglu8 E{big + F_ACTM, EFF, rb0}; gemm_phase(lds, 1024 / 2, S, E);
                    }
                    SEAMK(pb + Q_F1 + 2 * g, 10);
                }
                if (PM(11) && IN(pb + Q_F1 + 2 * g + 1)) {
                    const int nb = min(blke[0], MAXRB), rb0 = g * RBG, nrb = min(RBG, nb - rb0);
                    if (nrb > 0) {
                        int w0, w1, w2; moe_bounds(blke, w0, w1, w2);
                        SchedMoe S{(const char*)(big + F_ACTM), (const char*)(big + F_W + (size_t)NEXP * F_EW13), w0, w1, w2, rb0, rb0, nrb, 4, G, (int)blockIdx.x, (size_t)256 * EFF, F_EW2};
                        EpiPlain8 E{(bf16_t*)(big + F_YK), 1.0f / W2_SCALE}; gemm_phase(lds, EFF / 2, S, E);
                    }
                    SEAMK(pb + Q_F1 + 2 * g + 1, 11);
                }
            }
        }
        if (PM(12) && IN(pb + Q_LN2)) { ln2_phase(p, lds, l, Tact); SEAMK(pb + Q_LN2, 12); }
    }
#undef IN
#undef SEAMK
    if (TSEL && blockIdx.x == 0 && tid == 0) { const unsigned long long t0 = wall_clock64(), w = tacc[0] * (unsigned long long)TMULT; while (wall_clock64() - t0 < w) __builtin_amdgcn_s_sleep(32); }
}

static bool phase_active(int ph) {
    if (ph < PH_L0) return true;
    const int l = (ph - PH_L0) / PH_PER_L, q = (ph - PH_L0) % PH_PER_L;
    if (q == Q_POOLV) return false;
    if (q <= Q_F0 || q == Q_LN2) return true;
    if (q >= Q_F1 && q < Q_LN2) { if ((l & 1) == 0) return q == Q_F1; return q < Q_F1 + 2 * NGRP; }
    return false;
}

extern "C" void kernel_launch(void* const* d_in, const int* in_sizes, int n_in, void* d_out, int out_size, void* d_ws, size_t ws_size, hipStream_t stream) {
    static int grid = 0;
    if (grid == 0) {
        if (n_in != 24 || out_size != NLAT * 1024 || ws_size < WS_END) { fprintf(stderr, "kernel_launch: unexpected shapes (n_in %d out %d ws %zu need %zu)\n", n_in, out_size, ws_size, (size_t)WS_END); grid = -1; return; }
        int dev = 0, cus = 0, per_cu = 0;
        if (hipGetDevice(&dev) != hipSuccess || hipDeviceGetAttribute(&cus, hipDeviceAttributeMultiprocessorCount, dev) != hipSuccess) { grid = -1; return; }
        if (hipFuncSetAttribute((const void*)fwd_kernel, hipFuncAttributeMaxDynamicSharedMemorySize, LDS_BYTES) != hipSuccess) { fprintf(stderr, "kernel_launch: hipFuncSetAttribute failed\n"); grid = -1; return; }
        if (hipOccupancyMaxActiveBlocksPerMultiprocessor(&per_cu, (const void*)fwd_kernel, 512, LDS_BYTES) != hipSuccess || per_cu < 1) { fprintf(stderr, "kernel_launch: occupancy query says %d\n", per_cu); (void)hipGetLastError(); per_cu = 1; }
        grid = cus < 256 ? cus : 256;
    }
    if (grid < 0) return;
    (void)hipMemsetAsync((char*)d_ws + WS_CTL, 0, CTL_BYTES, stream);
    Params p{};
    for (int i = 0; i < 24; ++i) p.in[i] = (const float*)d_in[i];
    p.out = (float*)d_out; p.ws = (unsigned char*)d_ws;
#if MK_MULTI
#ifndef MAXPH
#define MAXPH NPH
#endif
    for (int ph = 0; ph < MAXPH; ++ph) {
        if (!phase_active(ph)) continue;
        p.ph_lo = ph; p.ph_hi = ph + 1;
        hipLaunchKernelGGL(fwd_kernel, dim3(grid), dim3(512), LDS_BYTES, stream, p);
    }
#else
    p.ph_lo = 0; p.ph_hi = NPH;
    hipLaunchKernelGGL(fwd_kernel, dim3(grid), dim3(512), LDS_BYTES, stream, p);
#endif
}
```

```cpp
#include <hip/hip_runtime.h>
#include <stdint.h>
#include <cstdio>

#define MAXPH NPH
#ifndef MK_MULTI
#define MK_MULTI 0
#endif

#define DEVINL __device__ __forceinline__
#define LAS __attribute__((address_space(3)))
typedef unsigned short bf16_t;
typedef short bf16x8 __attribute__((ext_vector_type(8)));
typedef short v4i16_t __attribute__((ext_vector_type(4)));
typedef float f32x4 __attribute__((ext_vector_type(4)));
typedef unsigned u32x4 __attribute__((ext_vector_type(4)));
typedef unsigned u32x2 __attribute__((ext_vector_type(2)));

constexpr int D = 1024, BATCH = 16, SEQ = 4096, DEPTH = 4, CTXL = 256, GRIDW = 64;
constexpr int NLAT = BATCH * SEQ, NCTX = BATCH * CTXL, T = NLAT + NCTX;
constexpr int INW = 5632, DFF = 2816, NEXP = 8, EFF = 3584;
constexpr int MAXRB = 552;
constexpr int RBG = 552;
constexpr int NGRP = 1;
constexpr float ALPHA = 1.6817928305074290f;
constexpr float LN_EPS = 1e-5f;
constexpr float KSCALE = 0.08838834764831845f;

constexpr size_t AL(size_t x) { return (x + 255) & ~(size_t)255; }
constexpr size_t U = (size_t)T * 1024 * 2;
constexpr size_t WS_CTL = 0;
constexpr size_t CTL_BYTES = 65536;
constexpr size_t WS_MOD = WS_CTL + CTL_BYTES;
constexpr size_t WS_ROPE = AL(WS_MOD + (size_t)4 * 17 * 6144 * 4);
constexpr size_t WS_CTXS = AL(WS_ROPE + (size_t)4096 * 64 * 8);
constexpr size_t WS_TOKE = AL(WS_CTXS + (size_t)NCTX * 1024 * 4);
constexpr size_t WS_TOKW = AL(WS_TOKE + (size_t)T * 8);
constexpr size_t WS_TOKD = AL(WS_TOKW + (size_t)T * 8);
constexpr size_t WS_WGCNT = AL(WS_TOKD + (size_t)T * 8);
constexpr size_t WS_BLKE = AL(WS_WGCNT + 256 * 8 * 4);
constexpr size_t WS_ST1 = AL(WS_BLKE + (MAXRB + 8) * 4);
constexpr size_t WS_ST2 = AL(WS_ST1 + (size_t)T * 8);
constexpr size_t WS_WMIX = AL(WS_ST2 + (size_t)T * 8);
constexpr size_t WMIX_IN = 0, WMIX_POOL = (size_t)INW * 1024 * 2, WMIX_RET = WMIX_POOL + (size_t)1024 * 512 * 2, WMIX_OUT = WMIX_RET + (size_t)1024 * 1024 * 2, WMIX_IN8 = WMIX_OUT + (size_t)1024 * 1024 * 2, WMIX_BYTES = WMIX_IN8 + (size_t)2048 * 1024;
constexpr size_t WS_A = AL(WS_WMIX + WMIX_BYTES);
constexpr size_t WS_BIG = AL(WS_A + U);
constexpr size_t B_U = 0, B_Q = U / 2, B_K = U, B_V = U + U / 2, B_SG = 2 * U + U / 2, B_GP = 3 * U + U / 2, B_GR = 4 * U + U / 2, B_OF = 5 * U + U / 2, B_OB = 6 * U + U / 2, B_END = 7 * U + U / 2;
constexpr size_t B_URET = B_V, B_Y1 = B_Q, B_MIX = B_OF;
constexpr size_t F_W = 0;
constexpr size_t F_DW2 = (size_t)2 * DFF * 1024 * 2;
constexpr float W13_SCALE = 64.0f, W2_SCALE = 256.0f;
constexpr size_t F_EW13 = (size_t)2 * EFF * 1024, F_EW2 = (size_t)1024 * EFF, F_EALL = (size_t)NEXP * (F_EW13 + F_EW2);
constexpr size_t F_XS = AL(F_EALL);
constexpr size_t F_YK = AL(F_XS + (size_t)MAXRB * 256 * 1024);
constexpr size_t F_ACTM = AL(F_YK + (size_t)MAXRB * 256 * 1024 * 2);
constexpr size_t F_ACT = AL(F_DW2 + (size_t)1024 * DFF * 2);
constexpr size_t F_END_D = F_ACT + (size_t)T * DFF * 2, F_END_M = F_ACTM + (size_t)RBG * 256 * EFF;
constexpr size_t WS_END = WS_BIG + B_END;
static_assert(F_END_D <= B_END && F_END_M <= B_END, "FFN stage must fit in BIG");
static_assert(WS_END <= (size_t)1295298688, "workspace budget");

constexpr int CW_BAR = 0;
constexpr int CW_DBG = 4096;

constexpr int LDS_MAIN = 139264;
constexpr int LDS_TAB = LDS_MAIN;
constexpr int LDS_CTL = LDS_MAIN + 1024;
constexpr int LDS_BYTES = LDS_CTL + 256;

DEVINL float bf2f(unsigned b) { return __uint_as_float(b << 16); }
DEVINL float bflo(unsigned w) { return __uint_as_float(w << 16); }
DEVINL float bfhi(unsigned w) { return __uint_as_float(w & 0xffff0000u); }
typedef __bf16 bf16v2_t __attribute__((ext_vector_type(2)));
typedef float f32v2_t __attribute__((ext_vector_type(2)));
DEVINL unsigned pk2(float lo, float hi) { const f32v2_t v = {lo, hi}; return __builtin_bit_cast(unsigned, __builtin_convertvector(v, bf16v2_t)); }
DEVINL void unpk8(const u32x4 w, float (&v)[8]) { v[0] = bflo(w.x); v[1] = bfhi(w.x); v[2] = bflo(w.y); v[3] = bfhi(w.y); v[4] = bflo(w.z); v[5] = bfhi(w.z); v[6] = bflo(w.w); v[7] = bfhi(w.w); }
DEVINL u32x4 pk8(const float (&v)[8]) { u32x4 w; w.x = pk2(v[0], v[1]); w.y = pk2(v[2], v[3]); w.z = pk2(v[4], v[5]); w.w = pk2(v[6], v[7]); return w; }
typedef _Float16 f16v2_t __attribute__((ext_vector_type(2)));
DEVINL unsigned pk2h(float lo, float hi) { return __builtin_bit_cast(unsigned, __builtin_amdgcn_cvt_pkrtz(lo, hi)); }
DEVINL float h2f_bits(unsigned h) { const unsigned m = h & 0x7fffu; const unsigned f = ((h & 0x8000u) << 16) | ((m << 13) + 0x38000000u); return (m < 0x400u) ? 0.f : __uint_as_float(f); }
DEVINL float h2f_cvt(unsigned h) { float f; asm("v_cvt_f32_f16_e32 %0, %1" : "=v"(f) : "v"(h)); return f; }
DEVINL void unpk8h(const u32x4 w, float (&v)[8]) {
    v[0] = h2f_cvt(w.x); v[1] = h2f_cvt(w.x >> 16); v[2] = h2f_cvt(w.y); v[3] = h2f_cvt(w.y >> 16);
    v[4] = h2f_cvt(w.z); v[5] = h2f_cvt(w.z >> 16); v[6] = h2f_cvt(w.w); v[7] = h2f_cvt(w.w >> 16); }
DEVINL u32x4 pk8h(const float (&v)[8]) { u32x4 w; w.x = pk2h(v[0], v[1]); w.y = pk2h(v[2], v[3]); w.z = pk2h(v[4], v[5]); w.w = pk2h(v[6], v[7]); return w; }
DEVINL void ld8f(const float* p, float (&v)[8]) { const f32x4 a = *(const f32x4*)p, b = *(const f32x4*)(p + 4); v[0] = a[0]; v[1] = a[1]; v[2] = a[2]; v[3] = a[3]; v[4] = b[0]; v[5] = b[1]; v[6] = b[2]; v[7] = b[3]; }
DEVINL unsigned pk4_fp8(float a, float b, float c, float d) { int w = 0; w = __builtin_amdgcn_cvt_pk_fp8_f32(a, b, w, false); w = __builtin_amdgcn_cvt_pk_fp8_f32(c, d, w, true); return (unsigned)w; }
DEVINL bf16_t f2bf(float f) { return (bf16_t)(pk2(f, 0.f) & 0xffffu); }
DEVINL float sigmoidf_(float x) { return __builtin_amdgcn_rcpf(1.0f + __builtin_amdgcn_exp2f(-1.4426950408889634f * x)); }
DEVINL float siluf_(float x) { return x * __builtin_amdgcn_rcpf(1.0f + __builtin_amdgcn_exp2f(-1.4426950408889634f * x)); }
DEVINL f32x4 exp2_4(const f32x4 x) { f32x4 r; r[0] = __builtin_amdgcn_exp2f(x[0]); r[1] = __builtin_amdgcn_exp2f(x[1]); r[2] = __builtin_amdgcn_exp2f(x[2]); r[3] = __builtin_amdgcn_exp2f(x[3]); return r; }
DEVINL f32x4 rcp_4(const f32x4 x) { f32x4 r; r[0] = __builtin_amdgcn_rcpf(x[0]); r[1] = __builtin_amdgcn_rcpf(x[1]); r[2] = __builtin_amdgcn_rcpf(x[2]); r[3] = __builtin_amdgcn_rcpf(x[3]); return r; }
DEVINL void sigmoid8(f32x4& a0, f32x4& a1, const float nl2) {
    const f32x4 e0 = exp2_4(a0 * nl2), e1 = exp2_4(a1 * nl2);
    a0 = rcp_4(e0 + 1.0f); a1 = rcp_4(e1 + 1.0f);
}
DEVINL void swiglu8(f32x4& v0, f32x4& v1, const f32x4 a0, const f32x4 a1, const f32x4 b0, const f32x4 b1, const float nl2, const float s2) {
    const f32x4 e0 = exp2_4(a0 * nl2), e1 = exp2_4(a1 * nl2);
    const f32x4 p0 = a0 * b0, p1 = a1 * b1;
    const f32x4 r0 = rcp_4(e0 + 1.0f), r1 = rcp_4(e1 + 1.0f);
    v0 = p0 * (r0 * s2); v1 = p1 * (r1 * s2);
}
DEVINL int tid_hidden() { int t = threadIdx.x; asm volatile("" : "+v"(t)); return t; }
#define DPP_ADD(v, ctrl, rmask) v += __builtin_bit_cast(float, __builtin_amdgcn_update_dpp(0, __builtin_bit_cast(int, v), ctrl, rmask, 0xf, false))
DEVINL float wave_sum(float v) {
    DPP_ADD(v, 0xB1, 0xf);
    DPP_ADD(v, 0x4E, 0xf);
    DPP_ADD(v, 0x141, 0xf);
    DPP_ADD(v, 0x140, 0xf);
    DPP_ADD(v, 0x142, 0xa);
    DPP_ADD(v, 0x143, 0xc);
    return __builtin_bit_cast(float, __builtin_amdgcn_readlane(__builtin_bit_cast(int, v), 63));
}
DEVINL void wave_sum8(float (&v)[8], int lane) {
    float s1[4], s2[2];
#pragma unroll
    for (int e = 0; e < 4; ++e) { const auto r = __builtin_amdgcn_permlane32_swap(__float_as_uint(v[e]), __float_as_uint(v[e + 4]), false, false); s1[e] = __uint_as_float(r[0]) + __uint_as_float(r[1]); }
#pragma unroll
    for (int e = 0; e < 2; ++e) { const auto r = __builtin_amdgcn_permlane16_swap(__float_as_uint(s1[e]), __float_as_uint(s1[e + 2]), false, false); s2[e] = __uint_as_float(r[0]) + __uint_as_float(r[1]); }
    const bool hi8 = (lane & 8) != 0;
    const float tk = hi8 ? s2[1] : s2[0], ot = hi8 ? s2[0] : s2[1];
    float s3 = tk + __builtin_bit_cast(float, __builtin_amdgcn_update_dpp(0, __builtin_bit_cast(int, ot), 0x128, 0xf, 0xf, false));
    DPP_ADD(s3, 0x141, 0xf);
    DPP_ADD(s3, 0x4E, 0xf);
    DPP_ADD(s3, 0xB1, 0xf);
#pragma unroll
    for (int e = 0; e < 8; ++e) v[e] = __builtin_bit_cast(float, __builtin_amdgcn_readlane(__builtin_bit_cast(int, s3), 8 * e));
}

#define XB_TMO      128
#define XB_XCNT(j)  (256  + 64 * (j))
#define XB_XSUB(j)  (1280 + 64 * (j))
#define XB_XGEN(j)  (2304 + 64 * (j))
#define XB_TOP      3328
#define XB_TOPGEN   3392
#define XCD_BAR_WORDS 3456
#define XB_SPIN_CAP (1u << 20)
DEVINL unsigned xb_ld(unsigned* p)              { return __hip_atomic_load(p, __ATOMIC_RELAXED, __HIP_MEMORY_SCOPE_AGENT); }
DEVINL unsigned xb_add(unsigned* p, unsigned v) { return __hip_atomic_fetch_add(p, v, __ATOMIC_RELAXED, __HIP_MEMORY_SCOPE_AGENT); }
DEVINL unsigned xb_xcc_id() { return (unsigned)__builtin_amdgcn_s_getreg((3 << 11) | 20) & 0xFu; }
#define XB_SPIN(cond, bar) do { unsigned _sp = 0; while (cond) { __builtin_amdgcn_s_sleep(1); \
    if ((++_sp & 255u) == 0u) { if (xb_ld(&(bar)[XB_TMO])) break; if (_sp > XB_SPIN_CAP) { atomicAdd(&(bar)[XB_TMO], 1u); break; } } } } while (0)
struct XcdBarrier { unsigned* bar; unsigned x; volatile LAS unsigned* st; };
DEVINL XcdBarrier xcd_barrier_post(unsigned* bar, volatile LAS unsigned* st) {
    XcdBarrier b; b.bar = bar; b.x = xb_xcc_id(); b.st = st;
    if (threadIdx.x == 0) (void)xb_add(&bar[XB_XCNT(b.x)], 1u);
    return b;
}
DEVINL void xcd_barrier_complete(unsigned* bar, unsigned x, unsigned& nloc, unsigned& nx) {
    const unsigned G = gridDim.x * gridDim.y * gridDim.z;
    unsigned sum, cnt, mine, sp = 0u;
    for (;;) {
        sum = 0u; cnt = 0u; mine = 0u;
#pragma unroll
        for (unsigned j = 0; j < 16; ++j) { const unsigned c = xb_ld(&bar[XB_XCNT(j)]); sum += c; cnt += (c > 0u) ? 1u : 0u; mine = (j == x) ? c : mine; }
        if (sum == G) break;
        __builtin_amdgcn_s_sleep(1);
        if ((++sp & 255u) == 0u) { if (xb_ld(&bar[XB_TMO])) break; if (sp > XB_SPIN_CAP) { atomicAdd(&bar[XB_TMO], 1u); break; } }
    }
    nloc = mine > 0u ? mine : 1u; nx = cnt > 0u ? cnt : 1u;
}
DEVINL void xcd_barrier(const XcdBarrier& b) {
    asm volatile("s_waitcnt vmcnt(0)" ::: "memory");
    __syncthreads();
    if (threadIdx.x == 0) {
        unsigned* bar = b.bar;
        __builtin_amdgcn_s_waitcnt(0);
        unsigned nloc = b.st[0], nx = b.st[1];
        if (nloc == 0u) { xcd_barrier_complete(bar, b.x, nloc, nx); b.st[0] = nloc; b.st[1] = nx; }
        const unsigned old = xb_add(&bar[XB_XSUB(b.x)], 1u);
        const unsigned gen = old / nloc;
        if (old + 1u == (gen + 1u) * nloc) {
            __builtin_amdgcn_fence(__ATOMIC_RELEASE, "agent");
            asm volatile("s_waitcnt vmcnt(0)" ::: "memory");
            const unsigned og = xb_add(&bar[XB_TOP], 1u);
            const unsigned tg = og / nx;
            if (og + 1u == (tg + 1u) * nx) xb_add(&bar[XB_TOPGEN], 1u);
            else XB_SPIN(xb_ld(&bar[XB_TOPGEN]) == tg, bar);
            __builtin_amdgcn_fence(__ATOMIC_ACQUIRE, "agent");
            xb_add(&bar[XB_XGEN(b.x)], 1u);
            asm volatile("s_waitcnt vmcnt(0)" ::: "memory");
        } else {
            XB_SPIN(xb_ld(&bar[XB_XGEN(b.x)]) == gen, bar);
            __builtin_amdgcn_fence(__ATOMIC_ACQUIRE, "agent");
            asm volatile("s_waitcnt vmcnt(0)" ::: "memory");
        }
    }
    __syncthreads();
}

constexpr int BM = 256, BK = 64, HALF = 128, HTB = HALF * BK * 2, NXCD = 8, WGM = 8;
DEVINL int lds_byte(int r, int c) { const int st = (r >> 4) * 2 + (c >> 5), rr = r & 15, cc = c & 31, ob = rr * 64 + cc * 2; return st * 1024 + (ob ^ (((ob >> 9) & 1) << 5)); }
DEVINL void stage_rc(int b, int& R, int& C) { const int st = b / 1024, sb = b % 1024, swz = sb ^ (((sb >> 9) & 1) << 5); R = (st >> 1) * 16 + swz / 64; C = (st & 1) * 32 + (swz % 64) / 2; }
DEVINL int perm32(int rho) { const int n = rho >> 4, i = rho & 15; return 8 * (i >> 2) + 4 * n + (i & 3); }

struct Unit { int pm, pn; const char* a; const char* b; };

DEVINL bool rect_next(long L, int nM, int nN, int& pm, int& pn) {
    const int nwg = nM * nN; if (L >= nwg) return false;
    int wgid = (int)L; { const int q = nwg / NXCD, r = nwg % NXCD, xcd = wgid % NXCD, off = wgid / NXCD; wgid = (xcd < r ? xcd * (q + 1) : r * (q + 1) + (xcd - r) * q) + off; }
    const int nig = WGM * nN, gid = wgid / nig, fm = gid * WGM, gsz = (nM - fm) < WGM ? (nM - fm) : WGM;
    pm = fm + ((wgid % nig) % gsz); pn = (wgid % nig) / gsz; return true;
}
struct SchedRect {
    const char* A; const char* B; int nM, nN, G, c; size_t tstep;
    DEVINL bool next(int i, Unit& u) const { if (!rect_next((long)i * G + c, nM, nN, u.pm, u.pn)) return false; u.a = A + (size_t)u.pm * tstep; u.b = B + (size_t)u.pn * tstep; return true; }
};
struct SchedIn3 {
    const char* A; const char* B; int G, c; size_t tstep;
    DEVINL bool next(int i, Unit& u) const {
        const long L = (long)i * G + c;
        if (L < 256 * 14) { rect_next(L, 256, 14, u.pm, u.pn); }
        else { const long L2 = L - 256 * 14; if (L2 >= 16 * 6) return false; u.pm = 256 + (int)(L2 / 6); u.pn = 4 + (int)(L2 % 6); }
        u.a = A + (size_t)u.pm * tstep; u.b = B + (size_t)u.pn * tstep; return true; }
};
struct SchedMoe {
    const char* abase; const char* wbase; int eb0, eb1, eb2; int rb0, arb0, nrb, nN, G, c; size_t tstep, estride;
    DEVINL bool next(int i, Unit& u) const {
        int pm, pn; if (!rect_next((long)i * G + c, nrb, nN, pm, pn)) return false;
        u.pm = rb0 + pm; u.pn = pn;
        const int r = u.pm;
        const int e = (r >= (eb0 & 1023)) + (r >= ((eb0 >> 10) & 1023)) + (r >= ((eb0 >> 20) & 1023)) + (r >= (eb1 & 1023)) + (r >= ((eb1 >> 10) & 1023)) + (r >= ((eb1 >> 20) & 1023)) + (r >= (eb2 & 1023));
        u.a = abase + (size_t)(u.pm - arb0) * tstep; u.b = wbase + (size_t)e * estride + (size_t)pn * tstep; return true; }
};

DEVINL void moe_bounds(const int* blke, int& w0, int& w1, int& w2) {
    int b[7];
#pragma unroll
    for (int e = 0; e < 7; ++e) { int v = __builtin_amdgcn_readfirstlane(blke[1 + e]); v = v < 0 ? 0 : (v > 1023 ? 1023 : v); b[e] = v; }
    w0 = b[0] | (b[1] << 10) | (b[2] << 20); w1 = b[3] | (b[4] << 10) | (b[5] << 20); w2 = b[6];
}
typedef int v4i_t __attribute__((ext_vector_type(4)));
typedef int v8i_t __attribute__((ext_vector_type(8)));
DEVINL v8i_t cat_v8(bf16x8 lo, bf16x8 hi) { return __builtin_shufflevector(__builtin_bit_cast(v4i_t, lo), __builtin_bit_cast(v4i_t, hi), 0, 1, 2, 3, 4, 5, 6, 7); }
template <class Epi, class Sched>
DEVINL void gemm_phase(LAS unsigned char* lds, const int K, const Sched& S, const Epi& E) {
    int tid = threadIdx.x; asm volatile("" : "+v"(tid));
    const int wid = __builtin_amdgcn_readfirstlane(tid >> 6), lane = tid & 63, wr = wid >> 2, wc = wid & 3, fr = lane & 15, fq = lane >> 4;
    const int nt = K / BK;
    unsigned voffA, voffB;
    { int R, C; stage_rc(tid * 16, R, C); const int Rb = Epi::PERM ? ((R & ~31) + perm32(R & 31)) : R;
      voffA = (unsigned)(R * K + C) * 2u; voffB = (unsigned)(Rb * K + C) * 2u; }
    const size_t kstep = (size_t)(BK * 2);
    const size_t hstep = (size_t)HALF * K * 2;
    const size_t qstep = (size_t)64 * K * 2;
    const unsigned ldsw = (unsigned)wid * 1024u;
    const int aoff = lds_byte(wr * 64 + fr, fq * 8), boff = lds_byte(wc * 32 + fr, fq * 8);
#define PG8_SA(b, h) (((b) * 2 + (h)) * HTB)
#define PG8_SB(b, h) ((4 + (b) * 2 + (h)) * HTB)
#define PG8_STAGE(bufoff, gbase, voff) do { _Pragma("unroll") for (int _i = 0; _i < 2; ++_i) \
        __builtin_amdgcn_global_load_lds((const unsigned*)((const char*)(gbase) + _i * qstep + (voff)), (LAS unsigned*)(lds + (bufoff) + ldsw + _i * 8192), 16, 0, 0); } while (0)
#define PG8_LDA(dst, b, h) do { if constexpr (Epi::FP8) { _Pragma("unroll") for (int m = 0; m < 4; ++m) dst##8[m] = cat_v8(*(const LAS bf16x8*)(lds + PG8_SA(b, h) + aoff + m * 2048), *(const LAS bf16x8*)(lds + PG8_SA(b, h) + aoff + m * 2048 + 1024)); } \
        else { _Pragma("unroll") for (int m = 0; m < 4; ++m) _Pragma("unroll") for (int k = 0; k < 2; ++k) dst[m][k] = *(const LAS bf16x8*)(lds + PG8_SA(b, h) + aoff + m * 2048 + k * 1024); } } while (0)
#define PG8_LDB(dst, b, h) do { if constexpr (Epi::FP8) { _Pragma("unroll") for (int n = 0; n < 2; ++n) dst##8[n] = cat_v8(*(const LAS bf16x8*)(lds + PG8_SB(b, h) + boff + n * 2048), *(const LAS bf16x8*)(lds + PG8_SB(b, h) + boff + n * 2048 + 1024)); } \
        else { _Pragma("unroll") for (int n = 0; n < 2; ++n) _Pragma("unroll") for (int k = 0; k < 2; ++k) dst[n][k] = *(const LAS bf16x8*)(lds + PG8_SB(b, h) + boff + n * 2048 + k * 1024); } } while (0)
#define PG8_MMA(ai, bj, At, Bt) do { __builtin_amdgcn_s_setprio(1); \
        if constexpr (Epi::FP8) { _Pragma("unroll") for (int m = 0; m < 4; ++m) _Pragma("unroll") for (int n = 0; n < 2; ++n) \
            asm volatile("v_mfma_scale_f32_16x16x128_f8f6f4 %0, %1, %2, %0, %3, %3 op_sel_hi:[0,0,0]" : "+v"(acc[ai][bj][m][n]) : "v"(Bt##8[n]), "v"(At##8[m]), "v"(sc1)); } \
        else { _Pragma("unroll") for (int m = 0; m < 4; ++m) _Pragma("unroll") for (int n = 0; n < 2; ++n) _Pragma("unroll") for (int k = 0; k < 2; ++k) \
            acc[ai][bj][m][n] = __builtin_amdgcn_mfma_f32_16x16x32_bf16(Bt[n][k], At[m][k], acc[ai][bj][m][n], 0, 0, 0); } \
        __builtin_amdgcn_s_setprio(0); } while (0)
#define PG8_MFMA_DRAIN() do { if constexpr (Epi::FP8) { asm volatile("s_nop 15\n\ts_nop 15" : "+v"(acc[0][0][0][0]), "+v"(acc[0][0][0][1]), "+v"(acc[0][0][1][0]), "+v"(acc[0][0][1][1]), "+v"(acc[0][0][2][0]), "+v"(acc[0][0][2][1]), "+v"(acc[0][0][3][0]), "+v"(acc[0][0][3][1]), "+v"(acc[0][1][0][0]), "+v"(acc[0][1][0][1]), "+v"(acc[0][1][1][0]), "+v"(acc[0][1][1][1]), "+v"(acc[0][1][2][0]), "+v"(acc[0][1][2][1]), "+v"(acc[0][1][3][0]), "+v"(acc[0][1][3][1])); asm volatile("" : "+v"(acc[1][0][0][0]), "+v"(acc[1][0][0][1]), "+v"(acc[1][0][1][0]), "+v"(acc[1][0][1][1]), "+v"(acc[1][0][2][0]), "+v"(acc[1][0][2][1]), "+v"(acc[1][0][3][0]), "+v"(acc[1][0][3][1]), "+v"(acc[1][1][0][0]), "+v"(acc[1][1][0][1]), "+v"(acc[1][1][1][0]), "+v"(acc[1][1][1][1]), "+v"(acc[1][1][2][0]), "+v"(acc[1][1][2][1]), "+v"(acc[1][1][3][0]), "+v"(acc[1][1][3][1])); } } while (0)
#define PG8_WAIT_V(n) asm volatile("s_waitcnt vmcnt(" #n ")" ::: "memory")
#define PG8_WAIT_L(n) asm volatile("s_waitcnt lgkmcnt(" #n ")" ::: "memory")
#define PG8_WAIT_VN(n) asm volatile("s_waitcnt vmcnt(%0)" :: "n"(n) : "memory")
#define PG8_BAR __builtin_amdgcn_s_barrier()
#define PG8_SCHED __builtin_amdgcn_sched_barrier(0)
    Unit cur, nxt; int ui = 0;
    if (!S.next(0, cur)) return;
    f32x4 acc[2][2][4][2];
#pragma unroll
    for (int a = 0; a < 2; ++a)
#pragma unroll
        for (int b = 0; b < 2; ++b)
#pragma unroll
            for (int m = 0; m < 4; ++m)
#pragma unroll
                for (int n = 0; n < 2; ++n) acc[a][b][m][n] = (f32x4){0.f, 0.f, 0.f, 0.f};
    int sc1 = 0x7F7F7F7F; asm volatile("" : "+v"(sc1));
    bf16x8 At[4][2], B0[2][2], B1[2][2]; v8i_t At8[4], B08[2], B18[2];
    const char* cA = cur.a; const char* cB = cur.b;
    PG8_STAGE(PG8_SB(0, 0), cB, voffB); PG8_STAGE(PG8_SA(0, 0), cA, voffA); PG8_STAGE(PG8_SB(0, 1), cB + hstep, voffB); PG8_STAGE(PG8_SA(0, 1), cA + hstep, voffA);
    PG8_STAGE(PG8_SB(1, 0), cB + kstep, voffB); PG8_STAGE(PG8_SA(1, 0), cA + kstep, voffA); PG8_STAGE(PG8_SB(1, 1), cB + hstep + kstep, voffB);
    PG8_WAIT_V(6); PG8_BAR;
    if (wr == 1) PG8_BAR;
    for (;;) {
        const bool has_next = S.next(ui + 1, nxt);
        const char* nA = has_next ? nxt.a : cA; const char* nB = has_next ? nxt.b : cB;
        int epi_flag = (ui > 0) ? 1 : 0;
        for (int t = 0; t < nt; t += 2) {
            const bool last = (t == nt - 2);
            const char* a1 = cA + (size_t)(t + 1) * kstep;
            const char* a2 = last ? nA : cA + (size_t)(t + 2) * kstep; const char* b2 = last ? nB : cB + (size_t)(t + 2) * kstep;
            const char* a3 = a2 + kstep; const char* b3 = b2 + kstep;
            int after_epi = 0;
            if constexpr (Epi::FP8) { after_epi = __builtin_amdgcn_readfirstlane(epi_flag); asm volatile("" : "+s"(after_epi)); epi_flag = 0; }
            PG8_LDB(B0, 0, 0); PG8_LDB(B1, 0, 1); PG8_LDA(At, 0, 0); PG8_STAGE(PG8_SA(1, 1), a1 + hstep, voffA);
            if (Epi::FP8 && after_epi) PG8_WAIT_VN(8 + Epi::NST); else PG8_WAIT_V(8);
            PG8_WAIT_L(0); PG8_BAR; PG8_MMA(0, 0, At, B0); PG8_MMA(0, 1, At, B1); PG8_BAR; PG8_SCHED;
            PG8_LDA(At, 0, 1); PG8_STAGE(PG8_SB(0, 0), b2, voffB); PG8_STAGE(PG8_SB(0, 1), b2 + hstep, voffB); PG8_STAGE(PG8_SA(0, 0), a2, voffA);
            if (Epi::FP8 && after_epi) PG8_WAIT_VN(8 + Epi::NST); else PG8_WAIT_V(8);
            PG8_WAIT_L(0); PG8_BAR; PG8_MMA(1, 0, At, B0); PG8_MMA(1, 1, At, B1); PG8_BAR; PG8_SCHED;
            PG8_LDB(B0, 1, 0); PG8_LDB(B1, 1, 1); PG8_LDA(At, 1, 0); PG8_STAGE(PG8_SA(0, 1), a2 + hstep, voffA);
            PG8_WAIT_V(8); PG8_WAIT_L(0); PG8_BAR; PG8_MMA(0, 0, At, B0); PG8_MMA(0, 1, At, B1); PG8_BAR; PG8_SCHED;
            PG8_LDA(At, 1, 1); PG8_STAGE(PG8_SB(1, 0), b3, voffB); PG8_STAGE(PG8_SB(1, 1), b3 + hstep, voffB); PG8_STAGE(PG8_SA(1, 0), a3, voffA);
            PG8_WAIT_V(8); PG8_WAIT_L(0); PG8_BAR; PG8_MMA(1, 0, At, B0); PG8_MMA(1, 1, At, B1); PG8_BAR; PG8_SCHED;
        }
        PG8_MFMA_DRAIN();
        {
            int tz = threadIdx.x; asm volatile("" : "+v"(tz)); const int wz = __builtin_amdgcn_readfirstlane(tz >> 6), lz = tz & 63;
            E(acc, cur, wz >> 2, wz & 3, lz & 15, lz >> 4);
        }
        if (!has_next) break;
#pragma unroll
        for (int a = 0; a < 2; ++a)
#pragma unroll
            for (int b = 0; b < 2; ++b)
#pragma unroll
                for (int m = 0; m < 4; ++m)
#pragma unroll
                    for (int n = 0; n < 2; ++n) acc[a][b][m][n] = (f32x4){0.f, 0.f, 0.f, 0.f};
        cur = nxt; cA = nA; cB = nB; ++ui;
    }
    PG8_WAIT_V(0);
    if (wr == 0) PG8_BAR;
    PG8_BAR;
#undef PG8_SA
#undef PG8_SB
#undef PG8_STAGE
#undef PG8_LDA
#undef PG8_LDB
#undef PG8_MMA
#undef PG8_MFMA_DRAIN
#undef PG8_WAIT_V
#undef PG8_WAIT_L
#undef PG8_WAIT_VN
#undef PG8_BAR
#undef PG8_SCHED
}

typedef const f32x4 (&AccRef)[2][2][4][2];

struct EpiIn {
    static constexpr bool PERM = true, FP8 = false; static constexpr int NST = 16;
    bf16_t* big; const float* rope;
    template <int KIND> DEVINL void body(AccRef acc, bf16_t* dst, int ldc, int row0, int col0, bool lat, int wc, int fq) const {
        constexpr float ks = (KIND == 2) ? KSCALE : 1.0f;
        f32x4 csa[2][4], csb[2][4];
        if (KIND == 1 || KIND == 2) {
#pragma unroll
            for (int ai = 0; ai < 2; ++ai)
#pragma unroll
                for (int m = 0; m < 4; ++m) { const float* rp = rope + ((size_t)((row0 + ai * HALF + m * 16) & 4095) * 64 + wc * 16 + 4 * fq) * 2; csa[ai][m] = *(const f32x4*)rp; csb[ai][m] = *(const f32x4*)(rp + 4); }
            const f32x4 ident = (f32x4){1.f, 0.f, 1.f, 0.f};
#pragma unroll
            for (int ai = 0; ai < 2; ++ai)
#pragma unroll
                for (int m = 0; m < 4; ++m) { csa[ai][m] = lat ? csa[ai][m] : ident; csb[ai][m] = lat ? csb[ai][m] : ident; }
        }
#pragma unroll
        for (int ai = 0; ai < 2; ++ai)
#pragma unroll
            for (int m = 0; m < 4; ++m) {
                const unsigned ro = ((unsigned)(row0 + ai * HALF + m * 16) * (unsigned)ldc + (unsigned)col0) * 2u;
#pragma unroll
                for (int bj = 0; bj < 2; ++bj) {
                    f32x4 v0 = acc[ai][bj][m][0], v1 = acc[ai][bj][m][1];
                    if (KIND == 1 || KIND == 2) {
                        const f32x4 cs0 = csa[ai][m], cs1 = csb[ai][m];
                        f32x4 r0, r1;
                        r0[0] = (v0[0] * cs0[0] - v0[1] * cs0[1]) * ks; r0[1] = (v0[0] * cs0[1] + v0[1] * cs0[0]) * ks;
                        r0[2] = (v0[2] * cs0[2] - v0[3] * cs0[3]) * ks; r0[3] = (v0[2] * cs0[3] + v0[3] * cs0[2]) * ks;
                        r1[0] = (v1[0] * cs1[0] - v1[1] * cs1[1]) * ks; r1[1] = (v1[0] * cs1[1] + v1[1] * cs1[0]) * ks;
                        r1[2] = (v1[2] * cs1[2] - v1[3] * cs1[3]) * ks; r1[3] = (v1[2] * cs1[3] + v1[3] * cs1[2]) * ks;
                        v0 = r0; v1 = r1;
                    } else if (KIND == 3) {
                        f32x4 g0 = v0, g1 = v1; sigmoid8(g0, g1, -1.4426950408889634f); v0 *= g0; v1 *= g1;
                    } else if (KIND == 4) {
                        sigmoid8(v0, v1, -1.4426950408889634f);
                    }
                    u32x4 w; w.x = pk2(v0[0], v0[1]); w.y = pk2(v0[2], v0[3]); w.z = pk2(v1[0], v1[1]); w.w = pk2(v1[2], v1[3]);
                    *(u32x4*)((char*)dst + ro + (unsigned)(bj * HALF * 2)) = w;
                }
                asm volatile("" ::: "memory");
            }
    }
    DEVINL void operator()(AccRef acc, const Unit& u, int wr, int wc, int fr, int fq) const {
        const int pn = u.pn; bf16_t* dst; int ldc, colt, kind;
        if (pn < 2)       { dst = (bf16_t*)((char*)big + B_U);  ldc = 512;  colt = pn * 256;        kind = 0; }
        else if (pn < 4)  { dst = (bf16_t*)((char*)big + B_Q);  ldc = 512;  colt = (pn - 2) * 256;  kind = 1; }
        else if (pn < 6)  { dst = (bf16_t*)((char*)big + B_K);  ldc = 512;  colt = (pn - 4) * 256;  kind = 2; }
        else if (pn < 10) { dst = (bf16_t*)((char*)big + B_V);  ldc = 1024; colt = (pn - 6) * 256;  kind = 0; }
        else if (pn < 14) { dst = (bf16_t*)((char*)big + B_SG); ldc = 1024; colt = (pn - 10) * 256; kind = 3; }
        else if (pn < 18) { dst = (bf16_t*)((char*)big + B_GP); ldc = 1024; colt = (pn - 14) * 256; kind = 4; }
        else              { dst = (bf16_t*)((char*)big + B_GR); ldc = 1024; colt = (pn - 18) * 256; kind = 4; }
        const int row0 = u.pm * BM + wr * 64 + fr, col0 = colt + wc * 32 + 8 * fq;
        const bool lat = u.pm < 256;
        if (kind == 0) body<0>(acc, dst, ldc, row0, col0, lat, wc, fq);
        else if (kind == 1) body<1>(acc, dst, ldc, row0, col0, lat, wc, fq);
        else if (kind == 2) body<2>(acc, dst, ldc, row0, col0, lat, wc, fq);
        else if (kind == 3) body<3>(acc, dst, ldc, row0, col0, lat, wc, fq);
        else body<4>(acc, dst, ldc, row0, col0, lat, wc, fq);
    }
};

template <int MODE  > struct EpiGate {
    static constexpr bool PERM = true, FP8 = false; static constexpr int NST = 16;
    bf16_t* out; const bf16_t* gate; const bf16_t* y1;
    DEVINL void operator()(AccRef acc, const Unit& u, int wr, int wc, int fr, int fq) const {
        const int row0 = u.pm * BM + wr * 64 + fr, col0 = u.pn * BM + wc * 32 + 8 * fq;
#pragma unroll
        for (int ai = 0; ai < 2; ++ai) {
            u32x4 g[4][2], y[4][2];
#pragma unroll
            for (int m = 0; m < 4; ++m)
#pragma unroll
                for (int bj = 0; bj < 2; ++bj) {
                    const size_t off = (size_t)(row0 + ai * HALF + m * 16) * 1024 + col0 + bj * HALF;
                    if (MODE != 2) g[m][bj] = *(const u32x4*)(gate + off);
                    if (MODE == 1) y[m][bj] = *(const u32x4*)(y1 + off);
                }
#pragma unroll
            for (int m = 0; m < 4; ++m)
#pragma unroll
                for (int bj = 0; bj < 2; ++bj) {
                    const size_t off = (size_t)(row0 + ai * HALF + m * 16) * 1024 + col0 + bj * HALF;
                    f32x4 v0 = acc[ai][bj][m][0], v1 = acc[ai][bj][m][1];
                    if (MODE != 2) {
                        const u32x4 gg = g[m][bj];
                        v0[0] *= bflo(gg.x); v0[1] *= bfhi(gg.x); v0[2] *= bflo(gg.y); v0[3] *= bfhi(gg.y);
                        v1[0] *= bflo(gg.z); v1[1] *= bfhi(gg.z); v1[2] *= bflo(gg.w); v1[3] *= bfhi(gg.w);
                    }
                    if (MODE == 1) {
                        const u32x4 yy = y[m][bj];
                        v0[0] += bflo(yy.x); v0[1] += bfhi(yy.x); v0[2] += bflo(yy.y); v0[3] += bfhi(yy.y);
                        v1[0] += bflo(yy.z); v1[1] += bfhi(yy.z); v1[2] += bflo(yy.w); v1[3] += bfhi(yy.w);
                    }
                    u32x4 w; w.x = pk2(v0[0], v0[1]); w.y = pk2(v0[2], v0[3]); w.z = pk2(v1[0], v1[1]); w.w = pk2(v1[2], v1[3]);
                    *(u32x4*)(out + off) = w;
                }
            asm volatile("" ::: "memory");
        }
    }
};

template <bool X0, bool ST, bool F8 = false>
struct EpiRes {
    static constexpr bool PERM = true, FP8 = F8;
     static constexpr int NST = 16;
    const float* x0_lat; const float* x0_ctx; bf16_t* strm; const float* modl; int which;
    const float* st; const float* gam; const float* bet;
    DEVINL void operator()(AccRef acc, const Unit& u, int wr, int wc, int fr, int fq) const {
        const bool lat = u.pm < 256;
        const float* mv = modl + ((size_t)(lat ? (u.pm >> 4) : 16) * 6 + which) * 1024;
        const int row0 = u.pm * BM + wr * 64 + fr, col0 = u.pn * BM + wc * 32 + 8 * fq;
        const char* x0 = nullptr; if (X0) x0 = (const char*)(lat ? x0_lat : x0_ctx - (size_t)NLAT * 1024);
        const unsigned so0 = ((unsigned)row0 * 1024u + (unsigned)col0) * 2u;
#pragma unroll
        for (int bj = 0; bj < 2; ++bj) {
            const int col = col0 + bj * HALF;
            float bv[8], gv[8], ev[8];
            ld8f(mv + col, bv); if (ST) { ld8f(gam + col, gv); ld8f(bet + col, ev); }
            f32v2_t bv2[4], G2[4], E2[4];
#pragma unroll
            for (int k = 0; k < 4; ++k) { bv2[k] = (f32v2_t){bv[2 * k], bv[2 * k + 1]}; if (F8) bv2[k] *= (1.0f / W2_SCALE);
                if (ST) { G2[k] = (f32v2_t){gv[2 * k], gv[2 * k + 1]} * ALPHA; E2[k] = (f32v2_t){ev[2 * k], ev[2 * k + 1]} * ALPHA; } }
            constexpr int NA = (X0 || F8) ? 1 : 2;
#pragma unroll
            for (int ab = 0; ab < 2; ab += NA) {
                u32x4 xr[NA][4]; f32x4 xa[NA][4], xb[NA][4]; float mean[NA][4], rstd[NA][4];
#pragma unroll
                for (int a = 0; a < NA; ++a)
#pragma unroll
                    for (int m = 0; m < 4; ++m) {
                        const unsigned rr = (unsigned)((ab + a) * HALF + m * 16);
                        const unsigned so = so0 + rr * 2048u + (unsigned)(bj * HALF * 2);
                        if (ST) { const float2 s2 = *(const float2*)((const char*)st + ((unsigned)row0 + rr) * 8u); mean[a][m] = s2.x; rstd[a][m] = s2.y; }
                        if (X0) { const char* xp = x0 + so * 2u; xa[a][m] = *(const f32x4*)xp; xb[a][m] = *(const f32x4*)(xp + 16); }
                        else xr[a][m] = *(const u32x4*)((const char*)strm + so);
                    }
#pragma unroll
                for (int a = 0; a < NA; ++a)
#pragma unroll
                    for (int m = 0; m < 4; ++m) {
                        const int ai = ab + a;
                        const unsigned so = so0 + (unsigned)(ai * HALF + m * 16) * 2048u + (unsigned)(bj * HALF * 2);
                        float xv[8];
                        if (X0) { const f32x4 p0 = xa[a][m], p1 = xb[a][m]; xv[0] = p0[0]; xv[1] = p0[1]; xv[2] = p0[2]; xv[3] = p0[3]; xv[4] = p1[0]; xv[5] = p1[1]; xv[6] = p1[2]; xv[7] = p1[3]; }
                        else unpk8h(xr[a][m], xv);
                        const f32x4 a0 = acc[ai][bj][m][0], a1 = acc[ai][bj][m][1];
                        float zv[8]; float ra = 1.0f, rb = 0.0f; if (ST) { ra = rstd[a][m]; rb = -mean[a][m] * ra; }
#pragma unroll
                        for (int k = 0; k < 4; ++k) {
                            const f32v2_t x2 = (f32v2_t){xv[2 * k], xv[2 * k + 1]};
                            const f32v2_t c2 = (k < 2) ? (f32v2_t){a0[(2 * k) & 3], a0[(2 * k + 1) & 3]} : (f32v2_t){a1[(2 * k) & 3], a1[(2 * k + 1) & 3]};
                            f32v2_t z;
                            if (ST) { const f32v2_t xn = x2 * ra + rb; z = xn * G2[k] + (bv2[k] * c2 + E2[k]); }
                            else z = x2 * ALPHA + bv2[k] * c2;
                            zv[2 * k] = z.x; zv[2 * k + 1] = z.y;
                        }
                        *(u32x4*)((char*)strm + so) = pk8h(zv);
                    }
                asm volatile("" ::: "memory");
            }
        }
    }
};

struct EpiSig8 {
    static constexpr bool PERM = true, FP8 = true; static constexpr int NST = 16;
    bf16_t* big;
    DEVINL void operator()(AccRef acc, const Unit& u, int wr, int wc, int fr, int fq) const {
        bf16_t* dst = (bf16_t*)((char*)big + (u.pn < 4 ? B_GP : B_GR));
        const int row0 = u.pm * BM + wr * 64 + fr, col0 = (u.pn & 3) * 256 + wc * 32 + 8 * fq;
        constexpr float s = 1.0f / W13_SCALE;
#pragma unroll
        for (int ai = 0; ai < 2; ++ai)
#pragma unroll
            for (int m = 0; m < 4; ++m) {
                bf16_t* rowp = dst + (size_t)(row0 + ai * HALF + m * 16) * 1024 + col0;
#pragma unroll
                for (int bj = 0; bj < 2; ++bj) { f32x4 v0 = acc[ai][bj][m][0], v1 = acc[ai][bj][m][1];
                    sigmoid8(v0, v1, -1.4426950408889634f * s);
                    u32x4 w; w.x = pk2(v0[0], v0[1]); w.y = pk2(v0[2], v0[3]); w.z = pk2(v1[0], v1[1]); w.w = pk2(v1[2], v1[3]);
                    *(u32x4*)(rowp + bj * HALF) = w; }
            }
    }
};
struct EpiSwiglu8 {
    static constexpr bool PERM = true, FP8 = true; static constexpr int NST = 8;
    unsigned char* act; int ldc; int rb0;
    DEVINL void operator()(AccRef acc, const Unit& u, int wr, int wc, int fr, int fq) const {
        const int row0 = (u.pm - rb0) * BM + wr * 64 + fr, col0 = u.pn * HALF + wc * 32 + 8 * fq;
        constexpr float s = 1.0f / W13_SCALE;
#pragma unroll
        for (int ai = 0; ai < 2; ++ai)
#pragma unroll
            for (int m = 0; m < 4; ++m) {
                f32x4 v0, v1; swiglu8(v0, v1, acc[ai][0][m][0], acc[ai][0][m][1], acc[ai][1][m][0], acc[ai][1][m][1], -1.4426950408889634f * s, s * s);
                u32x2 w; w.x = pk4_fp8(v0[0], v0[1], v0[2], v0[3]); w.y = pk4_fp8(v1[0], v1[1], v1[2], v1[3]);
                *(u32x2*)(act + (size_t)(row0 + ai * HALF + m * 16) * ldc + col0) = w;
            }
    }
};
struct EpiPlain8 {
    static constexpr bool PERM = true, FP8 = true; static constexpr int NST = 16;
    bf16_t* out; float scale;
    DEVINL void operator()(AccRef acc, const Unit& u, int wr, int wc, int fr, int fq) const {
        const int row0 = u.pm * BM + wr * 64 + fr, col0 = u.pn * BM + wc * 32 + 8 * fq;
#pragma unroll
        for (int ai = 0; ai < 2; ++ai)
#pragma unroll
            for (int m = 0; m < 4; ++m) {
                const size_t off = (size_t)(row0 + ai * HALF + m * 16) * 1024 + col0;
#pragma unroll
                for (int bj = 0; bj < 2; ++bj) { const f32x4 v0 = acc[ai][bj][m][0] * scale, v1 = acc[ai][bj][m][1] * scale;
                    u32x4 w; w.x = pk2(v0[0], v0[1]); w.y = pk2(v0[2], v0[3]); w.z = pk2(v1[0], v1[1]); w.w = pk2(v1[2], v1[3]);
                    *(u32x4*)(out + off + bj * HALF) = w; }
            }
    }
};
struct EpiSwiglu8b {
    static constexpr bool PERM = true, FP8 = true; static constexpr int NST = 8;
    bf16_t* act; int ldc;
    DEVINL void operator()(AccRef acc, const Unit& u, int wr, int wc, int fr, int fq) const {
        const int row0 = u.pm * BM + wr * 64 + fr, col0 = u.pn * HALF + wc * 32 + 8 * fq;
        constexpr float s = 1.0f / W13_SCALE;
#pragma unroll
        for (int ai = 0; ai < 2; ++ai)
#pragma unroll
            for (int m = 0; m < 4; ++m) {
                f32x4 v0, v1; swiglu8(v0, v1, acc[ai][0][m][0], acc[ai][0][m][1], acc[ai][1][m][0], acc[ai][1][m][1], -1.4426950408889634f * s, s * s);
                u32x4 w; w.x = pk2(v0[0], v0[1]); w.y = pk2(v0[2], v0[3]); w.z = pk2(v1[0], v1[1]); w.w = pk2(v1[2], v1[3]);
                *(u32x4*)(act + (size_t)(row0 + ai * HALF + m * 16) * ldc + col0) = w;
            }
    }
};

struct Params { const float* in[24]; float* out; unsigned char* ws; int ph_lo, ph_hi; };
enum { I_X = 0, I_C, I_CTX, I_CCTX, I_ADAW, I_ADAB, I_WIN, I_POOLW, I_POOLS, I_WPOOLOUT, I_WRETOUT, I_DECAY, I_WOUT, I_LNMG, I_LNMB, I_LNFG, I_LNFB, I_FW1, I_FW3, I_FW2, I_ROUTER, I_MW1, I_MW3, I_MW2 };

constexpr int PH_PRO_A = 0, PH_PRO_B = 1, PH_L0 = 2, PH_PER_L = 20, NPH = PH_L0 + DEPTH * PH_PER_L;
enum { Q_IN = 0, Q_POOLV, Q_RET, Q_COMB, Q_MIX, Q_OUT, Q_LN1, Q_F0, Q_F1  , Q_LN2 = 18 };

template <class RowMap>
DEVINL void cvt_T(LAS float* tl, const float* __restrict__ src, int K, int N, bf16_t* __restrict__ dst, RowMap rm, int rot) {
    const int tid = tid_hidden(), G = gridDim.x;
    const int tn = N / 128, ntile = (K / 128) * tn;
    const int r = tid >> 5, c4 = (tid & 31) * 4;
    const int nl = tid & 127, kq = tid >> 7;
    f32x4 v[8];
    int tile = (blockIdx.x + rot) % G;
    if (tile < ntile) { const int k0 = (tile / tn) * 128, n0 = (tile % tn) * 128;
#pragma unroll
        for (int q = 0; q < 8; ++q) v[q] = *(const f32x4*)(src + (size_t)(k0 + r + 16 * q) * N + n0 + c4); }
    for (; tile < ntile; tile += G) {
        const int k0 = (tile / tn) * 128, n0 = (tile % tn) * 128;
#pragma unroll
        for (int q = 0; q < 8; ++q) *(LAS f32x4*)(tl + (r + 16 * q) * 132 + c4) = v[q];
        __syncthreads();
        const int nt2 = tile + G;
        if (nt2 < ntile) { const int k2 = (nt2 / tn) * 128, n2 = (nt2 % tn) * 128;
#pragma unroll
            for (int q = 0; q < 8; ++q) v[q] = *(const f32x4*)(src + (size_t)(k2 + r + 16 * q) * N + n2 + c4); }
        bf16_t* drow = dst + (size_t)rm(n0 + nl) * K + k0 + kq * 32;
#pragma unroll
        for (int h = 0; h < 4; ++h) { float e[8];
#pragma unroll
            for (int j = 0; j < 8; ++j) e[j] = tl[(kq * 32 + h * 8 + j) * 132 + nl];
            u32x4 w; w.x = pk2(e[0], e[1]); w.y = pk2(e[2], e[3]); w.z = pk2(e[4], e[5]); w.w = pk2(e[6], e[7]);
            *(u32x4*)(drow + h * 8) = w; }
        __syncthreads();
    }
}
template <class RowMap>
DEVINL void cvt_T8(LAS float* tl, const float* __restrict__ src, int K, int N, unsigned char* __restrict__ dst, RowMap rm, int rot, float scale, int ld = 0) {
    if (ld == 0) ld = N;
    const int tid = tid_hidden(), G = gridDim.x;
    const int tn = N / 128, ntile = (K / 128) * tn;
    const int r = tid >> 5, c4 = (tid & 31) * 4;
    const int nl = tid & 127, kq = tid >> 7;
    f32x4 v[8];
    int tile = (blockIdx.x + rot) % G;
    if (tile < ntile) { const int k0 = (tile / tn) * 128, n0 = (tile % tn) * 128;
#pragma unroll
        for (int q = 0; q < 8; ++q) v[q] = *(const f32x4*)(src + (size_t)(k0 + r + 16 * q) * ld + n0 + c4); }
    for (; tile < ntile; tile += G) {
        const int k0 = (tile / tn) * 128, n0 = (tile % tn) * 128;
#pragma unroll
        for (int q = 0; q < 8; ++q) *(LAS f32x4*)(tl + (r + 16 * q) * 132 + c4) = v[q] * scale;
        __syncthreads();
        const int nt2 = tile + G;
        if (nt2 < ntile) { const int k2 = (nt2 / tn) * 128, n2 = (nt2 % tn) * 128;
#pragma unroll
            for (int q = 0; q < 8; ++q) v[q] = *(const f32x4*)(src + (size_t)(k2 + r + 16 * q) * ld + n2 + c4); }
        unsigned char* drow = dst + (size_t)rm(n0 + nl) * K + k0 + kq * 32;
#pragma unroll
        for (int h = 0; h < 2; ++h) { float e[16];
#pragma unroll
            for (int j = 0; j < 16; ++j) e[j] = tl[(kq * 32 + h * 16 + j) * 132 + nl];
            u32x4 w; w.x = pk4_fp8(e[0], e[1], e[2], e[3]); w.y = pk4_fp8(e[4], e[5], e[6], e[7]); w.z = pk4_fp8(e[8], e[9], e[10], e[11]); w.w = pk4_fp8(e[12], e[13], e[14], e[15]);
            *(u32x4*)(drow + h * 16) = w; }
        __syncthreads();
    }
}
struct MapId { DEVINL int operator()(int n) const { return n; } };
struct MapIn { DEVINL int operator()(int n) const { if (n < 512 || n >= 1536) return n; const int j = (n - 512) & 127, base = n - j; return base + (j < 64 ? 2 * j : 2 * (j - 64) + 1); } };
struct MapGU { int off; DEVINL int operator()(int n) const { return (n >> 7) * 256 + (n & 127) + off; } };

DEVINL void convert_mixer_weights(const Params& p, LAS unsigned char* lds, int l) {
    LAS float* tl = (LAS float*)lds;
    unsigned char* wm = p.ws + WS_WMIX;
    cvt_T(tl, p.in[I_WIN] + (size_t)l * 1024 * INW, 1024, INW, (bf16_t*)(wm + WMIX_IN), MapIn(), 0);
    cvt_T(tl, p.in[I_WRETOUT] + (size_t)l * 1024 * 1024, 1024, 1024, (bf16_t*)(wm + WMIX_RET), MapId(), 128);
    cvt_T(tl, p.in[I_WOUT] + (size_t)l * 1024 * 1024, 1024, 1024, (bf16_t*)(wm + WMIX_OUT), MapId(), 0);
    cvt_T8(tl, p.in[I_WIN] + (size_t)l * 1024 * INW + 3584, 1024, 2048, wm + WMIX_IN8, MapId(), 96, W13_SCALE, INW);
    const int tid = tid_hidden(), G = gridDim.x;
    LAS float* sW = (LAS float*)lds;
    LAS float* sP = (LAS float*)(lds + 32768);
    const float* pw = p.in[I_POOLW] + (size_t)l * 4 * 128 * 128; const float* ps = p.in[I_POOLS] + (size_t)l * 512; const float* wo = p.in[I_WPOOLOUT] + (size_t)l * 512 * 1024;
    bf16_t* dst = (bf16_t*)(wm + WMIX_POOL);
    for (int item = blockIdx.x; item < 256; item += G) {
        const int g = item >> 6, n0 = (item & 63) * 16;
        __syncthreads();
        for (int i = tid; i < 128 * 16; i += 512) { const int d = i >> 4, n = i & 15; sW[i] = ps[g * 128 + d] * wo[(size_t)(g * 128 + d) * 1024 + n0 + n]; }
        for (int i = tid; i < 128 * 128; i += 512) { const int c = i >> 7, d = i & 127; sP[c * 129 + d] = pw[(size_t)g * 16384 + i]; }
        __syncthreads();
        const int n = tid & 15, rq = tid >> 4;
        float a[4];
#pragma unroll
        for (int j = 0; j < 4; ++j) a[j] = 0.f;
        for (int d = 0; d < 128; ++d) { const float w = sW[d * 16 + n];
#pragma unroll
            for (int j = 0; j < 4; ++j) a[j] += sP[(rq * 4 + j) * 129 + d] * w; }
        u32x2 w0; w0.x = pk2(a[0], a[1]); w0.y = pk2(a[2], a[3]);
        *(u32x2*)(dst + (size_t)(n0 + n) * 512 + g * 128 + rq * 4) = w0;
    }
    __syncthreads();
}
DEVINL void convert_ffn_weights(const Params& p, LAS unsigned char* lds, int l) {
    LAS float* tl = (LAS float*)lds;
    unsigned char* fw = p.ws + WS_BIG + F_W;
    const int li = l >> 1;
    if ((l & 1) == 0) {
        cvt_T8(tl, p.in[I_FW1] + (size_t)li * 1024 * DFF, 1024, DFF, fw, MapGU{0}, 0, W13_SCALE);
        cvt_T8(tl, p.in[I_FW3] + (size_t)li * 1024 * DFF, 1024, DFF, fw, MapGU{128}, 64, W13_SCALE);
        cvt_T8(tl, p.in[I_FW2] + (size_t)li * DFF * 1024, DFF, 1024, fw + F_DW2, MapId(), 128, W2_SCALE);
    } else {
        for (int e = 0; e < NEXP; ++e) {
            const size_t so = ((size_t)li * NEXP + e) * 1024 * EFF;
            cvt_T8(tl, p.in[I_MW1] + so, 1024, EFF, fw + (size_t)e * F_EW13, MapGU{0}, e * 32, W13_SCALE);
            cvt_T8(tl, p.in[I_MW3] + so, 1024, EFF, fw + (size_t)e * F_EW13, MapGU{128}, e * 32 + 16, W13_SCALE);
            cvt_T8(tl, p.in[I_MW2] + so, EFF, 1024, fw + (size_t)NEXP * F_EW13 + (size_t)e * F_EW2, MapId(), e * 32 + 8, W2_SCALE);
        }
    }
}

DEVINL void adaln_phase(const Params& p, LAS unsigned char* lds) {
    const int tid = tid_hidden(), G = gridDim.x;
    LAS float* s = (LAS float*)lds;
    LAS float* red = (LAS float*)(lds + 17 * 1024 * 4);
    for (int i = tid; i < 17 * 1024; i += 512) { const float v = i < 16 * 1024 ? p.in[I_C][i] : p.in[I_CCTX][i - 16 * 1024]; s[i] = v / (1.0f + __expf(-v)); }
    __syncthreads();
    float* mod = (float*)(p.ws + WS_MOD);
    for (int item = blockIdx.x; item < 4 * 96; item += G) {
        const int l = item / 96, n = (item % 96) * 64 + (tid & 63), kq = tid >> 6;
        const float* w = p.in[I_ADAW] + (size_t)l * 1024 * 6144 + n;
        float a[17];
#pragma unroll
        for (int r = 0; r < 17; ++r) a[r] = 0.f;
#pragma unroll 4
        for (int k = kq * 128; k < kq * 128 + 128; k += 4) { const float w0 = w[(size_t)k * 6144], w1 = w[(size_t)(k + 1) * 6144], w2 = w[(size_t)(k + 2) * 6144], w3 = w[(size_t)(k + 3) * 6144];
#pragma unroll
            for (int r = 0; r < 17; ++r) { const f32x4 sv = *(const LAS f32x4*)(s + r * 1024 + k); a[r] += sv[0] * w0 + sv[1] * w1 + sv[2] * w2 + sv[3] * w3; } }
#pragma unroll
        for (int r = 0; r < 17; ++r) red[(kq * 17 + r) * 64 + (tid & 63)] = a[r];
        __syncthreads();
        for (int i = tid; i < 17 * 64; i += 512) { const int r = i >> 6, c = i & 63; float v = 0.f;
#pragma unroll
            for (int q = 0; q < 8; ++q) v += red[(q * 17 + r) * 64 + c];
            const int nn = (item % 96) * 64 + c; mod[((size_t)l * 17 + r) * 6144 + nn] = v + p.in[I_ADAB][(size_t)l * 6144 + nn]; }
        __syncthreads();
    }
}
DEVINL void rope_phase(const Params& p) {
    float* tab = (float*)(p.ws + WS_ROPE);
    for (int i = blockIdx.x * 512 + tid_hidden(); i < 4096 * 64; i += gridDim.x * 512) {
        const int pos = i >> 6, f = i & 63;
        const float inv = expf(-logf(10000.0f) * (float)(f & 31) / 32.0f);
        const float ang = (float)(f < 32 ? (pos >> 6) : (pos & 63)) * inv;
        float sn, cs; sincosf(ang, &sn, &cs);
        tab[2 * i] = cs; tab[2 * i + 1] = sn;
    }
}

DEVINL bf16_t* strm_row(const Params& p, int t) { return (bf16_t*)(p.ws + WS_A) + (size_t)t * 1024; }
DEVINL bf16_t* regA(const Params& p) { return (bf16_t*)p.out; }
DEVINL unsigned char* regA8(const Params& p) { return (unsigned char*)p.out + U; }
DEVINL const float* in_row0(const Params& p, int t) { return t < NLAT ? p.in[I_X] + (size_t)t * 1024 : p.in[I_CTX] + (size_t)(t - NLAT) * 1024; }
DEVINL const float* mod_row(const Params& p, int l, int t, int which) { const int r = t < NLAT ? (t >> 12) : 16; return (const float*)(p.ws + WS_MOD) + (((size_t)l * 17 + r) * 6 + which) * 1024; }

DEVINL void modulate0_phase(const Params& p) {
    const int tid = tid_hidden(), lane = tid & 63, gw = blockIdx.x * 8 + (tid >> 6), nw = gridDim.x * 8;
    bf16_t* h = regA(p);
    for (int t = gw; t < T; t += 2 * nw) {
        const int t2 = t + nw; const bool has2 = t2 < T; const int tb = has2 ? t2 : t;
        const float* xa = in_row0(p, t); const float* xb = in_row0(p, tb);
        f32x4 va[4], vb[4];
#pragma unroll
        for (int j = 0; j < 4; ++j) { va[j] = *(const f32x4*)(xa + j * 256 + lane * 4); vb[j] = *(const f32x4*)(xb + j * 256 + lane * 4); }
        const float* sha = mod_row(p, 0, t, 0); const float* sca = mod_row(p, 0, t, 1); const float* shb = mod_row(p, 0, tb, 0); const float* scb = mod_row(p, 0, tb, 1);
#pragma unroll
        for (int j = 0; j < 4; ++j) { const int c = j * 256 + lane * 4;
            const f32x4 ya = va[j] * (*(const f32x4*)(sca + c) + 1.0f) + *(const f32x4*)(sha + c); u32x2 w; w.x = pk2(ya[0], ya[1]); w.y = pk2(ya[2], ya[3]); *(u32x2*)(h + (size_t)t * 1024 + c) = w; *(unsigned*)(regA8(p) + (size_t)t * 1024 + c) = pk4_fp8(ya[0], ya[1], ya[2], ya[3]);
            if (has2) { const f32x4 yb = vb[j] * (*(const f32x4*)(scb + c) + 1.0f) + *(const f32x4*)(shb + c); u32x2 w2; w2.x = pk2(yb[0], yb[1]); w2.y = pk2(yb[2], yb[3]); *(u32x2*)(h + (size_t)tb * 1024 + c) = w2; *(unsigned*)(regA8(p) + (size_t)tb * 1024 + c) = pk4_fp8(yb[0], yb[1], yb[2], yb[3]); } }
    }
}

DEVINL void acc8(float (&a)[8], const u32x4 v) { a[0] += bflo(v.x); a[1] += bfhi(v.x); a[2] += bflo(v.y); a[3] += bfhi(v.y); a[4] += bflo(v.z); a[5] += bfhi(v.z); a[6] += bflo(v.w); a[7] += bfhi(v.w); }
template <int GI, bool HORIZ>
DEVINL void pool_item(const bf16_t* __restrict__ src, const bf16_t* __restrict__ usrc, bf16_t* __restrict__ dst, int t, int ch) {
    constexpr int W = 2 << GI, LEFT = W / 2, RIGHT = W - 1 - LEFT;
    const bool lat = t < NLAT;
    int pos, last, stride;
    if (HORIZ) { pos = lat ? (t & 63) : ((t - NLAT) & 255); last = lat ? 63 : 255; stride = 1; }
    else { pos = (t >> 6) & 63; last = 63; stride = 64; }
    float a[8];
#pragma unroll
    for (int j = 0; j < 8; ++j) a[j] = 0.f;
    if (!HORIZ && !lat) { *(u32x4*)(dst + (size_t)t * 512 + ch) = *(const u32x4*)(src + (size_t)t * 512 + ch); return; }
    const int lo = max(pos - LEFT, 0), hi = min(pos + RIGHT, last);
    u32x4 wv[W];
#pragma unroll
    for (int k = 0; k < W; ++k) { const int qc = min(max(pos - LEFT + k, lo), hi); wv[k] = *(const u32x4*)(src + (size_t)(t + (qc - pos) * stride) * 512 + ch); }
#pragma unroll
    for (int k = 0; k < W; ++k) { const int q = pos - LEFT + k; if (q >= lo && q <= hi) acc8(a, wv[k]); }
    const float inv = 1.0f / (float)(hi - lo + 1);
    u32x4 w;
    if (HORIZ) { const u32x4 uv = *(const u32x4*)(usrc + (size_t)t * 512 + ch);
        w.x = pk2(a[0] * inv - bflo(uv.x), a[1] * inv - bfhi(uv.x)); w.y = pk2(a[2] * inv - bflo(uv.y), a[3] * inv - bfhi(uv.y));
        w.z = pk2(a[4] * inv - bflo(uv.z), a[5] * inv - bfhi(uv.z)); w.w = pk2(a[6] * inv - bflo(uv.w), a[7] * inv - bfhi(uv.w)); }
    else { w.x = pk2(a[0] * inv, a[1] * inv); w.y = pk2(a[2] * inv, a[3] * inv); w.z = pk2(a[4] * inv, a[5] * inv); w.w = pk2(a[6] * inv, a[7] * inv); }
    *(u32x4*)(dst + (size_t)t * 512 + ch) = w;
}
template <bool HORIZ>
DEVINL void pool_phase(const Params& p, int Tact) {
    const int tid = tid_hidden(), lane = tid & 63, gw = blockIdx.x * 8 + (tid >> 6), nw = gridDim.x * 8;
    bf16_t* u = (bf16_t*)(p.ws + WS_BIG + B_U); bf16_t* vm = regA(p);
    const bf16_t* src = HORIZ ? vm : u; bf16_t* dst = HORIZ ? u : vm;
    for (int q = gw; q < Tact / 4; q += nw) {
        const int t = q * 4 + (lane >> 4), cl = (lane & 15) * 8;
        pool_item<3, HORIZ>(src, u, dst, t, 384 + cl); pool_item<2, HORIZ>(src, u, dst, t, 256 + cl); pool_item<1, HORIZ>(src, u, dst, t, 128 + cl); pool_item<0, HORIZ>(src, u, dst, t, cl);
    }
}
struct CombSet { u32x2 a[4], b[4], g[4]; };
DEVINL void comb_load(const Params& p, int t, int lane, CombSet& S) {
    const bf16_t* of = (const bf16_t*)(p.ws + WS_BIG + B_OF); const bf16_t* ob = (const bf16_t*)(p.ws + WS_BIG + B_OB); const bf16_t* sg = (const bf16_t*)(p.ws + WS_BIG + B_SG);
#pragma unroll
    for (int j = 0; j < 4; ++j) { const size_t off = (size_t)t * 1024 + j * 256 + lane * 4; S.a[j] = *(const u32x2*)(of + off); S.b[j] = *(const u32x2*)(ob + off); S.g[j] = *(const u32x2*)(sg + off); }
}
DEVINL void comb_row(const Params& p, int t, int lane, const CombSet& S) {
    bf16_t* ur = (bf16_t*)(p.ws + WS_BIG + B_URET);
#pragma unroll
    for (int j = 0; j < 4; ++j) {
        float o[4] = {bflo(S.a[j].x) + bflo(S.b[j].x), bfhi(S.a[j].x) + bfhi(S.b[j].x), bflo(S.a[j].y) + bflo(S.b[j].y), bfhi(S.a[j].y) + bfhi(S.b[j].y)};
        const float mean = wave_sum(o[0] + o[1] + o[2] + o[3]) * (1.0f / 256.0f);
        float q = 0.f;
#pragma unroll
        for (int e = 0; e < 4; ++e) { o[e] -= mean; q += o[e] * o[e]; }
        const float rstd = rsqrtf(wave_sum(q) * (1.0f / 256.0f) + LN_EPS);
        u32x2 w; w.x = pk2(bflo(S.g[j].x) * o[0] * rstd, bfhi(S.g[j].x) * o[1] * rstd); w.y = pk2(bflo(S.g[j].y) * o[2] * rstd, bfhi(S.g[j].y) * o[3] * rstd);
        *(u32x2*)(ur + (size_t)t * 1024 + j * 256 + lane * 4) = w;
    }
}
DEVINL void combine_phase(const Params& p, int Tact) {
    const int tid = tid_hidden(), lane = tid & 63, gw = blockIdx.x * 8 + (tid >> 6), nw = gridDim.x * 8;
    CombSet A0, A1, B0, B1;
    int ta = gw;
    if (ta < Tact) { comb_load(p, ta, lane, A0); comb_load(p, min(ta + nw, Tact - 1), lane, A1); }
    while (ta < Tact) {
        const int tn = ta + 2 * nw;
        if (tn < Tact) { comb_load(p, tn, lane, B0); comb_load(p, min(tn + nw, Tact - 1), lane, B1); }
        comb_row(p, ta, lane, A0); if (ta + nw < Tact) comb_row(p, ta + nw, lane, A1);
        if (tn >= Tact) break;
        const int tn2 = tn + 2 * nw;
        if (tn2 < Tact) { comb_load(p, tn2, lane, A0); comb_load(p, min(tn2 + nw, Tact - 1), lane, A1); }
        comb_row(p, tn, lane, B0); if (tn + nw < Tact) comb_row(p, tn + nw, lane, B1);
        ta = tn2;
    }
}

struct LnRaw { u32x4 r[2]; };
DEVINL void ln_load_row(const bf16_t* xr, int lane, LnRaw& R) { R.r[0] = *(const u32x4*)(xr + lane * 8); R.r[1] = *(const u32x4*)(xr + 512 + lane * 8); }
DEVINL void ln_norm16(float (&v)[2][8], float& mean_o, float& rstd_o) {
    float s = 0.f;
#pragma unroll
    for (int j = 0; j < 2; ++j)
#pragma unroll
        for (int e = 0; e < 8; ++e) s += v[j][e];
    const float mean = wave_sum(s) * (1.0f / 1024.0f);
    float q = 0.f;
#pragma unroll
    for (int j = 0; j < 2; ++j)
#pragma unroll
        for (int e = 0; e < 8; ++e) { v[j][e] -= mean; q += v[j][e] * v[j][e]; }
    const float rstd = rsqrtf(wave_sum(q) * (1.0f / 1024.0f) + LN_EPS);
#pragma unroll
    for (int j = 0; j < 2; ++j)
#pragma unroll
        for (int e = 0; e < 8; ++e) v[j][e] *= rstd;
    mean_o = mean; rstd_o = rstd;
}
DEVINL void lds8f(const LAS float* p, float (&v)[8]) { const f32x4 a = *(const LAS f32x4*)p, b = *(const LAS f32x4*)(p + 4); v[0] = a[0]; v[1] = a[1]; v[2] = a[2]; v[3] = a[3]; v[4] = b[0]; v[5] = b[1]; v[6] = b[2]; v[7] = b[3]; }
DEVINL int mod_ridx(int t) { return t < NLAT ? (t >> 12) : 16; }
DEVINL void lds_fill(LAS float* dst, const float* src, int tid) { for (int i = tid; i < 256; i += 512) *(LAS f32x4*)(dst + 4 * i) = *(const f32x4*)(src + 4 * i); }
DEVINL void ln1_row(const Params& p, int t, int lane, bool moe, const LnRaw& R, const LAS float* sG2, const LAS float* sB2, LAS float* sR, LAS int* sCnt) {
    unsigned char* h2 = (unsigned char*)regA(p);
    float v[2][8]; unpk8h(R.r[0], v[0]); unpk8h(R.r[1], v[1]);
    f32v2_t d[2][4];
#pragma unroll
    for (int j = 0; j < 2; ++j)
#pragma unroll
        for (int k = 0; k < 4; ++k) d[j][k] = (f32v2_t){v[j][2 * k], v[j][2 * k + 1]};
    f32v2_t s2 = (d[0][0] + d[0][1]) + (d[0][2] + d[0][3]) + ((d[1][0] + d[1][1]) + (d[1][2] + d[1][3]));
    const float mean = wave_sum(s2.x + s2.y) * (1.0f / 1024.0f);
    f32v2_t q2 = (f32v2_t){0.f, 0.f};
#pragma unroll
    for (int j = 0; j < 2; ++j)
#pragma unroll
        for (int k = 0; k < 4; ++k) { d[j][k] -= mean; q2 += d[j][k] * d[j][k]; }
    const float rstd = rsqrtf(wave_sum(q2.x + q2.y) * (1.0f / 1024.0f) + LN_EPS);
    if (lane == 0) { float* st1 = (float*)(p.ws + WS_ST1); st1[2 * t] = mean; st1[2 * t + 1] = rstd; }
    f32v2_t lg2[8];
#pragma unroll
    for (int e = 0; e < 8; ++e) lg2[e] = (f32v2_t){0.f, 0.f};
#pragma unroll
    for (int j = 0; j < 2; ++j) { const int c = j * 512 + lane * 8;
        float g8[8], b8[8]; lds8f(sG2 + c, g8); lds8f(sB2 + c, b8);
        f32v2_t hp[4];
#pragma unroll
        for (int k = 0; k < 4; ++k) hp[k] = d[j][k] * ((f32v2_t){g8[2 * k], g8[2 * k + 1]} * rstd) + (f32v2_t){b8[2 * k], b8[2 * k + 1]};
        { u32x2 w8; w8.x = pk4_fp8(hp[0].x, hp[0].y, hp[1].x, hp[1].y); w8.y = pk4_fp8(hp[2].x, hp[2].y, hp[3].x, hp[3].y); *(u32x2*)(h2 + (size_t)t * 1024 + c) = w8; }
        if (moe) {
#pragma unroll
            for (int e = 0; e < 8; ++e) { float w8[8]; lds8f(sR + e * 1024 + c, w8);
#pragma unroll
                for (int k = 0; k < 4; ++k) lg2[e] += hp[k] * (f32v2_t){w8[2 * k], w8[2 * k + 1]}; }
        }
    }
    if (moe) {
        int* toke = (int*)(p.ws + WS_TOKE); float* tokw = (float*)(p.ws + WS_TOKW);
        float lg[8];
#pragma unroll
        for (int e = 0; e < 8; ++e) lg[e] = lg2[e].x + lg2[e].y;
        wave_sum8(lg, lane);
        int e0 = 0; float m0 = lg[0];
#pragma unroll
        for (int e = 1; e < 8; ++e) if (lg[e] > m0) { m0 = lg[e]; e0 = e; }
        int e1 = -1; float m1 = -3.0e38f;
#pragma unroll
        for (int e = 0; e < 8; ++e) if (e != e0 && lg[e] > m1) { m1 = lg[e]; e1 = e; }
        if (e1 < 0) { e1 = (e0 + 1) & 7; m1 = m0; }
        const float ex = __expf(m1 - m0), w0 = __builtin_amdgcn_rcpf(1.0f + ex), w1 = ex * w0;
        if (lane == 0) { toke[2 * t] = e0; toke[2 * t + 1] = e1; tokw[2 * t] = w0; tokw[2 * t + 1] = w1; __hip_atomic_fetch_add(&sCnt[e0], 1, __ATOMIC_RELAXED, __HIP_MEMORY_SCOPE_WORKGROUP); __hip_atomic_fetch_add(&sCnt[e1], 1, __ATOMIC_RELAXED, __HIP_MEMORY_SCOPE_WORKGROUP); }
    }
}
DEVINL void ln1_phase(const Params& p, LAS unsigned char* lds, int l, int Tact) {
    const int tid = tid_hidden(), lane = tid & 63, wv = tid >> 6, G = gridDim.x;
    const bool moe = (l & 1) != 0;
    LAS float* sR = (LAS float*)lds;
    LAS int* sCnt = (LAS int*)(lds + 32768);
    LAS float* sG = (LAS float*)(lds + 36864); LAS float* sB = sG + 1024; LAS float* sSC = sB + 1024; LAS float* sSH = sSC + 2048;
    LAS float* sG2 = sSH + 2048; LAS float* sB2 = sG2 + 2048;
    const int per = (Tact + G - 1) / G, t0 = blockIdx.x * per, t1 = min(t0 + per, Tact);
    const int r_lo = mod_ridx(min(t0, Tact - 1)), r_hi = mod_ridx(max(t1 - 1, 0));
    if (moe) { const float* wr = p.in[I_ROUTER] + (size_t)(l >> 1) * 1024 * 8; for (int i = tid; i < 8192; i += 512) sR[(i & 7) * 1024 + (i >> 3)] = wr[i]; if (tid < 8) sCnt[tid] = 0; }
    { const float* modl = (const float*)(p.ws + WS_MOD) + (size_t)l * 17 * 6144;
      lds_fill(sG, p.in[I_LNMG] + (size_t)l * 1024, tid); lds_fill(sB, p.in[I_LNMB] + (size_t)l * 1024, tid);
      lds_fill(sSC, modl + ((size_t)r_lo * 6 + 4) * 1024, tid); lds_fill(sSC + 1024, modl + ((size_t)r_hi * 6 + 4) * 1024, tid);
      lds_fill(sSH, modl + ((size_t)r_lo * 6 + 3) * 1024, tid); lds_fill(sSH + 1024, modl + ((size_t)r_hi * 6 + 3) * 1024, tid); }
    __syncthreads();
    for (int i = tid; i < 2048; i += 512) { const int cc = i & 1023; const float sc1 = sSC[i] + 1.0f; sG2[i] = sG[cc] * sc1; sB2[i] = sB[cc] * sc1 + sSH[i]; }
    __syncthreads();
#define LN1_ROW(tt, RR) do { const int _o = (mod_ridx(tt) == r_lo) ? 0 : 1024; ln1_row(p, (tt), lane, moe, RR, sG2 + _o, sB2 + _o, sR, sCnt); } while (0)
    LnRaw A0, A1, B0, B1;
    int ta = t0 + wv;
    if (ta < t1) { ln_load_row(strm_row(p, ta), lane, A0); ln_load_row(strm_row(p, min(ta + 8, t1 - 1)), lane, A1); }
    while (ta < t1) {
        const int tn = ta + 16;
        if (tn < t1) { ln_load_row(strm_row(p, tn), lane, B0); ln_load_row(strm_row(p, min(tn + 8, t1 - 1)), lane, B1); }
        LN1_ROW(ta, A0); if (ta + 8 < t1) LN1_ROW(ta + 8, A1);
        if (tn >= t1) break;
        const int tn2 = tn + 16;
        if (tn2 < t1) { ln_load_row(strm_row(p, tn2), lane, A0); ln_load_row(strm_row(p, min(tn2 + 8, t1 - 1)), lane, A1); }
        LN1_ROW(tn, B0); if (tn + 8 < t1) LN1_ROW(tn + 8, B1);
        ta = tn2;
    }
#undef LN1_ROW
    __syncthreads();
    if (moe && tid < 8) ((int*)(p.ws + WS_WGCNT))[blockIdx.x * 8 + tid] = sCnt[tid];
    __syncthreads();
}

DEVINL void moe_scatter_phase(const Params& p, LAS unsigned char* lds, int Tact) {
    const int tid = tid_hidden(), lane = tid & 63, wv = tid >> 6, G = gridDim.x;
    LAS int* sC = (LAS int*)lds;
    LAS int* sBase = (LAS int*)(lds + 16384);
    LAS int* sE = (LAS int*)(lds + 16384 + 256);
    LAS int* sD = (LAS int*)(lds + 16384 + 256 + 4096);
    const int* wgc = (const int*)(p.ws + WS_WGCNT);
    for (int i = tid; i < G * 8; i += 512) sC[i] = wgc[i];
    __syncthreads();
    if (tid < 8) { int tot = 0, before = 0; for (int g = 0; g < G; ++g) { const int c = sC[g * 8 + tid]; if (g < (int)blockIdx.x) before += c; tot += c; } sBase[tid] = before; sBase[8 + tid] = (tot + 255) / 256 * 256; }
    __syncthreads();
    if (tid == 0) { int acc = 0; for (int e = 0; e < 8; ++e) { const int pd = sBase[8 + e]; sBase[e] += acc; acc += pd; sBase[8 + e] = acc; } }
    __syncthreads();
    const int per = (Tact + G - 1) / G, t0 = blockIdx.x * per, t1 = min(t0 + per, Tact), na = max(t1 - t0, 0) * 2;
    const int* toke = (const int*)(p.ws + WS_TOKE); int* tokd = (int*)(p.ws + WS_TOKD);
    for (int a = tid; a < na; a += 512) sE[a] = toke[2 * t0 + a] & 7;
    __syncthreads();
    for (int a = tid; a < na; a += 512) { const int e = sE[a]; int r = 0; for (int b = 0; b < a; ++b) r += (sE[b] == e) ? 1 : 0; int d = sBase[e] + r; d = min(max(d, 0), MAXRB * 256 - 1); sD[a] = d; tokd[2 * t0 + a] = d; }
    if (blockIdx.x == 0) {
        int* blke = (int*)(p.ws + WS_BLKE);
        if (tid == 0) blke[0] = sBase[15] / 256;
        if (tid < 7) blke[1 + tid] = sBase[8 + tid] / 256;
        for (int rb = tid; rb < MAXRB; rb += 512) { int e = 0; while (e < 7 && rb * 256 >= sBase[8 + e]) ++e; blke[8 + rb] = e; }
    }
    __syncthreads();
    const unsigned char* h2 = (const unsigned char*)regA(p); unsigned char* xs = p.ws + WS_BIG + F_XS;
    for (int a0 = wv; a0 < na; a0 += 64) {
        u32x4 v0[8];
#pragma unroll
        for (int r = 0; r < 8; ++r) { const int a = min(a0 + 8 * r, na - 1), t = t0 + (a >> 1); v0[r] = *(const u32x4*)(h2 + (size_t)t * 1024 + lane * 16); }
#pragma unroll
        for (int r = 0; r < 8; ++r) { const int a = a0 + 8 * r; if (a < na) { const int d = sD[a]; *(u32x4*)(xs + (size_t)d * 1024 + lane * 16) = v0[r]; } }
    }
    __syncthreads();
}

struct Ln2Set { LnRaw z; LnRaw ya, yb; float w0, w1, m1, r1; };
struct Ln2Par { const LAS float* G; const LAS float* B; const LAS float* SC; const LAS float* SH; const LAS float* M5; const LAS float* GM; const LAS float* BM; };
DEVINL void ln2_load(const Params& p, int t, int lane, bool moe, Ln2Set& S) {
    if (moe) { const int* tokd = (const int*)(p.ws + WS_TOKD); const float* tokw = (const float*)(p.ws + WS_TOKW); const bf16_t* yk = (const bf16_t*)(p.ws + WS_BIG + F_YK);
        const int d0 = tokd[2 * t], d1 = tokd[2 * t + 1]; S.w0 = tokw[2 * t]; S.w1 = tokw[2 * t + 1]; const float* st1 = (const float*)(p.ws + WS_ST1); S.m1 = st1[2 * t]; S.r1 = st1[2 * t + 1];
        ln_load_row(yk + (size_t)d0 * 1024, lane, S.ya); ln_load_row(yk + (size_t)d1 * 1024, lane, S.yb); }
    ln_load_row(strm_row(p, t), lane, S.z);
}
DEVINL void ln2_row(const Params& p, int l, int t, int lane, bool moe, const Ln2Set& S, const Ln2Par& P) {
    float v[2][8]; unpk8h(S.z.r[0], v[0]); unpk8h(S.z.r[1], v[1]);
    if (moe) {
#pragma unroll
        for (int j = 0; j < 2; ++j) { const int c = j * 512 + lane * 8; float a8[8], b8[8], g8[8], e8[8], m8[8]; unpk8(S.ya.r[j], a8); unpk8(S.yb.r[j], b8); lds8f(P.GM + c, g8); lds8f(P.BM + c, e8); lds8f(P.M5 + c, m8);
#pragma unroll
            for (int e = 0; e < 8; ++e) { const float x1 = (v[j][e] - S.m1) * S.r1 * g8[e] + e8[e];
                v[j][e] = x1 * ALPHA + m8[e] * (S.w0 * a8[e] + S.w1 * b8[e]); } } }
    float mean2, rstd2; ln_norm16(v, mean2, rstd2);
    const bool last = l + 1 >= DEPTH, store_x = moe || last;
    if (!store_x && lane == 0) { float* st2 = (float*)(p.ws + WS_ST2); st2[2 * t] = mean2; st2[2 * t + 1] = rstd2; }
#pragma unroll
    for (int j = 0; j < 2; ++j) { const int c = j * 512 + lane * 8; float g8[8], b8[8], xv[8]; lds8f(P.G + c, g8); lds8f(P.B + c, b8);
#pragma unroll
        for (int e = 0; e < 8; ++e) xv[e] = v[j][e] * g8[e] + b8[e];
        if (last) { float* o = p.out + (size_t)t * 1024 + c; *(f32x4*)o = (f32x4){xv[0], xv[1], xv[2], xv[3]}; *(f32x4*)(o + 4) = (f32x4){xv[4], xv[5], xv[6], xv[7]}; }
        else if (store_x) *(u32x4*)(strm_row(p, t) + c) = pk8h(xv);
        if (!last) { float s8[8], h8[8], hv[8]; lds8f(P.SC + c, s8); lds8f(P.SH + c, h8);
#pragma unroll
            for (int e = 0; e < 8; ++e) hv[e] = xv[e] * (s8[e] + 1.0f) + h8[e];
            *(u32x4*)(regA(p) + (size_t)t * 1024 + c) = pk8(hv);
            u32x2 w8; w8.x = pk4_fp8(hv[0], hv[1], hv[2], hv[3]); w8.y = pk4_fp8(hv[4], hv[5], hv[6], hv[7]); *(u32x2*)(regA8(p) + (size_t)t * 1024 + c) = w8; }
    }
}
DEVINL void ln2_phase(const Params& p, LAS unsigned char* lds, int l, int Tact) {
    const int tid = tid_hidden(), lane = tid & 63, wv = tid >> 6, G = gridDim.x;
    const bool moe = (l & 1) != 0, last = l + 1 >= DEPTH;
    LAS float* sG = (LAS float*)lds; LAS float* sB = sG + 1024; LAS float* sSC = sB + 1024; LAS float* sSH = sSC + 2048; LAS float* sM5 = sSH + 2048; LAS float* sGM = sM5 + 2048; LAS float* sBM = sGM + 1024;
    const int per = (Tact + G - 1) / G, t0 = blockIdx.x * per, t1 = min(t0 + per, Tact);
    const int r_lo = mod_ridx(min(t0, Tact - 1)), r_hi = mod_ridx(max(t1 - 1, 0));
    __syncthreads();
    { const float* mod = (const float*)(p.ws + WS_MOD); const float* modl = mod + (size_t)l * 17 * 6144; const float* modn = mod + (size_t)(last ? l : l + 1) * 17 * 6144;
      lds_fill(sG, p.in[I_LNFG] + (size_t)l * 1024, tid); lds_fill(sB, p.in[I_LNFB] + (size_t)l * 1024, tid);
      lds_fill(sSC, modn + ((size_t)r_lo * 6 + 1) * 1024, tid); lds_fill(sSC + 1024, modn + ((size_t)r_hi * 6 + 1) * 1024, tid);
      lds_fill(sSH, modn + ((size_t)r_lo * 6 + 0) * 1024, tid); lds_fill(sSH + 1024, modn + ((size_t)r_hi * 6 + 0) * 1024, tid);
      lds_fill(sM5, modl + ((size_t)r_lo * 6 + 5) * 1024, tid); lds_fill(sM5 + 1024, modl + ((size_t)r_hi * 6 + 5) * 1024, tid);
      lds_fill(sGM, p.in[I_LNMG] + (size_t)l * 1024, tid); lds_fill(sBM, p.in[I_LNMB] + (size_t)l * 1024, tid); }
    __syncthreads();
#define LN2_ROW(tt, SS) do { const int _o = (mod_ridx(tt) == r_lo) ? 0 : 1024; const Ln2Par _P{sG, sB, sSC + _o, sSH + _o, sM5 + _o, sGM, sBM}; ln2_row(p, l, (tt), lane, moe, SS, _P); } while (0)
    Ln2Set A0, A1, B0, B1;
    int ta = t0 + wv;
    if (ta < t1) { ln2_load(p, ta, lane, moe, A0); ln2_load(p, min(ta + 8, t1 - 1), lane, moe, A1); }
    while (ta < t1) {
        const int tn = ta + 16;
        if (tn < t1) { ln2_load(p, tn, lane, moe, B0); ln2_load(p, min(tn + 8, t1 - 1), lane, moe, B1); }
        LN2_ROW(ta, A0); if (ta + 8 < t1) LN2_ROW(ta + 8, A1);
        if (tn >= t1) break;
        const int tn2 = tn + 16;
        if (tn2 < t1) { ln2_load(p, tn2, lane, moe, A0); ln2_load(p, min(tn2 + 8, t1 - 1), lane, moe, A1); }
        LN2_ROW(tn, B0); if (tn + 8 < t1) LN2_ROW(tn + 8, B1);
        ta = tn2;
    }
#undef LN2_ROW
    __syncthreads();
}

DEVINL bf16x8 cat8(v4i16_t a, v4i16_t b) { bf16x8 r; r[0] = a[0]; r[1] = a[1]; r[2] = a[2]; r[3] = a[3]; r[4] = b[0]; r[5] = b[1]; r[6] = b[2]; r[7] = b[3]; return r; }
DEVINL void retention_phase(const Params& p, LAS unsigned char* lds, int l, bool need_ctx) {
    constexpr int RS = 272;
    int tid = threadIdx.x; asm volatile("" : "+v"(tid));
    const int w = __builtin_amdgcn_readfirstlane(tid >> 6), lane = tid & 63, fr = lane & 15, fq = lane >> 4;
    LAS unsigned char* Qs = lds; LAS unsigned char* Ks = lds + 34816; LAS unsigned char* Vs = lds + 69632; LAS unsigned char* Ps = lds + 104448;
    LAS float* tqd = (LAS float*)(lds + LDS_TAB); LAS float* tkd = tqd + 128;
    const bf16_t* qg = (const bf16_t*)(p.ws + WS_BIG + B_Q); const bf16_t* kg = (const bf16_t*)(p.ws + WS_BIG + B_K); const bf16_t* vg = (const bf16_t*)(p.ws + WS_BIG + B_V);
    const int lr = tid >> 4, lc = tid & 15;
    const int trq = fr >> 2, trp = fr & 3;
    for (int item = blockIdx.x; item < 256; item += gridDim.x) {
        const int dvs = item & 1, dir = (item >> 1) & 1, hd = (item >> 2) & 3, b = item >> 4;
        bf16_t* og = (bf16_t*)(p.ws + WS_BIG + (dir ? B_OB : B_OF));
        const float zl = p.in[I_DECAY][l * 8 + dir * 4 + hd];
        const float lg2 = -log1pf(expf(-zl)) * 1.4426950408889634f;
        __syncthreads();
        if (tid < 128) { tqd[tid] = exp2f(lg2 * (float)(dir ? 128 - tid : tid + 1)); tkd[tid] = exp2f(lg2 * (float)(dir ? tid : 127 - tid)); }
        const float cdec = exp2f(lg2 * 128.0f);
        float afac[4];
#pragma unroll
        for (int jj = 0; jj < 4; ++jj) afac[jj] = exp2f(lg2 * (float)(dir ? (4 * fq + jj - fr) : (fr - 4 * fq - jj)));
        f32x4 S[8];
#pragma unroll
        for (int t = 0; t < 8; ++t) S[t] = (f32x4){0.f, 0.f, 0.f, 0.f};
        u32x4 rq[4], rk[4], rv[4];
#define RET_TOK0(c) ((c) < 2 ? NLAT + b * 256 + (dir ? 1 - (c) : (c)) * 128 : b * 4096 + (dir ? 33 - (c) : (c) - 2) * 128)
#define RET_LOAD(c) do { const int _t0 = RET_TOK0(c); _Pragma("unroll") for (int ps = 0; ps < 4; ++ps) { const size_t _t = (size_t)(_t0 + lr + 32 * ps); \
            rq[ps] = *(const u32x4*)(qg + _t * 512 + hd * 128 + lc * 8); rk[ps] = *(const u32x4*)(kg + _t * 512 + hd * 128 + lc * 8); rv[ps] = *(const u32x4*)(vg + _t * 1024 + hd * 256 + dvs * 128 + lc * 8); } } while (0)
        RET_LOAD(0);
        for (int c = 0; c < 34; ++c) {
            const int tok0 = RET_TOK0(c);
            __syncthreads();
#pragma unroll
            for (int ps = 0; ps < 4; ++ps) { const int o = (lr + 32 * ps) * RS + lc * 16; *(LAS u32x4*)(Qs + o) = rq[ps]; *(LAS u32x4*)(Ks + o) = rk[ps]; *(LAS u32x4*)(Vs + o) = rv[ps]; }
            __syncthreads();
            if (c + 1 < 34) RET_LOAD(c + 1);
            const bool do_out = (c >= 2) || need_ctx;
            if (do_out) {
                const int rt = w < 4 ? w : 11 - w;
                bf16x8 qf[4];
#pragma unroll
                for (int s = 0; s < 4; ++s) qf[s] = *(const LAS bf16x8*)(Qs + (16 * rt + fr) * RS + (32 * s + 8 * fq) * 2);
                const int i = 16 * rt + fr;
#pragma unroll
                for (int t = 0; t < 8; ++t) {
                    const bool live = dir ? (t >= rt) : (t <= rt);
                    f32x4 a = (f32x4){0.f, 0.f, 0.f, 0.f};
                    if (live) {
#pragma unroll
                        for (int s = 0; s < 4; ++s) { const bf16x8 kf = *(const LAS bf16x8*)(Ks + (16 * t + fr) * RS + (32 * s + 8 * fq) * 2); a = __builtin_amdgcn_mfma_f32_16x16x32_bf16(kf, qf[s], a, 0, 0, 0); }
                        const float bt = __builtin_amdgcn_exp2f(lg2 * 16.0f * (float)(dir ? t - rt : rt - t));
#pragma unroll
                        for (int jj = 0; jj < 4; ++jj) { const int dd = dir ? (4 * fq + jj - fr) : (fr - 4 * fq - jj); a[jj] = (t != rt || dd >= 0) ? a[jj] * (afac[jj] * bt) : 0.f; }
                    }
                    u32x2 pw; pw.x = pk2(a[0], a[1]); pw.y = pk2(a[2], a[3]);
                    *(LAS u32x2*)(Ps + i * RS + (16 * t + 4 * fq) * 2) = pw;
                }
            }
            __syncthreads();
            bf16x8 vf[4];
#pragma unroll
            for (int s = 0; s < 4; ++s) { LAS unsigned char* a0 = Vs + (32 * s + 8 * fq + trq) * RS + (16 * w + 4 * trp) * 2;
                vf[s] = cat8(__builtin_amdgcn_ds_read_tr16_b64_v4i16((LAS v4i16_t*)a0), __builtin_amdgcn_ds_read_tr16_b64_v4i16((LAS v4i16_t*)(a0 + 4 * RS))); }
            if (do_out) {
                bf16x8 Sb[4];
#pragma unroll
                for (int s = 0; s < 4; ++s) { u32x4 t4; t4.x = pk2(S[2 * s][0], S[2 * s][1]); t4.y = pk2(S[2 * s][2], S[2 * s][3]); t4.z = pk2(S[2 * s + 1][0], S[2 * s + 1][1]); t4.w = pk2(S[2 * s + 1][2], S[2 * s + 1][3]); Sb[s] = __builtin_bit_cast(bf16x8, t4); }
#pragma unroll
                for (int ip = 0; ip < 4; ++ip) {
                    const int i0 = 16 * (2 * ip) + fr, i1 = i0 + 16;
                    bf16x8 q0[4], q1[4];
#pragma unroll
                    for (int s = 0; s < 4; ++s) { q0[s] = *(const LAS bf16x8*)(Qs + i0 * RS + (32 * s + 8 * fq) * 2); q1[s] = *(const LAS bf16x8*)(Qs + i1 * RS + (32 * s + 8 * fq) * 2); }
                    f32x4 a0 = (f32x4){0.f, 0.f, 0.f, 0.f}, a1 = a0;
#pragma unroll
                    for (int s = 0; s < 4; ++s) { a0 = __builtin_amdgcn_mfma_f32_16x16x32_bf16(Sb[s], q0[s], a0, 0, 0, 0); a1 = __builtin_amdgcn_mfma_f32_16x16x32_bf16(Sb[s], q1[s], a1, 0, 0, 0); }
                    a0 *= tqd[i0]; a1 *= tqd[i1];
#pragma unroll
                    for (int s = 0; s < 4; ++s) {
                        if (dir ? (2 * s + 1 >= 2 * ip) : (2 * s <= 2 * ip)) { const bf16x8 pb = *(const LAS bf16x8*)(Ps + i0 * RS + (32 * s + 8 * fq) * 2); a0 = __builtin_amdgcn_mfma_f32_16x16x32_bf16(vf[s], pb, a0, 0, 0, 0); }
                        if (dir ? (2 * s + 1 >= 2 * ip + 1) : (2 * s <= 2 * ip + 1)) { const bf16x8 pb = *(const LAS bf16x8*)(Ps + i1 * RS + (32 * s + 8 * fq) * 2); a1 = __builtin_amdgcn_mfma_f32_16x16x32_bf16(vf[s], pb, a1, 0, 0, 0); }
                    }
                    u32x2 ow0, ow1; ow0.x = pk2(a0[0], a0[1]); ow0.y = pk2(a0[2], a0[3]); ow1.x = pk2(a1[0], a1[1]); ow1.y = pk2(a1[2], a1[3]);
                    *(u32x2*)(og + (size_t)(tok0 + i0) * 1024 + hd * 256 + dvs * 128 + 16 * w + 4 * fq) = ow0;
                    *(u32x2*)(og + (size_t)(tok0 + i1) * 1024 + hd * 256 + dvs * 128 + 16 * w + 4 * fq) = ow1;
                }
            }
#pragma unroll
            for (int t = 0; t < 8; ++t) S[t] *= cdec;
#pragma unroll
            for (int s = 0; s < 4; ++s) {
                const f32x4 k0 = *(const LAS f32x4*)(tkd + 32 * s + 8 * fq), k1 = *(const LAS f32x4*)(tkd + 32 * s + 8 * fq + 4);
                const u32x4 vv = __builtin_bit_cast(u32x4, vf[s]); u32x4 t4;
                t4.x = pk2(bflo(vv.x) * k0[0], bfhi(vv.x) * k0[1]); t4.y = pk2(bflo(vv.y) * k0[2], bfhi(vv.y) * k0[3]);
                t4.z = pk2(bflo(vv.z) * k1[0], bfhi(vv.z) * k1[1]); t4.w = pk2(bflo(vv.w) * k1[2], bfhi(vv.w) * k1[3]);
                const bf16x8 vsc = __builtin_bit_cast(bf16x8, t4);
#pragma unroll
                for (int t = 0; t < 8; ++t) {
                    LAS unsigned char* a0 = Ks + (32 * s + 8 * fq + trq) * RS + (32 * (t >> 1) + 8 * trp + 4 * (t & 1)) * 2;
                    const bf16x8 kt = cat8(__builtin_amdgcn_ds_read_tr16_b64_v4i16((LAS v4i16_t*)a0), __builtin_amdgcn_ds_read_tr16_b64_v4i16((LAS v4i16_t*)(a0 + 4 * RS)));
                    S[t] = __builtin_amdgcn_mfma_f32_16x16x32_bf16(kt, vsc, S[t], 0, 0, 0);
                }
            }
        }
#undef RET_TOK0
#undef RET_LOAD
    }
    __syncthreads();
}

__global__ void __launch_bounds__(512, 2) fwd_kernel(Params p) {
    extern __shared__ __attribute__((aligned(16))) unsigned char lds_raw[];
    LAS unsigned char* lds = (LAS unsigned char*)lds_raw;
    const int tid = threadIdx.x, G = gridDim.x, lo = p.ph_lo, hi = p.ph_hi;
    volatile LAS unsigned* xst = (volatile LAS unsigned*)(lds + LDS_CTL);
    if (tid < 4) xst[tid] = 0u;
    __syncthreads();
    XcdBarrier bar; bar.bar = (unsigned*)(p.ws + WS_CTL) + CW_BAR; bar.x = 0; bar.st = xst;
    const bool multi = (hi - lo) > 1;
    if (multi) bar = xcd_barrier_post((unsigned*)(p.ws + WS_CTL) + CW_BAR, xst);
#ifndef PHM
#define PHM 0xFFFFFFFFu
#endif
#define PM(q) ((PHM >> (q)) & 1u)
#define IN(k) (lo <= (k) && (k) < hi)
#ifndef TSEL
#define TSEL 0u
#endif
#ifndef TMULT
#define TMULT 10
#endif
    volatile LAS unsigned long long* tacc = (volatile LAS unsigned long long*)(lds + LDS_CTL + 32);
    if (TSEL && tid == 0) { tacc[0] = 0ull; tacc[1] = wall_clock64(); }
#define SEAMK(k, kind) do { if ((k) + 1 < hi) xcd_barrier(bar); if (TSEL && blockIdx.x == 0 && tid == 0) { const unsigned long long _n = wall_clock64(); if ((TSEL >> (kind)) & 1u) tacc[0] += _n - tacc[1]; tacc[1] = _n; } } while (0)
    unsigned char* big = p.ws + WS_BIG;
    const char* wmix = (const char*)(p.ws + WS_WMIX);

    if (PM(13) && IN(PH_PRO_A)) { adaln_phase(p, lds); rope_phase(p); __syncthreads(); convert_mixer_weights(p, lds, 0); SEAMK(PH_PRO_A, 13); }
    if (PM(14) && IN(PH_PRO_B)) { modulate0_phase(p); SEAMK(PH_PRO_B, 14); }

    for (int l = 0; l < DEPTH; ++l) {
        const int pb = PH_L0 + l * PH_PER_L;
        if (hi <= pb || lo >= pb + PH_PER_L) continue;
        const bool need_ctx = l < DEPTH - 1;
        const int Tact = need_ctx ? T : NLAT, nMact = Tact / 256;
        const float* modl = (const float*)(p.ws + WS_MOD) + (size_t)l * 17 * 6144;

        if (PM(0) && IN(pb + Q_IN)) {
            EpiIn E{(bf16_t*)big, (const float*)(p.ws + WS_ROPE)};
            if (need_ctx) { SchedRect S{(const char*)regA(p), wmix + WMIX_IN, T / 256, 14, G, (int)blockIdx.x, (size_t)256 * 1024 * 2}; gemm_phase(lds, 1024, S, E); }
            else { SchedIn3 S{(const char*)regA(p), wmix + WMIX_IN, G, (int)blockIdx.x, (size_t)256 * 1024 * 2}; gemm_phase(lds, 1024, S, E); }
            __syncthreads();
            {
              SchedRect S8{(const char*)regA8(p), wmix + WMIX_IN8, nMact, 8, G, (int)blockIdx.x, (size_t)256 * 1024};
              EpiSig8 E8{(bf16_t*)big}; gemm_phase(lds, 1024 / 2, S8, E8); }
            SEAMK(pb + Q_IN, 0);
        }
        if (PM(2) && IN(pb + Q_RET)) { pool_phase<false>(p, Tact); retention_phase(p, lds, l, need_ctx); SEAMK(pb + Q_RET, 2); }
        if (PM(3) && IN(pb + Q_COMB)) { combine_phase(p, Tact); pool_phase<true>(p, Tact); SEAMK(pb + Q_COMB, 3); }
        if (PM(4) && IN(pb + Q_MIX)) {
            { SchedRect S{(const char*)(big + B_U), wmix + WMIX_POOL, nMact, 4, G, (int)blockIdx.x, (size_t)256 * 512 * 2};
              EpiGate<0> E{(bf16_t*)(big + B_Y1), (const bf16_t*)(big + B_GP), nullptr}; gemm_phase(lds, 512, S, E); }
            __syncthreads();
            { SchedRect S{(const char*)(big + B_URET), wmix + WMIX_RET, nMact, 4, G, (int)blockIdx.x, (size_t)256 * 1024 * 2};
              EpiGate<1> E{(bf16_t*)(big + B_MIX), (const bf16_t*)(big + B_GR), (const bf16_t*)(big + B_Y1)}; gemm_phase(lds, 1024, S, E); }
            SEAMK(pb + Q_MIX, 4);
        }
        if (PM(5) && IN(pb + Q_OUT)) {
            SchedRect S{(const char*)(big + B_MIX), wmix + WMIX_OUT, nMact, 4, G, (int)blockIdx.x, (size_t)256 * 1024 * 2};
            const bool renorm = (l & 1) != 0;
            const float* lg = p.in[I_LNFG] + (size_t)(l > 0 ? l - 1 : 0) * 1024; const float* lb = p.in[I_LNFB] + (size_t)(l > 0 ? l - 1 : 0) * 1024;
            if (l == 0) { EpiRes<true, false> E{p.in[I_X], p.in[I_CTX], (bf16_t*)(p.ws + WS_A), modl, 2, nullptr, lg, lb}; gemm_phase(lds, 1024, S, E); }
            else if (renorm) { EpiRes<false, true> E{nullptr, nullptr, (bf16_t*)(p.ws + WS_A), modl, 2, (const float*)(p.ws + WS_ST2), lg, lb}; gemm_phase(lds, 1024, S, E); }
            else { EpiRes<false, false> E{nullptr, nullptr, (bf16_t*)(p.ws + WS_A), modl, 2, nullptr, lg, lb}; gemm_phase(lds, 1024, S, E); }
            SEAMK(pb + Q_OUT, 5);
        }
        if (PM(6) && IN(pb + Q_LN1)) {
            ln1_phase(p, lds, l, Tact);
            convert_ffn_weights(p, lds, l);
            if (l + 1 < DEPTH) convert_mixer_weights(p, lds, l + 1);
            SEAMK(pb + Q_LN1, 6);
        }
        if ((l & 1) == 0) {
            if (PM(7) && IN(pb + Q_F0)) {
                SchedRect S{(const char*)regA(p), (const char*)(big + F_W), nMact, 2 * DFF / 256, G, (int)blockIdx.x, (size_t)256 * 1024};
                EpiSwiglu8 E{big + F_ACT, DFF, 0}; gemm_phase(lds, 1024 / 2, S, E);
                SEAMK(pb + Q_F0, 7);
            }
            if (PM(8) && IN(pb + Q_F1)) {
                SchedRect S{(const char*)(big + F_ACT), (const char*)(big + F_DW2), nMact, 4, G, (int)blockIdx.x, (size_t)256 * DFF};
                EpiRes<false, true, true> E{nullptr, nullptr, (bf16_t*)(p.ws + WS_A), modl, 5, (const float*)(p.ws + WS_ST1), p.in[I_LNMG] + (size_t)l * 1024, p.in[I_LNMB] + (size_t)l * 1024};
                gemm_phase(lds, DFF / 2, S, E);
                SEAMK(pb + Q_F1, 8);
            }
        } else {
            if (PM(9) && IN(pb + Q_F0)) { moe_scatter_phase(p, lds, Tact); SEAMK(pb + Q_F0, 9); }
            const int* blke = (const int*)(p.ws + WS_BLKE);
            for (int g = 0; g < NGRP; ++g) {
                if (PM(10) && IN(pb + Q_F1 + 2 * g)) {
                    const int nb = min(blke[0], MAXRB), rb0 = g * RBG, nrb = min(RBG, nb - rb0);
                    if (nrb > 0) {
                        int w0, w1, w2; moe_bounds(blke, w0, w1, w2);
                        SchedMoe S{(const char*)(big + F_XS), (const char*)(big + F_W), w0, w1, w2, rb0, 0, nrb, 2 * EFF / 256, G, (int)blockIdx.x, (size_t)256 * 1024, F_EW13};
                        EpiSwiglu8 E{big + F_ACTM, EFF, rb0}; gemm_phase(lds, 1024 / 2, S, E);
                    }
                    SEAMK(pb + Q_F1 + 2 * g, 10);
                }
                if (PM(11) && IN(pb + Q_F1 + 2 * g + 1)) {
                    const int nb = min(blke[0], MAXRB), rb0 = g * RBG, nrb = min(RBG, nb - rb0);
                    if (nrb > 0) {
                        int w0, w1, w2; moe_bounds(blke, w0, w1, w2);
                        SchedMoe S{(const char*)(big + F_ACTM), (const char*)(big + F_W + (size_t)NEXP * F_EW13), w0, w1, w2, rb0, rb0, nrb, 4, G, (int)blockIdx.x, (size_t)256 * EFF, F_EW2};
                        EpiPlain8 E{(bf16_t*)(big + F_YK), 1.0f / W2_SCALE}; gemm_phase(lds, EFF / 2, S, E);
                    }
                    SEAMK(pb + Q_F1 + 2 * g + 1, 11);
                }
            }
        }
        if (PM(12) && IN(pb + Q_LN2)) { ln2_phase(p, lds, l, Tact); SEAMK(pb + Q_LN2, 12); }
    }
#undef IN
#undef SEAMK
    if (TSEL && blockIdx.x == 0 && tid == 0) { const unsigned long long t0 = wall_clock64(), w = tacc[0] * (unsigned long long)TMULT; while (wall_clock64() - t0 < w) __builtin_amdgcn_s_sleep(32); }
}

static bool phase_active(int ph) {
    if (ph < PH_L0) return true;
    const int l = (ph - PH_L0) / PH_PER_L, q = (ph - PH_L0) % PH_PER_L;
    if (q == Q_POOLV) return false;
    if (q <= Q_F0 || q == Q_LN2) return true;
    if (q >= Q_F1 && q < Q_LN2) { if ((l & 1) == 0) return q == Q_F1; return q < Q_F1 + 2 * NGRP; }
    return false;
}

extern "C" void kernel_launch(void* const* d_in, const int* in_sizes, int n_in, void* d_out, int out_size, void* d_ws, size_t ws_size, hipStream_t stream) {
    static int grid = 0;
    if (grid == 0) {
        if (n_in != 24 || out_size != NLAT * 1024 || ws_size < WS_END) { fprintf(stderr, "kernel_launch: unexpected shapes (n_in %d out %d ws %zu need %zu)\n", n_in, out_size, ws_size, (size_t)WS_END); grid = -1; return; }
        int dev = 0, cus = 0, per_cu = 0;
        if (hipGetDevice(&dev) != hipSuccess || hipDeviceGetAttribute(&cus, hipDeviceAttributeMultiprocessorCount, dev) != hipSuccess) { grid = -1; return; }
        if (hipFuncSetAttribute((const void*)fwd_kernel, hipFuncAttributeMaxDynamicSharedMemorySize, LDS_BYTES) != hipSuccess) { fprintf(stderr, "kernel_launch: hipFuncSetAttribute failed\n"); grid = -1; return; }
        if (hipOccupancyMaxActiveBlocksPerMultiprocessor(&per_cu, (const void*)fwd_kernel, 512, LDS_BYTES) != hipSuccess || per_cu < 1) { fprintf(stderr, "kernel_launch: occupancy query says %d\n", per_cu); (void)hipGetLastError(); per_cu = 1; }
        grid = cus < 256 ? cus : 256;
    }
    if (grid < 0) return;
    (void)hipMemsetAsync((char*)d_ws + WS_CTL, 0, CTL_BYTES, stream);
    Params p{};
    for (int i = 0; i < 24; ++i) p.in[i] = (const float*)d_in[i];
    p.out = (float*)d_out; p.ws = (unsigned char*)d_ws;
#if MK_MULTI
#ifndef MAXPH
#define MAXPH NPH
#endif
    for (int ph = 0; ph < MAXPH; ++ph) {
        if (!phase_active(ph)) continue;
        p.ph_lo = ph; p.ph_hi = ph + 1;
        hipLaunchKernelGGL(fwd_kernel, dim3(grid), dim3(512), LDS_BYTES, stream, p);
    }
#else
    p.ph_lo = 0; p.ph_hi = NPH;
    hipLaunchKernelGGL(fwd_kernel, dim3(grid), dim3(512), LDS_BYTES, stream, p);
#endif
}
```
